# Optimizing an MI355X kernel written in HIP

```python
import jax, jax.numpy as jnp
from jax import lax
import numpy as np

D_MODEL = 1024
BATCH = 8
SEQ = 2048
DEPTH = 2

CHUNK = 64
PLE_DIM = 256
N_A = DEPTH // 2
N_B = DEPTH - N_A
POOL_WINDOWS = (2, 4, 8, 16)
N_POOL_GROUPS = len(POOL_WINDOWS)
POOL_GROUP_DIM = D_MODEL // N_POOL_GROUPS
POOL_WMAX = max(POOL_WINDOWS)
SB_HEADS = 16
SB_HEAD_DIM = D_MODEL // SB_HEADS
SB_SCALE = SB_HEAD_DIM ** -0.5
Q_BLOCK = 128
EPS = 1e-6

kernel_name = "yoco_pool_stickbreaking_hybrid"


def rms_norm(x, g):
    xf = x.astype(jnp.float32)
    y = xf * lax.rsqrt(jnp.mean(xf * xf, axis=-1, keepdims=True) + EPS)
    return (y * g.astype(jnp.float32)).astype(x.dtype)


def pool_mixer(h, w_in, w_group, scale, w_out):
    B, S, _ = h.shape
    u, z = jnp.split(h @ w_in, 2, axis=-1)
    u = u.reshape(B, S, N_POOL_GROUPS, POOL_GROUP_DIM)
    uf = u.astype(jnp.float32)
    cs = jnp.cumsum(uf, axis=1)
    cs_ext = jnp.pad(cs, ((0, 0), (POOL_WMAX, 0), (0, 0), (0, 0)))
    pos1 = jnp.arange(1, S + 1)
    means = []
    for g, w in enumerate(POOL_WINDOWS):
        lo = cs_ext[:, POOL_WMAX - w: POOL_WMAX - w + S, g]
        cnt = jnp.minimum(pos1, w).astype(jnp.float32)[None, :, None]
        means.append((cs[:, :, g] - lo) / cnt)
    pooled = (jnp.stack(means, axis=2) - uf).astype(h.dtype)
    mixed = jnp.einsum('bsgc,gcd->bsgd', pooled, w_group).reshape(B, S, D_MODEL) * scale
    return (mixed * jax.nn.silu(z)) @ w_out


def split_heads(t):
    B, S, _ = t.shape
    return t.reshape(B, S, SB_HEADS, SB_HEAD_DIM).transpose(0, 2, 1, 3)


def stick_breaking_attention(q, k, v):
    S = q.shape[2]
    outs = []
    for blk in range(S // Q_BLOCK):
        t0 = blk * Q_BLOCK
        L = t0 + Q_BLOCK
        logits = jnp.einsum('bhtd,bhsd->bhts', q[:, :, t0:L], k[:, :, :L]).astype(jnp.float32) * SB_SCALE
        t_idx = t0 + jnp.arange(Q_BLOCK)[:, None]
        s_idx = jnp.arange(L)[None, :]
        mask = s_idx < t_idx
        log_keep = jnp.where(mask, jax.nn.log_sigmoid(-logits), 0.0)
        later = lax.cumsum(log_keep, axis=log_keep.ndim - 1, reverse=True) - log_keep
        log_a = jax.nn.log_sigmoid(logits) + later
        a = jnp.where(mask, jnp.exp(log_a), 0.0)
        outs.append(jnp.einsum('bhts,bhsd->bhtd', a.astype(v.dtype), v[:, :, :L]))
    return jnp.concatenate(outs, axis=2)


def setup_inputs(seed: int = 0) -> dict:
    key = jax.random.key(seed)
    ks = jax.random.split(key, 20)
    D, C = D_MODEL, POOL_GROUP_DIM
    f32 = jnp.float32

    def nrm(k, shape, fan_in, gain=1.0):
        return jax.random.normal(k, shape, f32) * (gain * fan_in ** -0.5)

    def gain(k, shape):
        return 1.0 + 0.05 * jax.random.normal(k, shape, f32)

    return {
        "x": jax.random.normal(ks[0], (BATCH, SEQ, D), f32),
        "p": jax.random.normal(ks[1], (DEPTH, BATCH, SEQ, PLE_DIM), f32),
        "a_norm": gain(ks[2], (N_A, D)),
        "a_w_in": nrm(ks[3], (N_A, D, 2 * D), D),
        "a_w_group": nrm(ks[4], (N_A, N_POOL_GROUPS, C, C), C),
        "a_scale": gain(ks[5], (N_A, D)),
        "a_w_out": nrm(ks[6], (N_A, D, D), D, 0.5),
        "kv_norm": gain(ks[7], (D,)),
        "w_kv": nrm(ks[8], (D, 2 * D), D),
        "k_norm": gain(ks[9], (SB_HEAD_DIM,)),
        "b_norm": gain(ks[10], (N_B, D)),
        "b_w_in": nrm(ks[11], (N_B, D, 2 * D), D),
        "b_q_norm": gain(ks[12], (N_B, SB_HEAD_DIM)),
        "b_w_out": nrm(ks[13], (N_B, D, D), D, 0.5),
        "ple_w": nrm(ks[14], (DEPTH, PLE_DIM, D), PLE_DIM, 0.5),
        "ple_gate_w": nrm(ks[15], (DEPTH, D, D), D),
    }


def reference(x, p, a_norm, a_w_in, a_w_group, a_scale, a_w_out, kv_norm, w_kv, k_norm,
              b_norm, b_w_in, b_q_norm, b_w_out, ple_w, ple_gate_w):
    B, S, _ = x.shape
    k_sh = v_sh = None
    for i in range(DEPTH):
        if i < N_A:
            h = rms_norm(x, a_norm[i])
            x = x + pool_mixer(h, a_w_in[i], a_w_group[i], a_scale[i], a_w_out[i])
        else:
            j = i - N_A
            if j == 0:
                kv_in = rms_norm(x, kv_norm)
                k_all, v_all = jnp.split(kv_in @ w_kv, 2, axis=-1)
                k_sh = rms_norm(split_heads(k_all), k_norm)
                v_sh = split_heads(v_all)
            h = rms_norm(x, b_norm[j])
            q, z = jnp.split(h @ b_w_in[j], 2, axis=-1)
            q = rms_norm(split_heads(q), b_q_norm[j])
            o = stick_breaking_attention(q, k_sh, v_sh)
            o = o.transpose(0, 2, 1, 3).reshape(B, S, D_MODEL)
            x = x + (o * jax.nn.silu(z)) @ b_w_out[j]
        x = x + (p[i] @ ple_w[i]) * jax.nn.sigmoid(x @ ple_gate_w[i])
    return x
```

```cpp
#include <hip/hip_runtime.h>
#include <hip/hip_cooperative_groups.h>
#include <cstdio>
namespace cg = cooperative_groups;
namespace pg8 {
#define PG8_LAS __attribute__((address_space(3)))
typedef unsigned short bf16_t;
typedef short bf16x8 __attribute__((ext_vector_type(8)));
typedef float f32x4 __attribute__((ext_vector_type(4)));
typedef unsigned u32x4 __attribute__((ext_vector_type(4)));
constexpr int BM = 256, BK = 64, HALF = 128, HTB = HALF * BK * 2  , STAGE_BYTES = 8 * HTB, NXCD = 8, WGM = 8;

__host__ __device__ __forceinline__ int lds_byte(int r, int c) { const int st = (r >> 4) * 2 + (c >> 5), rr = r & 15, cc = c & 31, ob = rr * 64 + cc * 2; return st * 1024 + (ob ^ (((ob >> 9) & 1) << 5)); }
__host__ __device__ __forceinline__ void stage_rc(int b, int& R, int& C) { const int st = b / 1024, sb = b % 1024, swz = sb ^ (((sb >> 9) & 1) << 5); R = (st >> 1) * 16 + swz / 64; C = (st & 1) * 32 + (swz % 64) / 2; }
__host__ __device__ __forceinline__ int perm32(int rho) { const int n = rho >> 4, i = rho & 15; return 8 * (i >> 2) + 4 * n + (i & 3); }

struct Unit { int pm, pn; };
struct Gemm { const bf16_t* A; const bf16_t* Bt; int M, N, K; };
struct StaticOrder {
    int nM, nN, nwg, G, c;
    __host__ __device__ void init(int M, int N, int G_, int c_) { nM = M / BM; nN = N / BM; nwg = nM * nN; G = G_; c = c_; }
    __host__ __device__ bool next(int i, Unit& u) const {
        const long L = (long)i * G + c; if (L >= nwg) return false;
        int wgid = (int)L; { const int q = nwg / NXCD, r = nwg % NXCD, xcd = wgid % NXCD, off = wgid / NXCD; wgid = (xcd < r ? xcd * (q + 1) : r * (q + 1) + (xcd - r) * q) + off; }
        const int nig = WGM * nN, gid = wgid / nig, fm = gid * WGM, gsz = (nM - fm) < WGM ? (nM - fm) : WGM;
        u.pm = fm + ((wgid % nig) % gsz); u.pn = (wgid % nig) / gsz; return true;
    }
    __device__ __forceinline__ void a_ready(const Unit&) const {}
    __device__ __forceinline__ void done(const Unit&) const {}
};
template <class Epi, class Sched, bool STAMP = false>
__device__ __forceinline__ void gemm_phase(PG8_LAS unsigned char* lds, const Gemm g, const Sched& S, const Epi& E, unsigned long long* stamps) {
    const int tid = threadIdx.x, wid = __builtin_amdgcn_readfirstlane(tid >> 6), lane = tid & 63, wr = wid >> 2, wc = wid & 3, fr = lane & 15, fq = lane >> 4;
    const int K = g.K, nt = K / BK;
    int ts_lo = 0, ts_hi = 0, nts = 0; const unsigned long long rt_entry = STAMP ? (unsigned long long)wall_clock64() : 0ull;
#define PG8_STAMP() do { if (STAMP && wid == 0 && nts < 64) { const unsigned long long _c = (unsigned long long)clock64(); \
        ts_lo = (lane == nts) ? (int)(unsigned)_c : ts_lo; ts_hi = (lane == nts) ? (int)(unsigned)(_c >> 32) : ts_hi; ++nts; } } while (0)
    PG8_STAMP();
    unsigned voffA[2], voffB[2];
#pragma unroll
    for (int i = 0; i < 2; ++i) { int R, C; stage_rc(tid * 16 + i * 8192, R, C); const int Rb = Epi::PERM ? ((R & ~31) + perm32(R & 31)) : R;
        voffA[i] = (unsigned)(R * K + C) * 2u; voffB[i] = (unsigned)(Rb * K + C) * 2u; }
    const size_t kstep = (size_t)(BK * 2);
    const size_t hstep = (size_t)HALF * K * 2;
    const size_t tstep = 2 * hstep;
    const unsigned ldsw = (unsigned)wid * 1024u;
    const int aoff = lds_byte(wr * 64 + fr, fq * 8), boff = lds_byte(wc * 32 + fr, fq * 8);
#define PG8_SA(b, h) (((b) * 2 + (h)) * HTB)
#define PG8_SB(b, h) ((4 + (b) * 2 + (h)) * HTB)
#define PG8_STAGE(bufoff, gbase, voff) do { _Pragma("unroll") for (int _i = 0; _i < 2; ++_i) \
        __builtin_amdgcn_global_load_lds((const unsigned*)((const char*)(gbase) + (voff)[_i]), (PG8_LAS unsigned*)(lds + (bufoff) + ldsw + _i * 8192), 16, 0, 0); } while (0)
#define PG8_LDA(dst, b, h) do { _Pragma("unroll") for (int m = 0; m < 4; ++m) _Pragma("unroll") for (int k = 0; k < 2; ++k) dst[m][k] = *(const PG8_LAS bf16x8*)(lds + PG8_SA(b, h) + aoff + m * 2048 + k * 1024); } while (0)
#define PG8_LDB(dst, b, h) do { _Pragma("unroll") for (int n = 0; n < 2; ++n) _Pragma("unroll") for (int k = 0; k < 2; ++k) dst[n][k] = *(const PG8_LAS bf16x8*)(lds + PG8_SB(b, h) + boff + n * 2048 + k * 1024); } while (0)
#define PG8_MMA(ai, bj, At, Bt) do { __builtin_amdgcn_s_setprio(1); _Pragma("unroll") for (int m = 0; m < 4; ++m) _Pragma("unroll") for (int n = 0; n < 2; ++n) _Pragma("unroll") for (int k = 0; k < 2; ++k) \
        acc[ai][bj][m][n] = __builtin_amdgcn_mfma_f32_16x16x32_bf16(Bt[n][k], At[m][k], acc[ai][bj][m][n], 0, 0, 0); __builtin_amdgcn_s_setprio(0); } while (0)
#define PG8_WAIT_V(n) asm volatile("s_waitcnt vmcnt(" #n ")" ::: "memory")
#define PG8_WAIT_L(n) asm volatile("s_waitcnt lgkmcnt(" #n ")" ::: "memory")
#define PG8_BAR __builtin_amdgcn_s_barrier()
#define PG8_SCHED __builtin_amdgcn_sched_barrier(0)
    Unit cur, nxt; int ui = 0;
    if (!S.next(0, cur)) return;
    f32x4 acc[2][2][4][2];
#pragma unroll
    for (int a = 0; a < 2; ++a)
#pragma unroll
        for (int b = 0; b < 2; ++b)
#pragma unroll
            for (int m = 0; m < 4; ++m)
#pragma unroll
                for (int n = 0; n < 2; ++n) acc[a][b][m][n] = (f32x4){0.f, 0.f, 0.f, 0.f};
    bf16x8 At[4][2], B0[2][2], B1[2][2];
    const char* cA = (const char*)g.A + (size_t)cur.pm * tstep; const char* cB = (const char*)g.Bt + (size_t)cur.pn * tstep;
    S.a_ready(cur);
    PG8_STAGE(PG8_SB(0, 0), cB, voffB); PG8_STAGE(PG8_SA(0, 0), cA, voffA); PG8_STAGE(PG8_SB(0, 1), cB + hstep, voffB); PG8_STAGE(PG8_SA(0, 1), cA + hstep, voffA);
    if (wr == 1) PG8_BAR;
    PG8_WAIT_V(4); PG8_BAR;
    PG8_STAGE(PG8_SB(1, 0), cB + kstep, voffB); PG8_STAGE(PG8_SA(1, 0), cA + kstep, voffA); PG8_STAGE(PG8_SB(1, 1), cB + hstep + kstep, voffB);
    PG8_WAIT_V(6); PG8_BAR;
    PG8_STAMP();
    for (;;) {
        const bool has_next = S.next(ui + 1, nxt);
        const char* nA = has_next ? (const char*)g.A + (size_t)nxt.pm * tstep : cA; const char* nB = has_next ? (const char*)g.Bt + (size_t)nxt.pn * tstep : cB;
        for (int t = 0; t < nt; t += 2) {
            const bool last = (t == nt - 2);
            const char* a1 = cA + (size_t)(t + 1) * kstep;
            const char* a2 = last ? nA : cA + (size_t)(t + 2) * kstep; const char* b2 = last ? nB : cB + (size_t)(t + 2) * kstep;
            const char* a3 = a2 + kstep; const char* b3 = b2 + kstep;
            if (last && has_next) S.a_ready(nxt);
            PG8_LDB(B0, 0, 0); PG8_SCHED; PG8_LDA(At, 0, 0); PG8_STAGE(PG8_SA(1, 1), a1 + hstep, voffA);
            PG8_WAIT_L(8); PG8_BAR; PG8_WAIT_L(0); PG8_MMA(0, 0, At, B0); PG8_BAR; PG8_SCHED;
            PG8_LDB(B1, 0, 1); PG8_STAGE(PG8_SB(0, 0), b2, voffB);
            PG8_BAR; PG8_WAIT_L(0); PG8_MMA(0, 1, At, B1); PG8_BAR;
            PG8_LDA(At, 0, 1); PG8_STAGE(PG8_SA(0, 0), a2, voffA);
            PG8_BAR; PG8_WAIT_L(0); PG8_MMA(1, 0, At, B0); PG8_BAR; PG8_SCHED;
            PG8_STAGE(PG8_SB(0, 1), b2 + hstep, voffB);
            PG8_WAIT_V(6); PG8_BAR; PG8_MMA(1, 1, At, B1); PG8_BAR;
            PG8_LDB(B0, 1, 0); PG8_SCHED; PG8_LDA(At, 1, 0); PG8_STAGE(PG8_SA(0, 1), a2 + hstep, voffA);
            PG8_WAIT_L(8); PG8_BAR; PG8_WAIT_L(0); PG8_MMA(0, 0, At, B0); PG8_BAR; PG8_SCHED;
            PG8_LDB(B1, 1, 1); PG8_STAGE(PG8_SB(1, 0), b3, voffB);
            PG8_BAR; PG8_WAIT_L(0); PG8_MMA(0, 1, At, B1); PG8_BAR;
            PG8_LDA(At, 1, 1); PG8_STAGE(PG8_SA(1, 0), a3, voffA);
            PG8_BAR; PG8_WAIT_L(0); PG8_MMA(1, 0, At, B0); PG8_BAR; PG8_SCHED;
            PG8_STAGE(PG8_SB(1, 1), b3 + hstep, voffB);
            PG8_WAIT_V(6); PG8_BAR; PG8_MMA(1, 1, At, B1); PG8_BAR;
        }
        PG8_STAMP();
        if constexpr (!Epi::AFTER_DRAIN) { E(acc, cur, wr, wc, fr, fq); S.done(cur); }
        PG8_STAMP();
        if (!has_next) break;
#pragma unroll
        for (int a = 0; a < 2; ++a)
#pragma unroll
            for (int b = 0; b < 2; ++b)
#pragma unroll
                for (int m = 0; m < 4; ++m)
#pragma unroll
                    for (int n = 0; n < 2; ++n) acc[a][b][m][n] = (f32x4){0.f, 0.f, 0.f, 0.f};
        cur = nxt; cA = nA; cB = nB; ++ui;
    }
    PG8_WAIT_V(0);
    if (wr == 0) PG8_BAR;
    PG8_BAR;
    if constexpr (Epi::AFTER_DRAIN) { E.fused(acc, cur, wr, wc, fr, fq, lds, wid, lane); S.done(cur); }
    PG8_STAMP();
    if (STAMP && wid == 0) { stamps[lane] = lane < nts ? (((unsigned long long)(unsigned)ts_hi << 32) | (unsigned)ts_lo) : 0ull;
        if (lane == 62) stamps[62] = rt_entry; if (lane == 63) stamps[63] = (unsigned long long)wall_clock64(); }
#undef PG8_STAMP
#undef PG8_SA
#undef PG8_SB
#undef PG8_STAGE
#undef PG8_LDA
#undef PG8_LDB
#undef PG8_MMA
#undef PG8_WAIT_V
#undef PG8_WAIT_L
#undef PG8_BAR
#undef PG8_SCHED
}
}
using pg8::f32x4; using pg8::u32x4; using pg8::bf16_t; using pg8::Unit;
#define DI __device__ __forceinline__
#ifndef SPLIT_LAUNCH
#define SPLIT_LAUNCH 1
#endif
constexpr int M_TOK = 16384, DM = 1024, SEQ = 2048, NPHASE = 10;
constexpr float EPS = 1e-6f;
constexpr int LDS_BYTES = 131072;
constexpr size_t MiB = 1024 * 1024;
constexpr size_t OFF_WIN1 = 0, OFF_WAOUT = 4 * MiB, OFF_WPLE0 = 6 * MiB, OFF_WPLE1 = 6 * MiB + 512 * 1024, OFF_WG0 = 7 * MiB, OFF_WG1 = 9 * MiB,
                 OFF_WKQZ = 11 * MiB, OFF_WV = 17 * MiB, OFF_WBOUT = 19 * MiB, OFF_PB = 21 * MiB, OFF_R1 = 37 * MiB, OFF_R2 = 69 * MiB, OFF_R3 = 101 * MiB,
                 OFF_R4 = 133 * MiB, OFF_RSTD0 = 197 * MiB, OFF_RSTD1 = 197 * MiB + 65536, OFF_SSP = 197 * MiB + 131072, WS_END = 199 * MiB;

struct Params {
    const float *x, *p, *a_norm, *a_w_in, *a_w_group, *a_scale, *a_w_out, *kv_norm, *w_kv, *k_norm, *b_norm, *b_w_in, *b_q_norm, *b_w_out, *ple_w, *ple_gate_w;
    float* out; unsigned char* ws; int ph_lo, ph_hi;
};

typedef __bf16 bf16x2_t __attribute__((ext_vector_type(2)));
typedef float f32x2_t __attribute__((ext_vector_type(2)));
typedef short s16x8 __attribute__((ext_vector_type(8)));
typedef short s16x4 __attribute__((ext_vector_type(4)));
typedef float f32x16 __attribute__((ext_vector_type(16)));
DI unsigned pk2(float lo, float hi) { f32x2_t v = {lo, hi}; bf16x2_t r = __builtin_convertvector(v, bf16x2_t); return __builtin_bit_cast(unsigned, r); }
DI float bflo(unsigned u) { return __uint_as_float(u << 16); }
DI float bfhi(unsigned u) { return __uint_as_float(u & 0xffff0000u); }
DI u32x4 pk8(f32x4 a, f32x4 b) { u32x4 w; w.x = pk2(a[0], a[1]); w.y = pk2(a[2], a[3]); w.z = pk2(b[0], b[1]); w.w = pk2(b[2], b[3]); return w; }
DI float wave_sum(float v) {
#pragma unroll
    for (int o = 1; o < 64; o <<= 1) v += __shfl_xor(v, o);
    return v;
}
DI float sigm(float v) { return __builtin_amdgcn_rcpf(1.f + __expf(-v)); }
DI f32x4 silu4(f32x4 v) { f32x4 r; r[0] = v[0] * sigm(v[0]); r[1] = v[1] * sigm(v[1]); r[2] = v[2] * sigm(v[2]); r[3] = v[3] * sigm(v[3]); return r; }
DI f32x4 sigm4(f32x4 v) { f32x4 r; r[0] = sigm(v[0]); r[1] = sigm(v[1]); r[2] = sigm(v[2]); r[3] = sigm(v[3]); return r; }

typedef const f32x4 (&AccRef)[2][2][4][2];

struct Epi1 {
    static constexpr bool PERM = true, AFTER_DRAIN = false;
    bf16_t* ug; bf16_t* sz; const float* rstd0;
    DI void operator()(AccRef acc, const Unit& u, int wr, int wc, int fr, int fq) const {
        const int row0 = u.pm * 256 + wr * 64 + fr; const bool isz = u.pn >= 4;
        bf16_t* base = (isz ? sz : ug) + (u.pn & 3) * 256 + wc * 32 + 8 * fq;
#pragma unroll
        for (int ai = 0; ai < 2; ++ai)
#pragma unroll
            for (int m = 0; m < 4; ++m) { const int row = row0 + ai * 128 + m * 16; const float rs = rstd0[row]; bf16_t* rowp = base + (size_t)row * DM;
#pragma unroll
                for (int bj = 0; bj < 2; ++bj) { f32x4 v0 = acc[ai][bj][m][0] * rs, v1 = acc[ai][bj][m][1] * rs;
                    if (isz) { v0 = silu4(v0); v1 = silu4(v1); }
                    *(u32x4*)(rowp + bj * 128) = pk8(v0, v1); } }
    }
};
struct EpiE {
    static constexpr bool PERM = true, AFTER_DRAIN = false;
    bf16_t* e;
    DI void operator()(AccRef acc, const Unit& u, int wr, int wc, int fr, int fq) const {
        const int row0 = u.pm * 256 + wr * 64 + fr; bf16_t* base = e + u.pn * 256 + wc * 32 + 8 * fq;
#pragma unroll
        for (int ai = 0; ai < 2; ++ai)
#pragma unroll
            for (int m = 0; m < 4; ++m) { bf16_t* rowp = base + (size_t)(row0 + ai * 128 + m * 16) * DM;
#pragma unroll
                for (int bj = 0; bj < 2; ++bj) *(u32x4*)(rowp + bj * 128) = pk8(acc[ai][bj][m][0], acc[ai][bj][m][1]); }
    }
};
struct EpiRes {
    static constexpr bool PERM = true, AFTER_DRAIN = false;
    const float* src; float* dst; bf16_t* xb;
    DI void operator()(AccRef acc, const Unit& u, int wr, int wc, int fr, int fq) const {
        const int row0 = u.pm * 256 + wr * 64 + fr, col0 = u.pn * 256 + wc * 32 + 8 * fq;
#pragma unroll
        for (int ai = 0; ai < 2; ++ai)
#pragma unroll
            for (int m = 0; m < 4; ++m) { const size_t o = (size_t)(row0 + ai * 128 + m * 16) * DM + col0;
#pragma unroll
                for (int bj = 0; bj < 2; ++bj) { const f32x4 a0 = *(const f32x4*)(src + o + bj * 128), a1 = *(const f32x4*)(src + o + bj * 128 + 4);
                    const f32x4 v0 = a0 + acc[ai][bj][m][0], v1 = a1 + acc[ai][bj][m][1];
                    *(f32x4*)(dst + o + bj * 128) = v0; *(f32x4*)(dst + o + bj * 128 + 4) = v1; *(u32x4*)(xb + o + bj * 128) = pk8(v0, v1); } }
    }
};
template <bool NEXT> struct EpiGate {
    static constexpr bool PERM = true, AFTER_DRAIN = false;
    float* xio; const bf16_t* e; bf16_t* xb; float* ssp;
    DI void operator()(AccRef acc, const Unit& u, int wr, int wc, int fr, int fq) const {
        const int row0 = u.pm * 256 + wr * 64 + fr, col0 = u.pn * 256 + wc * 32 + 8 * fq;
#pragma unroll
        for (int ai = 0; ai < 2; ++ai)
#pragma unroll
            for (int m = 0; m < 4; ++m) { const int row = row0 + ai * 128 + m * 16; const size_t o = (size_t)row * DM + col0; float ss = 0.f;
#pragma unroll
                for (int bj = 0; bj < 2; ++bj) { const f32x4 a0 = *(const f32x4*)(xio + o + bj * 128), a1 = *(const f32x4*)(xio + o + bj * 128 + 4);
                    const u32x4 ev = *(const u32x4*)(e + o + bj * 128);
                    const f32x4 e0 = {bflo(ev.x), bfhi(ev.x), bflo(ev.y), bfhi(ev.y)}, e1 = {bflo(ev.z), bfhi(ev.z), bflo(ev.w), bfhi(ev.w)};
                    const f32x4 v0 = a0 + e0 * sigm4(acc[ai][bj][m][0]), v1 = a1 + e1 * sigm4(acc[ai][bj][m][1]);
                    *(f32x4*)(xio + o + bj * 128) = v0; *(f32x4*)(xio + o + bj * 128 + 4) = v1;
                    if (NEXT) { *(u32x4*)(xb + o + bj * 128) = pk8(v0, v1);
                        ss += (v0[0] * v0[0] + v0[1] * v0[1]) + (v0[2] * v0[2] + v0[3] * v0[3]) + (v1[0] * v1[0] + v1[1] * v1[1]) + (v1[2] * v1[2] + v1[3] * v1[3]); } }
                if (NEXT) { ss += __shfl_xor(ss, 16); ss += __shfl_xor(ss, 32); if (fq == 0) ssp[(size_t)row * 16 + u.pn * 4 + wc] = ss; } }
    }
};
struct EpiKQZ {
    static constexpr bool PERM = true, AFTER_DRAIN = false;
    bf16_t *kk, *qq, *sz2; const float *rstd1, *k_norm, *q_norm;
    DI void operator()(AccRef acc, const Unit& u, int wr, int wc, int fr, int fq) const {
        const int row0 = u.pm * 256 + wr * 64 + fr, kind = u.pn >> 2, pq = u.pn & 3;
        if (kind == 2) {
            bf16_t* base = sz2 + pq * 256 + 64 * wc + 8 * fq;
#pragma unroll
            for (int ai = 0; ai < 2; ++ai)
#pragma unroll
                for (int m = 0; m < 4; ++m) { const int row = row0 + ai * 128 + m * 16; const float rs = rstd1[row]; bf16_t* rowp = base + (size_t)row * DM;
#pragma unroll
                    for (int bj = 0; bj < 2; ++bj) *(u32x4*)(rowp + bj * 32) = pk8(silu4(acc[ai][bj][m][0] * rs), silu4(acc[ai][bj][m][1] * rs)); }
        } else {
            const float* gn = kind ? q_norm : k_norm; const float mul = kind ? 0.125f * 1.4426950408889634f : 1.f;
            bf16_t* dst = kind ? qq : kk; const int head = pq * 4 + wc;
            f32x4 g[2][2];
#pragma unroll
            for (int bj = 0; bj < 2; ++bj)
#pragma unroll
                for (int n = 0; n < 2; ++n) g[bj][n] = *(const f32x4*)(gn + 32 * bj + 8 * fq + 4 * n) * mul;
#pragma unroll
            for (int ai = 0; ai < 2; ++ai)
#pragma unroll
                for (int m = 0; m < 4; ++m) { const int row = row0 + ai * 128 + m * 16; const float rs = rstd1[row]; const int b = row >> 11, s = row & 2047;
                    f32x4 v[2][2]; float ss = 0.f;
#pragma unroll
                    for (int bj = 0; bj < 2; ++bj)
#pragma unroll
                        for (int n = 0; n < 2; ++n) { v[bj][n] = acc[ai][bj][m][n] * rs; ss += (v[bj][n][0] * v[bj][n][0] + v[bj][n][1] * v[bj][n][1]) + (v[bj][n][2] * v[bj][n][2] + v[bj][n][3] * v[bj][n][3]); }
                    ss += __shfl_xor(ss, 16); ss += __shfl_xor(ss, 32);
                    const float hr = rsqrtf(ss * (1.f / 64.f) + EPS);
                    bf16_t* rowp = dst + ((size_t)(b * 16 + head) * SEQ + s) * 64 + 8 * fq;
#pragma unroll
                    for (int bj = 0; bj < 2; ++bj) *(u32x4*)(rowp + 32 * bj) = pk8(v[bj][0] * hr * g[bj][0], v[bj][1] * hr * g[bj][1]); }
        }
    }
};
struct EpiVT {
    static constexpr bool PERM = true, AFTER_DRAIN = false;
    bf16_t* vt; const float* rstd1;
    DI void operator()(AccRef acc, const Unit& u, int wr, int wc, int fr, int fq) const {
        const int c0 = u.pm * 256 + wr * 64 + fr, tok0 = u.pn * 256 + wc * 32 + 8 * fq;
        f32x4 rs[2][2];
#pragma unroll
        for (int bj = 0; bj < 2; ++bj)
#pragma unroll
            for (int n = 0; n < 2; ++n) rs[bj][n] = *(const f32x4*)(rstd1 + tok0 + 128 * bj + 4 * n);
#pragma unroll
        for (int ai = 0; ai < 2; ++ai)
#pragma unroll
            for (int m = 0; m < 4; ++m) { const int c = c0 + ai * 128 + m * 16;
#pragma unroll
                for (int bj = 0; bj < 2; ++bj) { const int tok = tok0 + 128 * bj, b = tok >> 11, s = tok & 2047;
                    *(u32x4*)(vt + ((size_t)b * DM + c) * SEQ + s) = pk8(acc[ai][bj][m][0] * rs[bj][0], acc[ai][bj][m][1] * rs[bj][1]); } }
    }
};
template <class Epi> DI void run_gemm(PG8_LAS unsigned char* lds, const bf16_t* A, const bf16_t* Bt, int M, int N, int K, const Epi& E) {
    pg8::Gemm g{A, Bt, M, N, K}; pg8::StaticOrder S; S.init(M, N, (int)gridDim.x, (int)blockIdx.x);
    pg8::gemm_phase<Epi, pg8::StaticOrder, false>(lds, g, S, E, nullptr);
}

DI int headperm(int cl) { const int o = cl & 255, wc = o >> 6, bj = (o >> 5) & 1, r = o & 31; return (cl & ~255) + 128 * bj + 32 * wc + r; }
DI void transpose_tile(float* T, const float* src, int ld, int K, int nT, const float* gain, bf16_t* dst, int rowoff, bool perm, int tile) {
    const int tid = threadIdx.x, kt = tile / nT, nt = tile - kt * nT, k0 = kt * 64, n0 = nt * 64;
    __syncthreads();
#pragma unroll
    for (int i = 0; i < 2; ++i) { const int idx = tid + 512 * i, kk = idx >> 4, n4 = idx & 15;
        const float4 v = *(const float4*)(src + (size_t)(k0 + kk) * ld + n0 + n4 * 4);
        float* t = T + kk * 65 + n4 * 4; t[0] = v.x; t[1] = v.y; t[2] = v.z; t[3] = v.w; }
    __syncthreads();
    const int n = tid >> 3, kc = tid & 7; float f[8];
#pragma unroll
    for (int i = 0; i < 8; ++i) { f[i] = T[(kc * 8 + i) * 65 + n]; if (gain) f[i] *= gain[k0 + kc * 8 + i]; }
    int row = rowoff + n0 + n; if (perm) row = headperm(row);
    u32x4 w; w.x = pk2(f[0], f[1]); w.y = pk2(f[2], f[3]); w.z = pk2(f[4], f[5]); w.w = pk2(f[6], f[7]);
    *(u32x4*)(dst + (size_t)row * K + k0 + kc * 8) = w;
}
DI void weff_job(float* L, const Params& P, bf16_t* dst, int job) {
    float* As = L; float* Bs = L + 64 * 129;
    const int tid = threadIdx.x, k0 = (job >> 4) * 64, n0 = (job & 15) * 64, g = n0 >> 8, d0 = n0 & 255, kk = tid >> 3, dg = tid & 7;
    float acc[8];
#pragma unroll
    for (int j = 0; j < 8; ++j) acc[j] = 0.f;
    for (int c0 = 0; c0 < 256; c0 += 128) {
        __syncthreads();
#pragma unroll
        for (int i = 0; i < 4; ++i) { const int idx = tid + 512 * i;
            { const int r = idx >> 5, c4 = idx & 31; const float4 v = *(const float4*)(P.a_w_in + (size_t)(k0 + r) * 2048 + g * 256 + c0 + c4 * 4);
              float* t = As + r * 129 + c4 * 4; t[0] = v.x; t[1] = v.y; t[2] = v.z; t[3] = v.w; }
            { const int cc = idx >> 4, d4 = idx & 15; *(float4*)(Bs + cc * 64 + d4 * 4) = *(const float4*)(P.a_w_group + (size_t)(g * 256 + c0 + cc) * 256 + d0 + d4 * 4); } }
        __syncthreads();
#pragma unroll 4
        for (int c = 0; c < 128; ++c) { const float a = As[kk * 129 + c]; const float4 b0 = *(const float4*)(Bs + c * 64 + dg * 8), b1 = *(const float4*)(Bs + c * 64 + dg * 8 + 4);
            acc[0] += a * b0.x; acc[1] += a * b0.y; acc[2] += a * b0.z; acc[3] += a * b0.w; acc[4] += a * b1.x; acc[5] += a * b1.y; acc[6] += a * b1.z; acc[7] += a * b1.w; }
    }
    const float an = P.a_norm[k0 + kk];
#pragma unroll
    for (int j = 0; j < 8; ++j) { const int n = n0 + dg * 8 + j; const float v = acc[j] * an * P.a_scale[n];
        dst[(size_t)n * DM + k0 + kk] = (bf16_t)(pk2(v, v) & 0xffffu); }
}
DI void phase0(const Params& P, float* L) {
    const int tid = threadIdx.x, wid = tid >> 6, lane = tid & 63, w = blockIdx.x, G = gridDim.x;
    unsigned char* ws = P.ws;
    { bf16_t* xb = (bf16_t*)(ws + OFF_R1); float* rstd0 = (float*)(ws + OFF_RSTD0);
      for (int row = w * 8 + wid; row < M_TOK; row += G * 8) {
          const float4* xr = (const float4*)(P.x + (size_t)row * DM) + lane; float4 v[4]; float s = 0.f;
#pragma unroll
          for (int j = 0; j < 4; ++j) { v[j] = xr[64 * j]; s += (v[j].x * v[j].x + v[j].y * v[j].y) + (v[j].z * v[j].z + v[j].w * v[j].w); }
          s = wave_sum(s);
          uint2* o = (uint2*)(xb + (size_t)row * DM) + lane;
#pragma unroll
          for (int j = 0; j < 4; ++j) { uint2 q; q.x = pk2(v[j].x, v[j].y); q.y = pk2(v[j].z, v[j].w); o[64 * j] = q; }
          if (lane == 0) rstd0[row] = rsqrtf(s * (1.f / DM) + EPS); } }
    { const float4* pp = (const float4*)P.p; u32x4* pb = (u32x4*)(ws + OFF_PB);
      for (int i = w * 512 + tid; i < 2 * M_TOK * 256 / 8; i += G * 512) { const float4 a = pp[2 * i], b = pp[2 * i + 1];
          u32x4 q; q.x = pk2(a.x, a.y); q.y = pk2(a.z, a.w); q.z = pk2(b.x, b.y); q.w = pk2(b.z, b.w); pb[i] = q; } }
    for (int job = w; job < 256; job += G) weff_job(L, P, (bf16_t*)(ws + OFF_WIN1), job);
    for (int t = w; t < 2432; t += G) {
        int r = t;
        if (r < 256) { transpose_tile(L, P.a_w_in + 1024, 2048, 1024, 16, P.a_norm, (bf16_t*)(ws + OFF_WIN1) + (size_t)1024 * 1024, 0, false, r); continue; } r -= 256;
        if (r < 256) { transpose_tile(L, P.a_w_out, 1024, 1024, 16, nullptr, (bf16_t*)(ws + OFF_WAOUT), 0, false, r); continue; } r -= 256;
        if (r < 64) { transpose_tile(L, P.ple_w, 1024, 256, 16, nullptr, (bf16_t*)(ws + OFF_WPLE0), 0, false, r); continue; } r -= 64;
        if (r < 64) { transpose_tile(L, P.ple_w + 256 * 1024, 1024, 256, 16, nullptr, (bf16_t*)(ws + OFF_WPLE1), 0, false, r); continue; } r -= 64;
        if (r < 256) { transpose_tile(L, P.ple_gate_w, 1024, 1024, 16, nullptr, (bf16_t*)(ws + OFF_WG0), 0, false, r); continue; } r -= 256;
        if (r < 256) { transpose_tile(L, P.ple_gate_w + 1024 * 1024, 1024, 1024, 16, nullptr, (bf16_t*)(ws + OFF_WG1), 0, false, r); continue; } r -= 256;
        if (r < 256) { transpose_tile(L, P.w_kv, 2048, 1024, 16, P.kv_norm, (bf16_t*)(ws + OFF_WKQZ), 0, true, r); continue; } r -= 256;
        if (r < 256) { transpose_tile(L, P.w_kv + 1024, 2048, 1024, 16, P.kv_norm, (bf16_t*)(ws + OFF_WV), 0, false, r); continue; } r -= 256;
        if (r < 512) { transpose_tile(L, P.b_w_in, 2048, 1024, 32, P.b_norm, (bf16_t*)(ws + OFF_WKQZ), 1024, true, r); continue; } r -= 512;
        transpose_tile(L, P.b_w_out, 1024, 1024, 16, nullptr, (bf16_t*)(ws + OFF_WBOUT), 0, false, r);
    }
}
DI void unpack8(const u32x4 q, float (&f)[8]) { f[0] = bflo(q.x); f[1] = bfhi(q.x); f[2] = bflo(q.y); f[3] = bfhi(q.y); f[4] = bflo(q.z); f[5] = bfhi(q.z); f[6] = bflo(q.w); f[7] = bfhi(q.w); }
DI void pool_phase(const Params& P) {
    const bf16_t* ug = (const bf16_t*)(P.ws + OFF_R2); const bf16_t* sz = (const bf16_t*)(P.ws + OFF_R3); bf16_t* Gd = (bf16_t*)(P.ws + OFF_R1);
    const int nth = gridDim.x * 512;
    for (int idx = blockIdx.x * 512 + threadIdx.x; idx < 131072; idx += nth) {
        const int chunk = idx & 127, run = idx >> 7, row0 = run * 16, t0 = row0 & (SEQ - 1), c0 = chunk * 8, wlen = 2 << (chunk >> 5);
        const u32x4* up = (const u32x4*)(ug + (size_t)row0 * DM + c0); const u32x4* zp = (const u32x4*)(sz + (size_t)row0 * DM + c0); u32x4* gp = (u32x4*)(Gd + (size_t)row0 * DM + c0);
        float s[8], c[8], z[8];
#pragma unroll
        for (int j = 0; j < 8; ++j) s[j] = 0.f;
        if (t0 > 0) for (int j = 1; j <= wlen; ++j) { unpack8(up[-(j * 128)], c);
#pragma unroll
            for (int q = 0; q < 8; ++q) s[q] += c[q]; }
        const float inv_full = 1.f / (float)wlen;
        for (int rr = 0; rr < 16; ++rr) {
            const int t = t0 + rr;
            if (t >= wlen) { unpack8(up[(rr - wlen) * 128], c);
#pragma unroll
                for (int q = 0; q < 8; ++q) s[q] -= c[q]; }
            unpack8(up[rr * 128], c); unpack8(zp[rr * 128], z);
            const float inv = (t + 1 < wlen) ? 1.f / (float)(t + 1) : inv_full;
            float o[8];
#pragma unroll
            for (int q = 0; q < 8; ++q) { s[q] += c[q]; o[q] = (s[q] * inv - c[q]) * z[q]; }
            u32x4 w; w.x = pk2(o[0], o[1]); w.y = pk2(o[2], o[3]); w.z = pk2(o[4], o[5]); w.w = pk2(o[6], o[7]); gp[rr * 128] = w;
        }
    }
}
#define MFMA32(a, b, c) __builtin_amdgcn_mfma_f32_32x32x16_bf16((a), (b), (c), 0, 0, 0)
DI void attn_phase(const Params& P) {
    const bf16_t* kk = (const bf16_t*)(P.ws + OFF_R1); const bf16_t* qq = (const bf16_t*)(P.ws + OFF_R2); const bf16_t* vt = (const bf16_t*)(P.ws + OFF_R4);
    const bf16_t* sz2 = (const bf16_t*)(P.ws + OFF_R4 + 32 * MiB); bf16_t* g2 = (bf16_t*)(P.ws + OFF_R3);
    const int tid = threadIdx.x, wid = tid >> 6, lane = tid & 63, r = lane & 31, hh = lane >> 5, NGW = gridDim.x * 8;
    for (int item = blockIdx.x * 8 + wid; item < 8192; item += NGW) {
        const int qt = item & 63, bh = item >> 6, t0 = qt * 32;
        const bf16_t* Qp = qq + ((size_t)bh * SEQ + t0 + r) * 64 + hh * 8; const bf16_t* Kp = kk + ((size_t)bh * SEQ + r) * 64 + hh * 8;
        const bf16_t* Vp = vt + ((size_t)bh * 64 + r) * SEQ + 4 * hh;
        s16x8 qf[4];
#pragma unroll
        for (int ks = 0; ks < 4; ++ks) qf[ks] = *(const s16x8*)(Qp + ks * 16);
        f32x16 o0, o1;
#pragma unroll
        for (int i = 0; i < 16; ++i) { o0[i] = 0.f; o1[i] = 0.f; }
        float carry = 1.f;
        s16x8 kf[4]; s16x4 vf[2][2][2];
#pragma unroll
        for (int ks = 0; ks < 4; ++ks) kf[ks] = *(const s16x8*)(Kp + (size_t)t0 * 64 + ks * 16);
#pragma unroll
        for (int dt = 0; dt < 2; ++dt)
#pragma unroll
            for (int s = 0; s < 2; ++s)
#pragma unroll
                for (int pt = 0; pt < 2; ++pt) vf[dt][s][pt] = *(const s16x4*)(Vp + (size_t)dt * 32 * SEQ + t0 + 16 * s + 8 * pt);
        for (int kb = qt; kb >= 0; --kb) {
            s16x8 kn[4]; s16x4 vn[2][2][2];
            const int sn = (kb > 0 ? kb - 1 : 0) * 32;
#pragma unroll
            for (int ks = 0; ks < 4; ++ks) kn[ks] = *(const s16x8*)(Kp + (size_t)sn * 64 + ks * 16);
#pragma unroll
            for (int dt = 0; dt < 2; ++dt)
#pragma unroll
                for (int s = 0; s < 2; ++s)
#pragma unroll
                    for (int pt = 0; pt < 2; ++pt) vn[dt][s][pt] = *(const s16x4*)(Vp + (size_t)dt * 32 * SEQ + sn + 16 * s + 8 * pt);
            f32x16 x;
#pragma unroll
            for (int i = 0; i < 16; ++i) x[i] = 0.f;
#pragma unroll
            for (int ks = 0; ks < 4; ++ks) x = MFMA32(kf[ks], qf[ks], x);
            float beta[16], keep[16];
            const bool diag = (kb == qt);
#pragma unroll
            for (int i = 0; i < 16; ++i) {
                const float l = fminf(fmaxf(x[i], -100.f), 100.f);
                const float e = __builtin_amdgcn_exp2f(-l);
                float b = __builtin_amdgcn_rcpf(1.f + e), kp = e * b;
                if (diag) { const bool valid = ((i & 3) + 8 * (i >> 2) + 4 * hh) < r; b = valid ? b : 0.f; kp = valid ? kp : 1.f; }
                beta[i] = b; keep[i] = kp;
            }
            float Gp[4], PG[4];
#pragma unroll
            for (int g = 0; g < 4; ++g) { Gp[g] = (keep[4 * g] * keep[4 * g + 1]) * (keep[4 * g + 2] * keep[4 * g + 3]); PG[g] = __shfl_xor(Gp[g], 32); }
            float base[4];
            { float so = 1.f, sp = 1.f;
#pragma unroll
              for (int g = 3; g >= 0; --g) { base[g] = carry * so * sp * (hh == 0 ? PG[g] : 1.f); so *= Gp[g]; sp *= PG[g]; }
              carry = carry * so * sp; }
            float a[16];
#pragma unroll
            for (int g = 0; g < 4; ++g) { float run = base[g];
                a[4 * g + 3] = beta[4 * g + 3] * run; run *= keep[4 * g + 3];
                a[4 * g + 2] = beta[4 * g + 2] * run; run *= keep[4 * g + 2];
                a[4 * g + 1] = beta[4 * g + 1] * run; run *= keep[4 * g + 1];
                a[4 * g] = beta[4 * g] * run; }
#pragma unroll
            for (int s = 0; s < 2; ++s) {
                u32x4 pw; pw.x = pk2(a[8 * s], a[8 * s + 1]); pw.y = pk2(a[8 * s + 2], a[8 * s + 3]); pw.z = pk2(a[8 * s + 4], a[8 * s + 5]); pw.w = pk2(a[8 * s + 6], a[8 * s + 7]);
                const s16x8 pf = __builtin_bit_cast(s16x8, pw);
                const s16x8 va = __builtin_shufflevector(vf[0][s][0], vf[0][s][1], 0, 1, 2, 3, 4, 5, 6, 7);
                const s16x8 vb = __builtin_shufflevector(vf[1][s][0], vf[1][s][1], 0, 1, 2, 3, 4, 5, 6, 7);
                o0 = MFMA32(va, pf, o0); o1 = MFMA32(vb, pf, o1);
            }
            if (__all(carry < 1e-30f)) break;
#pragma unroll
            for (int ks = 0; ks < 4; ++ks) kf[ks] = kn[ks];
#pragma unroll
            for (int dt = 0; dt < 2; ++dt)
#pragma unroll
                for (int s = 0; s < 2; ++s)
#pragma unroll
                    for (int pt = 0; pt < 2; ++pt) vf[dt][s][pt] = vn[dt][s][pt];
        }
        const int b = bh >> 4, h = bh & 15; const size_t rowo = ((size_t)b * SEQ + t0 + r) * DM + h * 64 + 4 * hh;
#pragma unroll
        for (int g = 0; g < 4; ++g) {
            const uint2 z0 = *(const uint2*)(sz2 + rowo + 8 * g), z1 = *(const uint2*)(sz2 + rowo + 32 + 8 * g);
            uint2 w0, w1;
            w0.x = pk2(o0[4 * g] * bflo(z0.x), o0[4 * g + 1] * bfhi(z0.x)); w0.y = pk2(o0[4 * g + 2] * bflo(z0.y), o0[4 * g + 3] * bfhi(z0.y));
            w1.x = pk2(o1[4 * g] * bflo(z1.x), o1[4 * g + 1] * bfhi(z1.x)); w1.y = pk2(o1[4 * g + 2] * bflo(z1.y), o1[4 * g + 3] * bfhi(z1.y));
            *(uint2*)(g2 + rowo + 8 * g) = w0; *(uint2*)(g2 + rowo + 32 + 8 * g) = w1;
        }
    }
}

__global__ __launch_bounds__(512, 2) void yoco_fwd(Params P) {
    extern __shared__ __attribute__((aligned(16))) unsigned char shm[];
    cg::grid_group grid = cg::this_grid();
    PG8_LAS unsigned char* lds = (PG8_LAS unsigned char*)shm;
    unsigned char* ws = P.ws;
    bf16_t* R1 = (bf16_t*)(ws + OFF_R1); bf16_t* R2 = (bf16_t*)(ws + OFF_R2); bf16_t* R3 = (bf16_t*)(ws + OFF_R3); bf16_t* R4 = (bf16_t*)(ws + OFF_R4);
    float* rstd0 = (float*)(ws + OFF_RSTD0); float* rstd1 = (float*)(ws + OFF_RSTD1); float* ssp = (float*)(ws + OFF_SSP);
    const bf16_t* pb = (const bf16_t*)(ws + OFF_PB);
#define PH(k) if (P.ph_lo <= (k) && (k) < P.ph_hi)
#define SYNC(k) if (P.ph_lo <= (k) && (k) + 1 < P.ph_hi) grid.sync();
    PH(0) phase0(P, (float*)shm);
    SYNC(0)
    PH(1) { Epi1 E{R2, R3, rstd0}; run_gemm(lds, R1, (const bf16_t*)(ws + OFF_WIN1), M_TOK, 2048, 1024, E); }
    SYNC(1)
    PH(2) pool_phase(P);
    SYNC(2)
    PH(3) { EpiRes E{P.x, P.out, R2}; run_gemm(lds, R1, (const bf16_t*)(ws + OFF_WAOUT), M_TOK, 1024, 1024, E); }
    SYNC(3)
    PH(4) { EpiE E0{R1}; run_gemm(lds, pb, (const bf16_t*)(ws + OFF_WPLE0), M_TOK, 1024, 256, E0);
            EpiGate<true> E1{P.out, R1, R3, ssp}; run_gemm(lds, R2, (const bf16_t*)(ws + OFF_WG0), M_TOK, 1024, 1024, E1); }
    SYNC(4)
    PH(5) { for (int i = blockIdx.x * 512 + threadIdx.x; i < M_TOK; i += gridDim.x * 512) { const float4* q = (const float4*)(ssp + (size_t)i * 16);
                const float4 a = q[0], b = q[1], c = q[2], d = q[3];
                const float s = ((a.x + a.y) + (a.z + a.w)) + ((b.x + b.y) + (b.z + b.w)) + ((c.x + c.y) + (c.z + c.w)) + ((d.x + d.y) + (d.z + d.w));
                rstd1[i] = rsqrtf(s * (1.f / DM) + EPS); } }
    SYNC(5)
    PH(6) { EpiKQZ E0{R1, R2, R4 + (size_t)M_TOK * DM, rstd1, P.k_norm, P.b_q_norm}; run_gemm(lds, R3, (const bf16_t*)(ws + OFF_WKQZ), M_TOK, 3072, 1024, E0);
            EpiVT E1{R4, rstd1}; run_gemm(lds, (const bf16_t*)(ws + OFF_WV), R3, 1024, M_TOK, 1024, E1); }
    SYNC(6)
    PH(7) attn_phase(P);
    SYNC(7)
    PH(8) { EpiRes E{P.out, P.out, R2}; run_gemm(lds, R3, (const bf16_t*)(ws + OFF_WBOUT), M_TOK, 1024, 1024, E); }
    SYNC(8)
    PH(9) { EpiE E0{R1}; run_gemm(lds, pb + (size_t)M_TOK * 256, (const bf16_t*)(ws + OFF_WPLE1), M_TOK, 1024, 256, E0);
            EpiGate<false> E1{P.out, R1, nullptr, nullptr}; run_gemm(lds, R2, (const bf16_t*)(ws + OFF_WG1), M_TOK, 1024, 1024, E1); }
}

extern "C" void kernel_launch(void* const* d_in, const int* in_sizes, int n_in, void* d_out, int out_size, void* d_ws, size_t ws_size, hipStream_t stream) {
    static int grid = 0;
    if (grid == 0) {
        int dev = 0, cus = 0, per_cu = 0;
        if (n_in != 16 || out_size != M_TOK * DM || ws_size < WS_END) { fprintf(stderr, "kernel_launch: unexpected shapes (n_in %d out %d ws %zu)\n", n_in, out_size, ws_size); grid = -1; return; }
        (void)hipGetDevice(&dev); (void)hipDeviceGetAttribute(&cus, hipDeviceAttributeMultiprocessorCount, dev);
        if (hipFuncSetAttribute((const void*)yoco_fwd, hipFuncAttributeMaxDynamicSharedMemorySize, LDS_BYTES) != hipSuccess) { fprintf(stderr, "kernel_launch: hipFuncSetAttribute failed\n"); grid = -1; return; }
        (void)hipOccupancyMaxActiveBlocksPerMultiprocessor(&per_cu, (const void*)yoco_fwd, 512, LDS_BYTES);
        if (per_cu < 1) { fprintf(stderr, "kernel_launch: occupancy query says %d blocks per CU\n", per_cu); (void)hipGetLastError(); per_cu = 1; }
        grid = cus;
    }
    if (grid < 0) return;
    Params p{};
    const float** pp = (const float**)&p;
    for (int i = 0; i < 16; ++i) pp[i] = (const float*)d_in[i];
    p.out = (float*)d_out; p.ws = (unsigned char*)d_ws;
#if SPLIT_LAUNCH
    for (int ph = 0; ph < NPHASE; ++ph) { p.ph_lo = ph; p.ph_hi = ph + 1; hipLaunchKernelGGL(yoco_fwd, dim3(grid), dim3(512), LDS_BYTES, stream, p); }
#else
    p.ph_lo = 0; p.ph_hi = NPHASE;
    void* args[] = {&p};
    hipError_t e = hipLaunchCooperativeKernel((const void*)yoco_fwd, dim3(grid), dim3(512), args, LDS_BYTES, stream);
    if (e != hipSuccess) fprintf(stderr, "kernel_launch: cooperative launch failed: %s (grid %d)\n", hipGetErrorString(e), grid);
#endif
}
```

```cpp
#include <hip/hip_runtime.h>
#include <cstdio>
namespace pg8 {
#define PG8_LAS __attribute__((address_space(3)))
typedef unsigned short bf16_t;
typedef short bf16x8 __attribute__((ext_vector_type(8)));
typedef float f32x4 __attribute__((ext_vector_type(4)));
typedef unsigned u32x4 __attribute__((ext_vector_type(4)));
constexpr int BM = 256, BK = 64, HALF = 128, HTB = HALF * BK * 2  , STAGE_BYTES = 8 * HTB, NXCD = 8, WGM = 8;

__host__ __device__ __forceinline__ int lds_byte(int r, int c) { const int st = (r >> 4) * 2 + (c >> 5), rr = r & 15, cc = c & 31, ob = rr * 64 + cc * 2; return st * 1024 + (ob ^ (((ob >> 9) & 1) << 5)); }
__host__ __device__ __forceinline__ void stage_rc(int b, int& R, int& C) { const int st = b / 1024, sb = b % 1024, swz = sb ^ (((sb >> 9) & 1) << 5); R = (st >> 1) * 16 + swz / 64; C = (st & 1) * 32 + (swz % 64) / 2; }
__host__ __device__ __forceinline__ int perm32(int rho) { const int n = rho >> 4, i = rho & 15; return 8 * (i >> 2) + 4 * n + (i & 3); }

struct Unit { int pm, pn; };
struct Gemm { const bf16_t* A; const bf16_t* Bt; int M, N, K; };
struct StaticOrder {
    int nM, nN, nwg, G, c;
    __host__ __device__ void init(int M, int N, int G_, int c_) { nM = M / BM; nN = N / BM; nwg = nM * nN; G = G_; c = c_; }
    __host__ __device__ bool next(int i, Unit& u) const {
        const long L = (long)i * G + c; if (L >= nwg) return false;
        int wgid = (int)L; { const int q = nwg / NXCD, r = nwg % NXCD, xcd = wgid % NXCD, off = wgid / NXCD; wgid = (xcd < r ? xcd * (q + 1) : r * (q + 1) + (xcd - r) * q) + off; }
        const int nig = WGM * nN, gid = wgid / nig, fm = gid * WGM, gsz = (nM - fm) < WGM ? (nM - fm) : WGM;
        u.pm = fm + ((wgid % nig) % gsz); u.pn = (wgid % nig) / gsz; return true;
    }
    __device__ __forceinline__ void a_ready(const Unit&) const {}
    __device__ __forceinline__ void done(const Unit&) const {}
};
template <class Epi, class Sched, bool STAMP = false>
__device__ __forceinline__ void gemm_phase(PG8_LAS unsigned char* lds, const Gemm g, const Sched& S, const Epi& E, unsigned long long* stamps) {
    const int tid = threadIdx.x, wid = __builtin_amdgcn_readfirstlane(tid >> 6), lane = tid & 63, wr = wid >> 2, wc = wid & 3, fr = lane & 15, fq = lane >> 4;
    const int K = g.K, nt = K / BK;
    int ts_lo = 0, ts_hi = 0, nts = 0; const unsigned long long rt_entry = STAMP ? (unsigned long long)wall_clock64() : 0ull;
#define PG8_STAMP() do { if (STAMP && wid == 0 && nts < 64) { const unsigned long long _c = (unsigned long long)clock64(); \
        ts_lo = (lane == nts) ? (int)(unsigned)_c : ts_lo; ts_hi = (lane == nts) ? (int)(unsigned)(_c >> 32) : ts_hi; ++nts; } } while (0)
    PG8_STAMP();
    unsigned voffA[2], voffB[2];
#pragma unroll
    for (int i = 0; i < 2; ++i) { int R, C; stage_rc(tid * 16 + i * 8192, R, C); const int Rb = Epi::PERM ? ((R & ~31) + perm32(R & 31)) : R;
        voffA[i] = (unsigned)(R * K + C) * 2u; voffB[i] = (unsigned)(Rb * K + C) * 2u; }
    const size_t kstep = (size_t)(BK * 2);
    const size_t hstep = (size_t)HALF * K * 2;
    const size_t tstep = 2 * hstep;
    const unsigned ldsw = (unsigned)wid * 1024u;
    const int aoff = lds_byte(wr * 64 + fr, fq * 8), boff = lds_byte(wc * 32 + fr, fq * 8);
#define PG8_SA(b, h) (((b) * 2 + (h)) * HTB)
#define PG8_SB(b, h) ((4 + (b) * 2 + (h)) * HTB)
#define PG8_STAGE(bufoff, gbase, voff) do { _Pragma("unroll") for (int _i = 0; _i < 2; ++_i) \
        __builtin_amdgcn_global_load_lds((const unsigned*)((const char*)(gbase) + (voff)[_i]), (PG8_LAS unsigned*)(lds + (bufoff) + ldsw + _i * 8192), 16, 0, 0); } while (0)
#define PG8_LDA(dst, b, h) do { _Pragma("unroll") for (int m = 0; m < 4; ++m) _Pragma("unroll") for (int k = 0; k < 2; ++k) dst[m][k] = *(const PG8_LAS bf16x8*)(lds + PG8_SA(b, h) + aoff + m * 2048 + k * 1024); } while (0)
#define PG8_LDB(dst, b, h) do { _Pragma("unroll") for (int n = 0; n < 2; ++n) _Pragma("unroll") for (int k = 0; k < 2; ++k) dst[n][k] = *(const PG8_LAS bf16x8*)(lds + PG8_SB(b, h) + boff + n * 2048 + k * 1024); } while (0)
#define PG8_MMA(ai, bj, At, Bt) do { __builtin_amdgcn_s_setprio(1); _Pragma("unroll") for (int m = 0; m < 4; ++m) _Pragma("unroll") for (int n = 0; n < 2; ++n) _Pragma("unroll") for (int k = 0; k < 2; ++k) \
        acc[ai][bj][m][n] = __builtin_amdgcn_mfma_f32_16x16x32_bf16(Bt[n][k], At[m][k], acc[ai][bj][m][n], 0, 0, 0); __builtin_amdgcn_s_setprio(0); } while (0)
#define PG8_WAIT_V(n) asm volatile("s_waitcnt vmcnt(" #n ")" ::: "memory")
#define PG8_WAIT_L(n) asm volatile("s_waitcnt lgkmcnt(" #n ")" ::: "memory")
#define PG8_BAR __builtin_amdgcn_s_barrier()
#define PG8_SCHED __builtin_amdgcn_sched_barrier(0)
    Unit cur, nxt; int ui = 0;
    if (!S.next(0, cur)) return;
    f32x4 acc[2][2][4][2];
#pragma unroll
    for (int a = 0; a < 2; ++a)
#pragma unroll
        for (int b = 0; b < 2; ++b)
#pragma unroll
            for (int m = 0; m < 4; ++m)
#pragma unroll
                for (int n = 0; n < 2; ++n) acc[a][b][m][n] = (f32x4){0.f, 0.f, 0.f, 0.f};
    bf16x8 At[4][2], B0[2][2], B1[2][2];
    const char* cA = (const char*)g.A + (size_t)cur.pm * tstep; const char* cB = (const char*)g.Bt + (size_t)cur.pn * tstep;
    S.a_ready(cur);
    PG8_STAGE(PG8_SB(0, 0), cB, voffB); PG8_STAGE(PG8_SA(0, 0), cA, voffA); PG8_STAGE(PG8_SB(0, 1), cB + hstep, voffB); PG8_STAGE(PG8_SA(0, 1), cA + hstep, voffA);
    if (wr == 1) PG8_BAR;
    PG8_WAIT_V(4); PG8_BAR;
    PG8_STAGE(PG8_SB(1, 0), cB + kstep, voffB); PG8_STAGE(PG8_SA(1, 0), cA + kstep, voffA); PG8_STAGE(PG8_SB(1, 1), cB + hstep + kstep, voffB);
    PG8_WAIT_V(6); PG8_BAR;
    PG8_STAMP();
    for (;;) {
        const bool has_next = S.next(ui + 1, nxt);
        const char* nA = has_next ? (const char*)g.A + (size_t)nxt.pm * tstep : cA; const char* nB = has_next ? (const char*)g.Bt + (size_t)nxt.pn * tstep : cB;
        for (int t = 0; t < nt; t += 2) {
            const bool last = (t == nt - 2);
            const char* a1 = cA + (size_t)(t + 1) * kstep;
            const char* a2 = last ? nA : cA + (size_t)(t + 2) * kstep; const char* b2 = last ? nB : cB + (size_t)(t + 2) * kstep;
            const char* a3 = a2 + kstep; const char* b3 = b2 + kstep;
            if (last && has_next) S.a_ready(nxt);
            PG8_LDB(B0, 0, 0); PG8_SCHED; PG8_LDA(At, 0, 0); PG8_STAGE(PG8_SA(1, 1), a1 + hstep, voffA);
            PG8_WAIT_L(8); PG8_BAR; PG8_WAIT_L(0); PG8_MMA(0, 0, At, B0); PG8_BAR; PG8_SCHED;
            PG8_LDB(B1, 0, 1); PG8_STAGE(PG8_SB(0, 0), b2, voffB);
            PG8_BAR; PG8_WAIT_L(0); PG8_MMA(0, 1, At, B1); PG8_BAR;
            PG8_LDA(At, 0, 1); PG8_STAGE(PG8_SA(0, 0), a2, voffA);
            PG8_BAR; PG8_WAIT_L(0); PG8_MMA(1, 0, At, B0); PG8_BAR; PG8_SCHED;
            PG8_STAGE(PG8_SB(0, 1), b2 + hstep, voffB);
            PG8_WAIT_V(6); PG8_BAR; PG8_MMA(1, 1, At, B1); PG8_BAR;
            PG8_LDB(B0, 1, 0); PG8_SCHED; PG8_LDA(At, 1, 0); PG8_STAGE(PG8_SA(0, 1), a2 + hstep, voffA);
            PG8_WAIT_L(8); PG8_BAR; PG8_WAIT_L(0); PG8_MMA(0, 0, At, B0); PG8_BAR; PG8_SCHED;
            PG8_LDB(B1, 1, 1); PG8_STAGE(PG8_SB(1, 0), b3, voffB);
            PG8_BAR; PG8_WAIT_L(0); PG8_MMA(0, 1, At, B1); PG8_BAR;
            PG8_LDA(At, 1, 1); PG8_STAGE(PG8_SA(1, 0), a3, voffA);
            PG8_BAR; PG8_WAIT_L(0); PG8_MMA(1, 0, At, B0); PG8_BAR; PG8_SCHED;
            PG8_STAGE(PG8_SB(1, 1), b3 + hstep, voffB);
            PG8_WAIT_V(6); PG8_BAR; PG8_MMA(1, 1, At, B1); PG8_BAR;
        }
        PG8_STAMP();
        if constexpr (!Epi::AFTER_DRAIN) { E(acc, cur, wr, wc, fr, fq); S.done(cur); }
        PG8_STAMP();
        if (!has_next) break;
#pragma unroll
        for (int a = 0; a < 2; ++a)
#pragma unroll
            for (int b = 0; b < 2; ++b)
#pragma unroll
                for (int m = 0; m < 4; ++m)
#pragma unroll
                    for (int n = 0; n < 2; ++n) acc[a][b][m][n] = (f32x4){0.f, 0.f, 0.f, 0.f};
        cur = nxt; cA = nA; cB = nB; ++ui;
    }
    PG8_WAIT_V(0);
    if (wr == 0) PG8_BAR;
    PG8_BAR;
    if constexpr (Epi::AFTER_DRAIN) { E.fused(acc, cur, wr, wc, fr, fq, lds, wid, lane); S.done(cur); }
    PG8_STAMP();
    if (STAMP && wid == 0) { stamps[lane] = lane < nts ? (((unsigned long long)(unsigned)ts_hi << 32) | (unsigned)ts_lo) : 0ull;
        if (lane == 62) stamps[62] = rt_entry; if (lane == 63) stamps[63] = (unsigned long long)wall_clock64(); }
#undef PG8_STAMP
#undef PG8_SA
#undef PG8_SB
#undef PG8_STAGE
#undef PG8_LDA
#undef PG8_LDB
#undef PG8_MMA
#undef PG8_WAIT_V
#undef PG8_WAIT_L
#undef PG8_BAR
#undef PG8_SCHED
}
}
namespace pg8 {
struct UnitX { int pm, pn, kind; };
struct GDesc { const bf16_t* A; const bf16_t* Bt; int ks; };
__device__ __forceinline__ void map_unit(int L, int nM, int nN, int& pm, int& pn) {
    const int nwg = nM * nN; int wgid = L; { const int q = nwg / NXCD, r = nwg % NXCD, xcd = wgid % NXCD, off = wgid / NXCD; wgid = (xcd < r ? xcd * (q + 1) : r * (q + 1) + (xcd - r) * q) + off; }
    const int nig = WGM * nN, gid = wgid / nig, fm = gid * WGM, gsz = (nM - fm) < WGM ? (nM - fm) : WGM;
    pm = fm + ((wgid % nig) % gsz); pn = (wgid % nig) / gsz;
}
template <class Epi, class Sched>
__device__ __forceinline__ void gemm_stream(PG8_LAS unsigned char* lds, const Sched& S, const Epi& E) {
    const int tid = threadIdx.x, wid = __builtin_amdgcn_readfirstlane(tid >> 6), lane = tid & 63, wr = wid >> 2, wc = wid & 3, fr = lane & 15, fq = lane >> 4;
    const size_t kstep = (size_t)(BK * 2);
    const unsigned ldsw = (unsigned)wid * 1024u;
    const int aoff = lds_byte(wr * 64 + fr, fq * 8), boff = lds_byte(wc * 32 + fr, fq * 8);
#define PG8_SA(b, h) (((b) * 2 + (h)) * HTB)
#define PG8_SB(b, h) ((4 + (b) * 2 + (h)) * HTB)
#define PG8_STAGE(bufoff, gbase, voff) do { _Pragma("unroll") for (int _i = 0; _i < 2; ++_i) \
        __builtin_amdgcn_global_load_lds((const unsigned*)((const char*)(gbase) + (voff)[_i]), (PG8_LAS unsigned*)(lds + (bufoff) + ldsw + _i * 8192), 16, 0, 0); } while (0)
#define PG8_LDA(dst, b, h) do { _Pragma("unroll") for (int m = 0; m < 4; ++m) _Pragma("unroll") for (int k = 0; k < 2; ++k) dst[m][k] = *(const PG8_LAS bf16x8*)(lds + PG8_SA(b, h) + aoff + m * 2048 + k * 1024); } while (0)
#define PG8_LDB(dst, b, h) do { _Pragma("unroll") for (int n = 0; n < 2; ++n) _Pragma("unroll") for (int k = 0; k < 2; ++k) dst[n][k] = *(const PG8_LAS bf16x8*)(lds + PG8_SB(b, h) + boff + n * 2048 + k * 1024); } while (0)
#define PG8_MMA(ai, bj, At, Bt) do { __builtin_amdgcn_s_setprio(1); _Pragma("unroll") for (int m = 0; m < 4; ++m) _Pragma("unroll") for (int n = 0; n < 2; ++n) _Pragma("unroll") for (int k = 0; k < 2; ++k) \
        acc[ai][bj][m][n] = __builtin_amdgcn_mfma_f32_16x16x32_bf16(Bt[n][k], At[m][k], acc[ai][bj][m][n], 0, 0, 0); __builtin_amdgcn_s_setprio(0); } while (0)
#define PG8_WAIT_V(n) asm volatile("s_waitcnt vmcnt(" #n ")" ::: "memory")
#define PG8_WAIT_L(n) asm volatile("s_waitcnt lgkmcnt(" #n ")" ::: "memory")
#define PG8_BAR __builtin_amdgcn_s_barrier()
#define PG8_SCHED __builtin_amdgcn_sched_barrier(0)
    UnitX cur, nxt; int ui = 0;
    if (!S.next(0, cur)) return;
    f32x4 acc[2][2][4][2];
#pragma unroll
    for (int a = 0; a < 2; ++a)
#pragma unroll
        for (int b = 0; b < 2; ++b)
#pragma unroll
            for (int m = 0; m < 4; ++m)
#pragma unroll
                for (int n = 0; n < 2; ++n) acc[a][b][m][n] = (f32x4){0.f, 0.f, 0.f, 0.f};
    bf16x8 At[4][2], B0[2][2], B1[2][2];
    GDesc dc = S.desc(cur.kind);
    int ksC = dc.ks; size_t hsC = (size_t)HALF * ksC * 2;
    unsigned vAc[2], vBc[2];
#pragma unroll
    for (int i = 0; i < 2; ++i) { int R, C; stage_rc(tid * 16 + i * 8192, R, C); const int Rb = (R & ~31) + perm32(R & 31);
        vAc[i] = (unsigned)(R * ksC + C) * 2u; vBc[i] = (unsigned)(Rb * ksC + C) * 2u; }
    int shC = 31 - __builtin_clz((unsigned)ksC * 2u);
    const char* cA = (const char*)dc.A + (size_t)cur.pm * 2 * hsC; const char* cB = (const char*)dc.Bt + (size_t)cur.pn * 2 * hsC;
    PG8_STAGE(PG8_SB(0, 0), cB, vBc); PG8_STAGE(PG8_SA(0, 0), cA, vAc); PG8_STAGE(PG8_SB(0, 1), cB + hsC, vBc); PG8_STAGE(PG8_SA(0, 1), cA + hsC, vAc);
    if (wr == 1) PG8_BAR;
    PG8_WAIT_V(4); PG8_BAR;
    PG8_STAGE(PG8_SB(1, 0), cB + kstep, vBc); PG8_STAGE(PG8_SA(1, 0), cA + kstep, vAc); PG8_STAGE(PG8_SB(1, 1), cB + hsC + kstep, vBc);
    PG8_WAIT_V(6); PG8_BAR;
    for (;;) {
        const bool has_next = S.next(ui + 1, nxt);
        const char* nA = cA; const char* nB = cB; int ksN = ksC; size_t hsN = hsC;
        if (has_next) { const GDesc dn = S.desc(nxt.kind); ksN = dn.ks; hsN = (size_t)HALF * ksN * 2;
            nA = (const char*)dn.A + (size_t)nxt.pm * 2 * hsN; nB = (const char*)dn.Bt + (size_t)nxt.pn * 2 * hsN; }
        const int shN = 31 - __builtin_clz((unsigned)ksN * 2u); const unsigned cmask = (unsigned)ksC * 2u - 1u;
        const int nt = ksC / BK;
        for (int t = 0; t < nt; t += 2) {
            const bool last = (t == nt - 2);
            const char* a1 = cA + (size_t)(t + 1) * kstep;
            const char* a2 = last ? nA : cA + (size_t)(t + 2) * kstep; const char* b2 = last ? nB : cB + (size_t)(t + 2) * kstep;
            const char* a3 = a2 + kstep; const char* b3 = b2 + kstep;
            const size_t hs2 = last ? hsN : hsC;
            unsigned vA2[2], vB2[2];
#pragma unroll
            for (int i = 0; i < 2; ++i) { vA2[i] = last ? (((vAc[i] >> shC) << shN) | (vAc[i] & cmask)) : vAc[i]; vB2[i] = last ? (((vBc[i] >> shC) << shN) | (vBc[i] & cmask)) : vBc[i]; }
            PG8_LDB(B0, 0, 0); PG8_SCHED; PG8_LDA(At, 0, 0); PG8_STAGE(PG8_SA(1, 1), a1 + hsC, vAc);
            PG8_WAIT_L(8); PG8_BAR; PG8_WAIT_L(0); PG8_MMA(0, 0, At, B0); PG8_BAR; PG8_SCHED;
            PG8_LDB(B1, 0, 1); PG8_STAGE(PG8_SB(0, 0), b2, vB2);
            PG8_BAR; PG8_WAIT_L(0); PG8_MMA(0, 1, At, B1); PG8_BAR;
            PG8_LDA(At, 0, 1); PG8_STAGE(PG8_SA(0, 0), a2, vA2);
            PG8_BAR; PG8_WAIT_L(0); PG8_MMA(1, 0, At, B0); PG8_BAR; PG8_SCHED;
            PG8_STAGE(PG8_SB(0, 1), b2 + hs2, vB2);
            PG8_WAIT_V(6); PG8_BAR; PG8_MMA(1, 1, At, B1); PG8_BAR;
            PG8_LDB(B0, 1, 0); PG8_SCHED; PG8_LDA(At, 1, 0); PG8_STAGE(PG8_SA(0, 1), a2 + hs2, vA2);
            PG8_WAIT_L(8); PG8_BAR; PG8_WAIT_L(0); PG8_MMA(0, 0, At, B0); PG8_BAR; PG8_SCHED;
            PG8_LDB(B1, 1, 1); PG8_STAGE(PG8_SB(1, 0), b3, vB2);
            PG8_BAR; PG8_WAIT_L(0); PG8_MMA(0, 1, At, B1); PG8_BAR;
            PG8_LDA(At, 1, 1); PG8_STAGE(PG8_SA(1, 0), a3, vA2);
            PG8_BAR; PG8_WAIT_L(0); PG8_MMA(1, 0, At, B0); PG8_BAR; PG8_SCHED;
            PG8_STAGE(PG8_SB(1, 1), b3 + hs2, vB2);
            PG8_WAIT_V(6); PG8_BAR; PG8_MMA(1, 1, At, B1); PG8_BAR;
        }
        E(acc, cur, wr, wc, fr, fq);
        if (!has_next) break;
#pragma unroll
        for (int a = 0; a < 2; ++a)
#pragma unroll
            for (int b = 0; b < 2; ++b)
#pragma unroll
                for (int m = 0; m < 4; ++m)
#pragma unroll
                    for (int n = 0; n < 2; ++n) acc[a][b][m][n] = (f32x4){0.f, 0.f, 0.f, 0.f};
#pragma unroll
        for (int i = 0; i < 2; ++i) { vAc[i] = ((vAc[i] >> shC) << shN) | (vAc[i] & cmask); vBc[i] = ((vBc[i] >> shC) << shN) | (vBc[i] & cmask); }
        cur = nxt; cA = nA; cB = nB; ksC = ksN; hsC = hsN; shC = shN; ++ui;
    }
    PG8_WAIT_V(0);
    if (wr == 0) PG8_BAR;
    PG8_BAR;
#undef PG8_SA
#undef PG8_SB
#undef PG8_STAGE
#undef PG8_LDA
#undef PG8_LDB
#undef PG8_MMA
#undef PG8_WAIT_V
#undef PG8_WAIT_L
#undef PG8_BAR
#undef PG8_SCHED
}
}
#define XB_TMO      128
#define XB_XCNT(j)  (256  + 64 * (j))
#define XB_XSUB(j)  (1280 + 64 * (j))
#define XB_XGEN(j)  (2304 + 64 * (j))
#define XB_TOP      3328
#define XB_TOPGEN   3392
#define XCD_BAR_WORDS 3456
#define XB_SPIN_CAP (1u << 18)
#define LAS __attribute__((address_space(3)))
__device__ __forceinline__ unsigned xb_ld(unsigned* p)              { return __hip_atomic_load(p, __ATOMIC_RELAXED, __HIP_MEMORY_SCOPE_AGENT); }
__device__ __forceinline__ unsigned xb_add(unsigned* p, unsigned v) { return __hip_atomic_fetch_add(p, v, __ATOMIC_RELAXED, __HIP_MEMORY_SCOPE_AGENT); }
__device__ __forceinline__ unsigned xb_xcc_id() { return (unsigned)__builtin_amdgcn_s_getreg((3 << 11) | 20) & 0xFu; }
#define XB_SPIN(cond, bar) do { unsigned _sp = 0; while (cond) { __builtin_amdgcn_s_sleep(1); \
    if ((++_sp & 255u) == 0u) { if (xb_ld(&(bar)[XB_TMO])) break; if (_sp > XB_SPIN_CAP) { atomicAdd(&(bar)[XB_TMO], 1u); break; } } } } while (0)

struct XcdBarrier {
    unsigned* bar; unsigned x;
    volatile LAS unsigned* st;
};

__device__ __forceinline__ XcdBarrier xcd_barrier_post(unsigned* bar, volatile LAS unsigned* st) {
    XcdBarrier b; b.bar = bar; b.x = xb_xcc_id(); b.st = st;
    if (threadIdx.x == 0) (void)xb_add(&bar[XB_XCNT(b.x)], 1u);
    return b;
}
__device__ __forceinline__ void xcd_barrier_complete(unsigned* bar, unsigned x, unsigned& nloc, unsigned& nx) {
    const unsigned G = gridDim.x * gridDim.y * gridDim.z;
    unsigned sum, cnt, mine, sp = 0u;
    for (;;) {
        sum = 0u; cnt = 0u; mine = 0u;
#pragma unroll
        for (unsigned j = 0; j < 16; ++j) { const unsigned c = xb_ld(&bar[XB_XCNT(j)]); sum += c; cnt += (c > 0u) ? 1u : 0u; mine = (j == x) ? c : mine; }
        if (sum == G) break;
        __builtin_amdgcn_s_sleep(1);
        if ((++sp & 255u) == 0u) { if (xb_ld(&bar[XB_TMO])) break; if (sp > XB_SPIN_CAP) { atomicAdd(&bar[XB_TMO], 1u); break; } }
    }
    nloc = mine > 0u ? mine : 1u; nx = cnt > 0u ? cnt : 1u;
}

template <class F> __device__ __forceinline__ void xcd_barrier(const XcdBarrier& b, F&& shadow) {
    asm volatile("s_waitcnt vmcnt(0)" ::: "memory");
    __syncthreads();
    if (threadIdx.x == 0) {
        unsigned* bar = b.bar;
        __builtin_amdgcn_s_waitcnt(0);
        unsigned nloc = b.st[0], nx = b.st[1];
        if (nloc == 0u) { xcd_barrier_complete(bar, b.x, nloc, nx); b.st[0] = nloc; b.st[1] = nx; }
        const unsigned old = xb_add(&bar[XB_XSUB(b.x)], 1u);
        const unsigned gen = old / nloc;
        if (old + 1u == (gen + 1u) * nloc) {
            __builtin_amdgcn_fence(__ATOMIC_RELEASE, "agent");
            asm volatile("s_waitcnt vmcnt(0)" ::: "memory");
            const unsigned og = xb_add(&bar[XB_TOP], 1u);
            const unsigned tg = og / nx;
            if (og + 1u == (tg + 1u) * nx) xb_add(&bar[XB_TOPGEN], 1u);
            else XB_SPIN(xb_ld(&bar[XB_TOPGEN]) == tg, bar);
            __builtin_amdgcn_fence(__ATOMIC_ACQUIRE, "agent");
            xb_add(&bar[XB_XGEN(b.x)], 1u);
            asm volatile("s_waitcnt vmcnt(0)" ::: "memory");
        } else {
            XB_SPIN(xb_ld(&bar[XB_XGEN(b.x)]) == gen, bar);
            __builtin_amdgcn_fence(__ATOMIC_ACQUIRE, "agent");
            asm volatile("s_waitcnt vmcnt(0)" ::: "memory");
        }
    } else if (threadIdx.x >= 64) shadow();
    __syncthreads();
}
using pg8::f32x4; using pg8::u32x4; using pg8::bf16_t; using pg8::Unit;
#define DI __device__ __forceinline__
constexpr int M_TOK = 16384, DM = 1024, SEQ = 2048, NPHASE = 10;
constexpr float EPS = 1e-6f;
constexpr int LDS_BYTES = 131072 + 16;
constexpr size_t MiB = 1024 * 1024;
constexpr size_t OFF_WIN1 = 0, OFF_WAOUT = 4 * MiB, OFF_WPLE0 = 6 * MiB, OFF_WPLE1 = 6 * MiB + 512 * 1024, OFF_WG0 = 7 * MiB, OFF_WG1 = 9 * MiB,
                 OFF_WKQZ = 11 * MiB, OFF_WV = 17 * MiB, OFF_WBOUT = 19 * MiB, OFF_PB = 21 * MiB, OFF_R1 = 37 * MiB, OFF_R2 = 69 * MiB, OFF_R3 = 101 * MiB,
                 OFF_R4 = 133 * MiB, OFF_RSTD0 = 197 * MiB, OFF_RSTD1 = 197 * MiB + 65536, OFF_SSP = 197 * MiB + 131072, OFF_BAR = 199 * MiB, OFF_E1 = 200 * MiB, WS_END = 232 * MiB;

struct Params {
    const float *x, *p, *a_norm, *a_w_in, *a_w_group, *a_scale, *a_w_out, *kv_norm, *w_kv, *k_norm, *b_norm, *b_w_in, *b_q_norm, *b_w_out, *ple_w, *ple_gate_w;
    float* out; unsigned char* ws; int ph_lo, ph_hi;
};

typedef __bf16 bf16x2_t __attribute__((ext_vector_type(2)));
typedef float f32x2_t __attribute__((ext_vector_type(2)));
typedef unsigned u32x2_t __attribute__((ext_vector_type(2)));
typedef short s16x8 __attribute__((ext_vector_type(8)));
typedef short s16x4 __attribute__((ext_vector_type(4)));
typedef float f32x16 __attribute__((ext_vector_type(16)));
DI unsigned pk2(float lo, float hi) { f32x2_t v = {lo, hi}; bf16x2_t r = __builtin_convertvector(v, bf16x2_t); return __builtin_bit_cast(unsigned, r); }
DI float bflo(unsigned u) { return __uint_as_float(u << 16); }
DI float bfhi(unsigned u) { return __uint_as_float(u & 0xffff0000u); }
DI u32x4 pk8(f32x4 a, f32x4 b) { u32x4 w; w.x = pk2(a[0], a[1]); w.y = pk2(a[2], a[3]); w.z = pk2(b[0], b[1]); w.w = pk2(b[2], b[3]); return w; }
DI float wave_sum(float v) {
#pragma unroll
    for (int o = 1; o < 64; o <<= 1) v += __shfl_xor(v, o);
    return v;
}
DI float sigm(float v) { return __builtin_amdgcn_rcpf(1.f + __expf(-v)); }
DI f32x4 silu4(f32x4 v) { f32x4 r; r[0] = v[0] * sigm(v[0]); r[1] = v[1] * sigm(v[1]); r[2] = v[2] * sigm(v[2]); r[3] = v[3] * sigm(v[3]); return r; }
DI f32x4 sigm4(f32x4 v) { f32x4 r; r[0] = sigm(v[0]); r[1] = sigm(v[1]); r[2] = sigm(v[2]); r[3] = sigm(v[3]); return r; }

typedef const f32x4 (&AccRef)[2][2][4][2];

struct Epi1 {
    static constexpr bool PERM = true, AFTER_DRAIN = false;
    bf16_t* ug; bf16_t* sz; const float* rstd0;
    DI void operator()(AccRef acc, const Unit& u, int wr, int wc, int fr, int fq) const {
        const int row0 = u.pm * 256 + wr * 64 + fr; const bool isz = u.pn >= 4;
        bf16_t* base = (isz ? sz : ug) + (u.pn & 3) * 256 + wc * 32 + 8 * fq;
        float rsv[2][4];
#pragma unroll
        for (int ai = 0; ai < 2; ++ai)
#pragma unroll
            for (int m = 0; m < 4; ++m) rsv[ai][m] = rstd0[row0 + ai * 128 + m * 16];
#pragma unroll
        for (int ai = 0; ai < 2; ++ai)
#pragma unroll
            for (int m = 0; m < 4; ++m) { const int row = row0 + ai * 128 + m * 16; const float rs = rsv[ai][m]; bf16_t* rowp = base + (size_t)row * DM;
#pragma unroll
                for (int bj = 0; bj < 2; ++bj) { f32x4 v0 = acc[ai][bj][m][0] * rs, v1 = acc[ai][bj][m][1] * rs;
                    if (isz) { v0 = silu4(v0); v1 = silu4(v1); }
                    *(u32x4*)(rowp + bj * 128) = pk8(v0, v1); } }
    }
};
struct EpiE {
    static constexpr bool PERM = true, AFTER_DRAIN = false;
    bf16_t* e;
    DI void operator()(AccRef acc, const Unit& u, int wr, int wc, int fr, int fq) const {
        const int row0 = u.pm * 256 + wr * 64 + fr; bf16_t* base = e + u.pn * 256 + wc * 32 + 8 * fq;
#pragma unroll
        for (int ai = 0; ai < 2; ++ai)
#pragma unroll
            for (int m = 0; m < 4; ++m) { bf16_t* rowp = base + (size_t)(row0 + ai * 128 + m * 16) * DM;
#pragma unroll
                for (int bj = 0; bj < 2; ++bj) *(u32x4*)(rowp + bj * 128) = pk8(acc[ai][bj][m][0], acc[ai][bj][m][1]); }
    }
};
DI void unpk8(const u32x4 q, f32x4& lo, f32x4& hi) { lo = (f32x4){bflo(q.x), bfhi(q.x), bflo(q.y), bfhi(q.y)}; hi = (f32x4){bflo(q.z), bfhi(q.z), bflo(q.w), bfhi(q.w)}; }
template <bool SRCF32> struct EpiResB {
    static constexpr bool PERM = true, AFTER_DRAIN = false;
    const float* srcf; const bf16_t* srcb; bf16_t* xb;
    DI void operator()(AccRef acc, const Unit& u, int wr, int wc, int fr, int fq) const {
        const int row0 = u.pm * 256 + wr * 64 + fr, col0 = u.pn * 256 + wc * 32 + 8 * fq;
#pragma unroll
        for (int ai = 0; ai < 2; ++ai) {
            f32x4 a[4][2][2];
#pragma unroll
            for (int m = 0; m < 4; ++m) { const size_t o = (size_t)(row0 + ai * 128 + m * 16) * DM + col0;
#pragma unroll
                for (int bj = 0; bj < 2; ++bj) {
                    if (SRCF32) { a[m][bj][0] = *(const f32x4*)(srcf + o + bj * 128); a[m][bj][1] = *(const f32x4*)(srcf + o + bj * 128 + 4); }
                    else { const u32x4 q = *(const u32x4*)(srcb + o + bj * 128); unpk8(q, a[m][bj][0], a[m][bj][1]); } } }
#pragma unroll
            for (int m = 0; m < 4; ++m) { const size_t o = (size_t)(row0 + ai * 128 + m * 16) * DM + col0;
#pragma unroll
                for (int bj = 0; bj < 2; ++bj) *(u32x4*)(xb + o + bj * 128) = pk8(a[m][bj][0] + acc[ai][bj][m][0], a[m][bj][1] + acc[ai][bj][m][1]); }
        }
    }
};
template <bool NEXT> struct EpiGate {
    static constexpr bool PERM = true, AFTER_DRAIN = false;
    const bf16_t* xin; const bf16_t* e; bf16_t* xb; float* ssp; float* outf;
    DI void operator()(AccRef acc, const Unit& u, int wr, int wc, int fr, int fq) const {
        const int row0 = u.pm * 256 + wr * 64 + fr, col0 = u.pn * 256 + wc * 32 + 8 * fq;
#pragma unroll
        for (int ai = 0; ai < 2; ++ai) {
            u32x4 xv[4][2], ev[4][2];
#pragma unroll
            for (int m = 0; m < 4; ++m) { const size_t o = (size_t)(row0 + ai * 128 + m * 16) * DM + col0;
#pragma unroll
                for (int bj = 0; bj < 2; ++bj) { xv[m][bj] = *(const u32x4*)(xin + o + bj * 128); ev[m][bj] = *(const u32x4*)(e + o + bj * 128); } }
#pragma unroll
            for (int m = 0; m < 4; ++m) { const int row = row0 + ai * 128 + m * 16; const size_t o = (size_t)row * DM + col0; float ss = 0.f;
#pragma unroll
                for (int bj = 0; bj < 2; ++bj) { f32x4 a0, a1, e0, e1; unpk8(xv[m][bj], a0, a1); unpk8(ev[m][bj], e0, e1);
                    const f32x4 v0 = a0 + e0 * sigm4(acc[ai][bj][m][0]), v1 = a1 + e1 * sigm4(acc[ai][bj][m][1]);
                    if (NEXT) { *(u32x4*)(xb + o + bj * 128) = pk8(v0, v1);
                        ss += (v0[0] * v0[0] + v0[1] * v0[1]) + (v0[2] * v0[2] + v0[3] * v0[3]) + (v1[0] * v1[0] + v1[1] * v1[1]) + (v1[2] * v1[2] + v1[3] * v1[3]); }
                    else { *(f32x4*)(outf + o + bj * 128) = v0; *(f32x4*)(outf + o + bj * 128 + 4) = v1; } }
                if (NEXT) { ss += __shfl_xor(ss, 16); ss += __shfl_xor(ss, 32); if (fq == 0) atomicAdd(ssp + row, ss); } }
        }
    }
};
struct EpiKQZ {
    static constexpr bool PERM = true, AFTER_DRAIN = false;
    bf16_t *kk, *qq, *sz2; const float *rstd1, *k_norm, *q_norm;
    DI void operator()(AccRef acc, const Unit& u, int wr, int wc, int fr, int fq) const {
        const int row0 = u.pm * 256 + wr * 64 + fr, kind = u.pn >> 2, pq = u.pn & 3;
        float rsv[2][4];
#pragma unroll
        for (int ai = 0; ai < 2; ++ai)
#pragma unroll
            for (int m = 0; m < 4; ++m) rsv[ai][m] = rstd1[row0 + ai * 128 + m * 16];
        if (kind == 2) {
            bf16_t* base = sz2 + pq * 256 + 64 * wc + 8 * fq;
#pragma unroll
            for (int ai = 0; ai < 2; ++ai)
#pragma unroll
                for (int m = 0; m < 4; ++m) { const int row = row0 + ai * 128 + m * 16; const float rs = rsqrtf(rsv[ai][m] * (1.f / DM) + EPS); bf16_t* rowp = base + (size_t)row * DM;
#pragma unroll
                    for (int bj = 0; bj < 2; ++bj) *(u32x4*)(rowp + bj * 32) = pk8(silu4(acc[ai][bj][m][0] * rs), silu4(acc[ai][bj][m][1] * rs)); }
        } else {
            const float* gn = kind ? q_norm : k_norm; const float mul = kind ? 0.125f * 1.4426950408889634f : 1.f;
            bf16_t* dst = kind ? qq : kk; const int head = pq * 4 + wc;
            f32x4 g[2][2];
#pragma unroll
            for (int bj = 0; bj < 2; ++bj)
#pragma unroll
                for (int n = 0; n < 2; ++n) g[bj][n] = *(const f32x4*)(gn + 32 * bj + 8 * fq + 4 * n) * mul;
#pragma unroll
            for (int ai = 0; ai < 2; ++ai)
#pragma unroll
                for (int m = 0; m < 4; ++m) { const int row = row0 + ai * 128 + m * 16; const float rs = rsqrtf(rsv[ai][m] * (1.f / DM) + EPS); const int b = row >> 11, s = row & 2047;
                    f32x4 v[2][2]; float ss = 0.f;
#pragma unroll
                    for (int bj = 0; bj < 2; ++bj)
#pragma unroll
                        for (int n = 0; n < 2; ++n) { v[bj][n] = acc[ai][bj][m][n] * rs; ss += (v[bj][n][0] * v[bj][n][0] + v[bj][n][1] * v[bj][n][1]) + (v[bj][n][2] * v[bj][n][2] + v[bj][n][3] * v[bj][n][3]); }
                    ss += __shfl_xor(ss, 16); ss += __shfl_xor(ss, 32);
                    const float hr = rsqrtf(ss * (1.f / 64.f) + EPS);
                    bf16_t* rowp = dst + ((size_t)(b * 16 + head) * SEQ + s) * 64 + 8 * fq;
#pragma unroll
                    for (int bj = 0; bj < 2; ++bj) *(u32x4*)(rowp + 32 * bj) = pk8(v[bj][0] * hr * g[bj][0], v[bj][1] * hr * g[bj][1]); }
        }
    }
};
struct EpiVT {
    static constexpr bool PERM = true, AFTER_DRAIN = false;
    bf16_t* vt; const float* rstd1;
    DI void operator()(AccRef acc, const Unit& u, int wr, int wc, int fr, int fq) const {
        const int c0 = u.pm * 256 + wr * 64 + fr, tok0 = u.pn * 256 + wc * 32 + 8 * fq;
        f32x4 rs[2][2];
#pragma unroll
        for (int bj = 0; bj < 2; ++bj)
#pragma unroll
            for (int n = 0; n < 2; ++n) { const f32x4 q = *(const f32x4*)(rstd1 + tok0 + 128 * bj + 4 * n);
#pragma unroll
                for (int j = 0; j < 4; ++j) rs[bj][n][j] = rsqrtf(q[j] * (1.f / DM) + EPS); }
#pragma unroll
        for (int ai = 0; ai < 2; ++ai)
#pragma unroll
            for (int m = 0; m < 4; ++m) { const int c = c0 + ai * 128 + m * 16;
#pragma unroll
                for (int bj = 0; bj < 2; ++bj) { const int tok = tok0 + 128 * bj, b = tok >> 11, s = tok & 2047;
                    *(u32x4*)(vt + ((size_t)b * DM + c) * SEQ + s) = pk8(acc[ai][bj][m][0] * rs[bj][0], acc[ai][bj][m][1] * rs[bj][1]); } }
    }
};
template <class Epi> DI void run_gemm(PG8_LAS unsigned char* lds, const bf16_t* A, const bf16_t* Bt, int M, int N, int K, const Epi& E) {
    pg8::Gemm g{A, Bt, M, N, K}; pg8::StaticOrder S; S.init(M, N, (int)gridDim.x, (int)blockIdx.x);
    pg8::gemm_phase<Epi, pg8::StaticOrder, false>(lds, g, S, E, nullptr);
}

struct SchedPG {
    const unsigned char* ws; int layer, G, c;
    DI bool next(int i, pg8::UnitX& u) const { const int L = i * G + c; if (L >= 512) return false;
        pg8::map_unit(L & 255, 64, 4, u.pm, u.pn); u.kind = L >> 8; return true; }
    DI pg8::GDesc desc(int k) const { pg8::GDesc d;
        const size_t oa = k == 0 ? OFF_PB + (size_t)layer * M_TOK * 256 * 2 : OFF_R2, ob = k == 0 ? (layer ? OFF_WPLE1 : OFF_WPLE0) : (layer ? OFF_WG1 : OFF_WG0);
        d.A = (const bf16_t*)(ws + oa); d.Bt = (const bf16_t*)(ws + ob); d.ks = k == 0 ? 256 : 1024; return d; }
    DI void a_ready(const pg8::UnitX&) const {}
    DI void done(const pg8::UnitX&) const {}
};
template <bool NEXT> struct EpiPG {
    static constexpr bool PERM = true;
    EpiE e; EpiGate<NEXT> g;
    DI void operator()(AccRef acc, const pg8::UnitX& u, int wr, int wc, int fr, int fq) const { const Unit uu{u.pm, u.pn};
        if (u.kind == 0) e(acc, uu, wr, wc, fr, fq); else g(acc, uu, wr, wc, fr, fq); }
};
struct SchedP6 {
    const unsigned char* ws; int G, c;
    DI bool next(int i, pg8::UnitX& u) const { const int L = i * G + c; if (L >= 1024) return false;
        if (L < 768) { pg8::map_unit(L, 64, 12, u.pm, u.pn); u.kind = 0; } else { pg8::map_unit(L - 768, 4, 64, u.pm, u.pn); u.kind = 1; }
        return true; }
    DI pg8::GDesc desc(int k) const { pg8::GDesc d; d.A = (const bf16_t*)(ws + (k == 0 ? OFF_R3 : OFF_WV)); d.Bt = (const bf16_t*)(ws + (k == 0 ? OFF_WKQZ : OFF_R3)); d.ks = 1024; return d; }
};
struct EpiP6 {
    static constexpr bool PERM = true;
    EpiKQZ a; EpiVT b;
    DI void operator()(AccRef acc, const pg8::UnitX& u, int wr, int wc, int fr, int fq) const { const Unit uu{u.pm, u.pn};
        if (u.kind == 0) a(acc, uu, wr, wc, fr, fq); else b(acc, uu, wr, wc, fr, fq); }
};

DI int headperm(int cl) { const int o = cl & 255, wc = o >> 6, bj = (o >> 5) & 1, r = o & 31; return (cl & ~255) + 128 * bj + 32 * wc + r; }
DI void transpose_item(float* scr, const float* src, int ld, int K, int nT, const float* gain, bf16_t* dst, int rowoff, bool perm, int item, int lane) {
    const int kt = item / nT, nt = item - kt * nT, k0 = kt * 64, n0 = nt * 32, lr = lane >> 3, lc = lane & 7;
    float4 v[8];
#pragma unroll
    for (int i = 0; i < 8; ++i) v[i] = *(const float4*)(src + (size_t)(k0 + i * 8 + lr) * ld + n0 + lc * 4);
    float gk[8];
#pragma unroll
    for (int i = 0; i < 8; ++i) gk[i] = gain ? gain[k0 + 8 * lc + i] : 1.f;
#pragma unroll
    for (int i = 0; i < 8; ++i) { float* t = scr + (i * 8 + lr) * 33 + lc * 4; t[0] = v[i].x; t[1] = v[i].y; t[2] = v[i].z; t[3] = v[i].w; }
    asm volatile("s_waitcnt lgkmcnt(0)" ::: "memory");
#pragma unroll
    for (int j = 0; j < 4; ++j) { const int n = lr + 8 * j; const float* t = scr + (8 * lc) * 33 + n;
        int row = rowoff + n0 + n; if (perm) row = headperm(row);
        u32x4 w; w.x = pk2(t[0] * gk[0], t[33] * gk[1]); w.y = pk2(t[66] * gk[2], t[99] * gk[3]); w.z = pk2(t[132] * gk[4], t[165] * gk[5]); w.w = pk2(t[198] * gk[6], t[231] * gk[7]);
        *(u32x4*)(dst + (size_t)row * K + k0 + 8 * lc) = w; }
    asm volatile("s_waitcnt lgkmcnt(0)" ::: "memory");
}
DI void weff_job(float* L, const Params& P, bf16_t* dst, int job) {
    float* As = L; float* Bs = L + 64 * 129;
    const int tid = threadIdx.x, k0 = (job >> 4) * 64, n0 = (job & 15) * 64, g = n0 >> 8, d0 = n0 & 255, kk = tid >> 3, dg = tid & 7;
    float acc[8];
#pragma unroll
    for (int j = 0; j < 8; ++j) acc[j] = 0.f;
    for (int c0 = 0; c0 < 256; c0 += 128) {
        __syncthreads();
#pragma unroll
        for (int i = 0; i < 4; ++i) { const int idx = tid + 512 * i;
            { const int r = idx >> 5, c4 = idx & 31; const float4 v = *(const float4*)(P.a_w_in + (size_t)(k0 + r) * 2048 + g * 256 + c0 + c4 * 4);
              float* t = As + r * 129 + c4 * 4; t[0] = v.x; t[1] = v.y; t[2] = v.z; t[3] = v.w; }
            { const int cc = idx >> 4, d4 = idx & 15; *(float4*)(Bs + cc * 64 + d4 * 4) = *(const float4*)(P.a_w_group + (size_t)(g * 256 + c0 + cc) * 256 + d0 + d4 * 4); } }
        __syncthreads();
#pragma unroll 4
        for (int c = 0; c < 128; ++c) { const float a = As[kk * 129 + c]; const float4 b0 = *(const float4*)(Bs + c * 64 + dg * 8), b1 = *(const float4*)(Bs + c * 64 + dg * 8 + 4);
            acc[0] += a * b0.x; acc[1] += a * b0.y; acc[2] += a * b0.z; acc[3] += a * b0.w; acc[4] += a * b1.x; acc[5] += a * b1.y; acc[6] += a * b1.z; acc[7] += a * b1.w; }
    }
    const float an = P.a_norm[k0 + kk];
#pragma unroll
    for (int j = 0; j < 8; ++j) { const int n = n0 + dg * 8 + j; const float v = acc[j] * an * P.a_scale[n];
        dst[(size_t)n * DM + k0 + kk] = (bf16_t)(pk2(v, v) & 0xffffu); }
}
DI void shadow_p_convert(const Params& P, int half) {
    const float4* pp = (const float4*)P.p; u32x4* pb = (u32x4*)(P.ws + OFF_PB);
    const int HALFCH = M_TOK * 256 / 8, step = gridDim.x * 448, base = half * HALFCH;
    for (int i = blockIdx.x * 448 + ((int)threadIdx.x - 64); i < HALFCH; i += 5 * step) { float4 a[5], b[5];
#pragma unroll
        for (int q = 0; q < 5; ++q) if (i + q * step < HALFCH) { a[q] = pp[2 * (base + i + q * step)]; b[q] = pp[2 * (base + i + q * step) + 1]; }
#pragma unroll
        for (int q = 0; q < 5; ++q) if (i + q * step < HALFCH) { u32x4 u; u.x = pk2(a[q].x, a[q].y); u.y = pk2(a[q].z, a[q].w); u.z = pk2(b[q].x, b[q].y); u.w = pk2(b[q].z, b[q].w); pb[base + i + q * step] = u; } }
}
DI void deferred_items(const Params& P, float* L, int seam) {
    const int wid = threadIdx.x >> 6, lane = threadIdx.x & 63; unsigned char* ws = P.ws; float* scr = L + wid * (64 * 33);
    const int nitems = (seam == 0) ? 768 : (seam == 1 ? 512 : 1024);
    for (int t = blockIdx.x * 7 + (wid - 1); t < nitems; t += gridDim.x * 7) {
        const int r = t & 511, hi = t >> 9;
        if (seam == 0) { if (hi == 0) transpose_item(scr, P.a_w_out, 1024, 1024, 32, nullptr, (bf16_t*)(ws + OFF_WAOUT), 0, false, r, lane);
                         else if (r < 128) transpose_item(scr, P.ple_w, 1024, 256, 32, nullptr, (bf16_t*)(ws + OFF_WPLE0), 0, false, r, lane);
                         else transpose_item(scr, P.ple_w + 256 * 1024, 1024, 256, 32, nullptr, (bf16_t*)(ws + OFF_WPLE1), 0, false, r - 128, lane); }
        else if (seam == 1) transpose_item(scr, P.ple_gate_w, 1024, 1024, 32, nullptr, (bf16_t*)(ws + OFF_WG0), 0, false, r, lane);
        else if (seam == 2) { if (hi == 0) transpose_item(scr, P.w_kv, 2048, 1024, 32, P.kv_norm, (bf16_t*)(ws + OFF_WKQZ), 0, true, r, lane);
                              else transpose_item(scr, P.w_kv + 1024, 2048, 1024, 32, P.kv_norm, (bf16_t*)(ws + OFF_WV), 0, false, r, lane); }
        else if (seam == 3) transpose_item(scr, P.b_w_in, 2048, 1024, 64, P.b_norm, (bf16_t*)(ws + OFF_WKQZ), 1024, true, t, lane);
        else { if (hi == 0) transpose_item(scr, P.b_w_out, 1024, 1024, 32, nullptr, (bf16_t*)(ws + OFF_WBOUT), 0, false, r, lane);
               else transpose_item(scr, P.ple_gate_w + 1024 * 1024, 1024, 1024, 32, nullptr, (bf16_t*)(ws + OFF_WG1), 0, false, r, lane); }
    }
    if (seam < 2) shadow_p_convert(P, seam);
}
DI void phase0(const Params& P, float* L) {
    const int tid = threadIdx.x, wid = tid >> 6, lane = tid & 63, w = blockIdx.x, G = gridDim.x;
    unsigned char* ws = P.ws;
    { float* ss1 = (float*)(ws + OFF_RSTD1); for (int i = w * 512 + tid; i < M_TOK; i += G * 512) ss1[i] = 0.f; }
    if ((w & 1) == 0) { for (int job = w; job < 256; job += G) weff_job(L, P, (bf16_t*)(ws + OFF_WIN1), job); __syncthreads(); }
    { float* scr = L + wid * (64 * 33);
      for (int t = w * 8 + wid; t < 512; t += G * 8) transpose_item(scr, P.a_w_in + 1024, 2048, 1024, 32, P.a_norm, (bf16_t*)(ws + OFF_WIN1) + (size_t)1024 * 1024, 0, false, t, lane); }
    { bf16_t* xb = (bf16_t*)(ws + OFF_R1); float* rstd0 = (float*)(ws + OFF_RSTD0);
      for (int row = (w * 8 + wid) * 8; row < M_TOK; row += G * 64) {
          float4 v[8][4];
#pragma unroll
          for (int q = 0; q < 8; ++q)
#pragma unroll
              for (int j = 0; j < 4; ++j) v[q][j] = ((const float4*)(P.x + (size_t)(row + q) * DM) + lane)[64 * j];
#pragma unroll
          for (int q = 0; q < 8; ++q) { float s = 0.f;
#pragma unroll
              for (int j = 0; j < 4; ++j) s += (v[q][j].x * v[q][j].x + v[q][j].y * v[q][j].y) + (v[q][j].z * v[q][j].z + v[q][j].w * v[q][j].w);
              s = wave_sum(s);
              uint2* o = (uint2*)(xb + (size_t)(row + q) * DM) + lane;
#pragma unroll
              for (int j = 0; j < 4; ++j) { uint2 u; u.x = pk2(v[q][j].x, v[q][j].y); u.y = pk2(v[q][j].z, v[q][j].w); o[64 * j] = u; }
              if (lane == 0) rstd0[row + q] = rsqrtf(s * (1.f / DM) + EPS); } } }
    if ((w & 1) != 0) { __syncthreads(); for (int job = w; job < 256; job += G) weff_job(L, P, (bf16_t*)(ws + OFF_WIN1), job); }
}
DI void unpack8(const u32x4 q, float (&f)[8]) { f[0] = bflo(q.x); f[1] = bfhi(q.x); f[2] = bflo(q.y); f[3] = bfhi(q.y); f[4] = bflo(q.z); f[5] = bfhi(q.z); f[6] = bflo(q.w); f[7] = bfhi(q.w); }
DI void pool_phase(const Params& P) {
    const bf16_t* ug = (const bf16_t*)(P.ws + OFF_R2); const bf16_t* sz = (const bf16_t*)(P.ws + OFF_R3); bf16_t* Gd = (bf16_t*)(P.ws + OFF_R1);
    const int nth = gridDim.x * 512;
    for (int idx = blockIdx.x * 512 + threadIdx.x; idx < 131072; idx += nth) {
        const int chunk = idx & 127, run = idx >> 7, row0 = run * 16, t0 = row0 & (SEQ - 1), c0 = chunk * 8, wlen = 2 << (chunk >> 5);
        const u32x4* up = (const u32x4*)(ug + (size_t)row0 * DM + c0); const u32x4* zp = (const u32x4*)(sz + (size_t)row0 * DM + c0); u32x4* gp = (u32x4*)(Gd + (size_t)row0 * DM + c0);
        float s[8], c[8], z[8];
#pragma unroll
        for (int j = 0; j < 8; ++j) s[j] = 0.f;
        { const bool hist = t0 > 0;
#pragma unroll
          for (int j = 1; j <= 16; ++j) {
              const int jj = hist ? (j <= wlen ? j : wlen) : 0; const float mk = (hist && j <= wlen) ? 1.f : 0.f;
              unpack8(up[-(jj * 128)], c);
#pragma unroll
              for (int q = 0; q < 8; ++q) s[q] += mk * c[q]; } }
        const float inv_full = 1.f / (float)wlen;
#pragma unroll 4
        for (int rr = 0; rr < 16; ++rr) {
            const int t = t0 + rr;
            if (t >= wlen) { unpack8(up[(rr - wlen) * 128], c);
#pragma unroll
                for (int q = 0; q < 8; ++q) s[q] -= c[q]; }
            unpack8(up[rr * 128], c); unpack8(zp[rr * 128], z);
            const float inv = (t + 1 < wlen) ? 1.f / (float)(t + 1) : inv_full;
            float o[8];
#pragma unroll
            for (int q = 0; q < 8; ++q) { s[q] += c[q]; o[q] = (s[q] * inv - c[q]) * z[q]; }
            u32x4 w; w.x = pk2(o[0], o[1]); w.y = pk2(o[2], o[3]); w.z = pk2(o[4], o[5]); w.w = pk2(o[6], o[7]); gp[rr * 128] = w;
        }
    }
}
#define MFMA32(a, b, c) __builtin_amdgcn_mfma_f32_32x32x16_bf16((a), (b), (c), 0, 0, 0)
DI void attn_phase(const Params& P, PG8_LAS unsigned char* lds) {
    constexpr int HIST = 128, WIN = 384, KP = 144, VP = 776, NF = 6, VCH = 48;
    PG8_LAS unsigned char* Kl = lds; PG8_LAS unsigned char* Vl = lds + WIN * KP;
    const bf16_t* kk = (const bf16_t*)(P.ws + OFF_R1); const bf16_t* qq = (const bf16_t*)(P.ws + OFF_R2); const bf16_t* vt = (const bf16_t*)(P.ws + OFF_R4);
    const bf16_t* sz2 = (const bf16_t*)(P.ws + OFF_R4 + 32 * MiB); bf16_t* g2 = (bf16_t*)P.out;
    const int tid = threadIdx.x, wid = tid >> 6, lane = tid & 63, r = lane & 31, hh = lane >> 5;
#define ATT_LOAD_FILL(IT, KV, VV) do { const int _bh = (IT) >> 3, _wlo = ((IT) & 7) * 256 - HIST; const bf16_t* _Kg = kk + (size_t)_bh * SEQ * 64; const bf16_t* _Vg = vt + (size_t)_bh * 64 * SEQ; \
        _Pragma("unroll") for (int i = 0; i < NF; ++i) { const int c = tid + 512 * i, row = c >> 3, part = c & 7, key = _wlo + row; if (key >= 0) KV[i] = *(const u32x4*)(_Kg + (size_t)key * 64 + part * 8); } \
        _Pragma("unroll") for (int i = 0; i < NF; ++i) { const int c = tid + 512 * i, d = c / VCH, part = c - d * VCH, key0 = _wlo + part * 8; if (key0 >= 0) VV[i] = *(const u32x4*)(_Vg + (size_t)d * SEQ + key0); } } while (0)
#define ATT_LOAD_Q(IT, QF) do { const bf16_t* _Qp = qq + ((size_t)((IT) >> 3) * SEQ + ((IT) & 7) * 256 + 32 * wid + r) * 64 + hh * 8; \
        _Pragma("unroll") for (int ks = 0; ks < 4; ++ks) QF[ks] = *(const s16x8*)(_Qp + ks * 16); } while (0)
    u32x4 kv[NF], vv[NF];
    if ((int)blockIdx.x < 1024) { ATT_LOAD_FILL((int)blockIdx.x, kv, vv); }
    for (int item = blockIdx.x; item < 1024; item += gridDim.x) {
        const int qc = item & 7, bh = item >> 3, t0 = qc * 256, wlo = t0 - HIST, tq = t0 + 32 * wid;
        const bf16_t* Kg = kk + (size_t)bh * SEQ * 64; const bf16_t* Vg = vt + (size_t)bh * 64 * SEQ;
        const int b = bh >> 4, h = bh & 15; const size_t rowo = ((size_t)b * SEQ + tq + r) * DM + h * 64 + 4 * hh;
        s16x8 qf[4]; ATT_LOAD_Q(item, qf);
        __syncthreads();
#pragma unroll
        for (int i = 0; i < NF; ++i) { const int c = tid + 512 * i, row = c >> 3, part = c & 7, key = wlo + row;
            if (key >= 0) *(PG8_LAS u32x4*)(Kl + row * KP + part * 16) = kv[i]; }
#pragma unroll
        for (int i = 0; i < NF; ++i) { const int c = tid + 512 * i, d = c / VCH, part = c - d * VCH, key0 = wlo + part * 8;
            if (key0 >= 0) { PG8_LAS u32x2_t* w = (PG8_LAS u32x2_t*)(Vl + d * VP + part * 16); u32x2_t a = {vv[i].x, vv[i].y}, bb = {vv[i].z, vv[i].w}; w[0] = a; w[1] = bb; } }
        __syncthreads();
        uint2 zz[2][4];
#pragma unroll
        for (int g = 0; g < 4; ++g) { zz[0][g] = *(const uint2*)(sz2 + rowo + 8 * g); zz[1][g] = *(const uint2*)(sz2 + rowo + 32 + 8 * g); }
        const int nitem = item + gridDim.x;
        u32x4 kvn[NF], vvn[NF];
        if (nitem < 1024) { ATT_LOAD_FILL(nitem, kvn, vvn); }
        f32x16 o0, o1;
#pragma unroll
        for (int i = 0; i < 16; ++i) { o0[i] = 0.f; o1[i] = 0.f; }
        float carry = 1.f;
        for (int s0 = tq; s0 >= 0; s0 -= 32) {
            s16x8 kf[4]; s16x4 vf[2][2][2];
            if (s0 >= wlo) {
                PG8_LAS const unsigned char* kp = Kl + (s0 - wlo + r) * KP + hh * 16; PG8_LAS const unsigned char* vp = Vl + r * VP + (s0 - wlo + 4 * hh) * 2;
#pragma unroll
                for (int ks = 0; ks < 4; ++ks) kf[ks] = *(PG8_LAS const s16x8*)(kp + ks * 32);
#pragma unroll
                for (int dt = 0; dt < 2; ++dt)
#pragma unroll
                    for (int s = 0; s < 2; ++s)
#pragma unroll
                        for (int pt = 0; pt < 2; ++pt) vf[dt][s][pt] = *(PG8_LAS const s16x4*)(vp + dt * 32 * VP + (16 * s + 8 * pt) * 2);
            } else {
                const bf16_t* kp = Kg + (size_t)(s0 + r) * 64 + hh * 8; const bf16_t* vp = Vg + (size_t)r * SEQ + s0 + 4 * hh;
#pragma unroll
                for (int ks = 0; ks < 4; ++ks) kf[ks] = *(const s16x8*)(kp + ks * 16);
#pragma unroll
                for (int dt = 0; dt < 2; ++dt)
#pragma unroll
                    for (int s = 0; s < 2; ++s)
#pragma unroll
                        for (int pt = 0; pt < 2; ++pt) vf[dt][s][pt] = *(const s16x4*)(vp + (size_t)dt * 32 * SEQ + 16 * s + 8 * pt);
            }
            f32x16 x;
#pragma unroll
            for (int i = 0; i < 16; ++i) x[i] = 0.f;
#pragma unroll
            for (int ks = 0; ks < 4; ++ks) x = MFMA32(kf[ks], qf[ks], x);
            float beta[16], keep[16];
            const bool diag = (s0 == tq);
#pragma unroll
            for (int i = 0; i < 16; ++i) {
                const float l = fmaxf(x[i], -120.f);
                const float e = __builtin_amdgcn_exp2f(-l);
                float bt = __builtin_amdgcn_rcpf(1.f + e), kp = e * bt;
                beta[i] = bt; keep[i] = kp;
            }
            if (diag) {
#pragma unroll
                for (int i = 0; i < 16; ++i) { const bool valid = ((i & 3) + 8 * (i >> 2) + 4 * hh) < r; beta[i] = valid ? beta[i] : 0.f; keep[i] = valid ? keep[i] : 1.f; }
            }
            float Gp[4], PG[4];
#pragma unroll
            for (int g = 0; g < 4; ++g) { Gp[g] = (keep[4 * g] * keep[4 * g + 1]) * (keep[4 * g + 2] * keep[4 * g + 3]); PG[g] = __shfl_xor(Gp[g], 32); }
            float base[4];
            { float so = 1.f, sp = 1.f;
#pragma unroll
              for (int g = 3; g >= 0; --g) { base[g] = carry * so * sp * (hh == 0 ? PG[g] : 1.f); so *= Gp[g]; sp *= PG[g]; }
              carry = carry * so * sp; }
            float a[16];
#pragma unroll
            for (int g = 0; g < 4; ++g) { float run = base[g];
                a[4 * g + 3] = beta[4 * g + 3] * run; run *= keep[4 * g + 3];
                a[4 * g + 2] = beta[4 * g + 2] * run; run *= keep[4 * g + 2];
                a[4 * g + 1] = beta[4 * g + 1] * run; run *= keep[4 * g + 1];
                a[4 * g] = beta[4 * g] * run; }
#pragma unroll
            for (int s = 0; s < 2; ++s) {
                u32x4 pw; pw.x = pk2(a[8 * s], a[8 * s + 1]); pw.y = pk2(a[8 * s + 2], a[8 * s + 3]); pw.z = pk2(a[8 * s + 4], a[8 * s + 5]); pw.w = pk2(a[8 * s + 6], a[8 * s + 7]);
                const s16x8 pf = __builtin_bit_cast(s16x8, pw);
                const s16x8 va = __builtin_shufflevector(vf[0][s][0], vf[0][s][1], 0, 1, 2, 3, 4, 5, 6, 7);
                const s16x8 vb = __builtin_shufflevector(vf[1][s][0], vf[1][s][1], 0, 1, 2, 3, 4, 5, 6, 7);
                o0 = MFMA32(va, pf, o0); o1 = MFMA32(vb, pf, o1);
            }
            if (__all(carry < 1e-12f)) break;
        }
#pragma unroll
        for (int g = 0; g < 4; ++g) {
            const uint2 z0 = zz[0][g], z1 = zz[1][g];
            uint2 w0, w1;
            w0.x = pk2(o0[4 * g] * bflo(z0.x), o0[4 * g + 1] * bfhi(z0.x)); w0.y = pk2(o0[4 * g + 2] * bflo(z0.y), o0[4 * g + 3] * bfhi(z0.y));
            w1.x = pk2(o1[4 * g] * bflo(z1.x), o1[4 * g + 1] * bfhi(z1.x)); w1.y = pk2(o1[4 * g + 2] * bflo(z1.y), o1[4 * g + 3] * bfhi(z1.y));
            *(uint2*)(g2 + rowo + 8 * g) = w0; *(uint2*)(g2 + rowo + 32 + 8 * g) = w1;
        }
#pragma unroll
        for (int i = 0; i < NF; ++i) { kv[i] = kvn[i]; vv[i] = vvn[i]; }
    }
#undef ATT_LOAD_FILL
#undef ATT_LOAD_Q
}

__global__ __launch_bounds__(512, 2) void yoco_fwd(Params P) {
    extern __shared__ __attribute__((aligned(16))) unsigned char shm[];
    PG8_LAS unsigned char* lds = (PG8_LAS unsigned char*)shm;
    unsigned char* ws = P.ws;
    bf16_t* R1 = (bf16_t*)(ws + OFF_R1); bf16_t* R2 = (bf16_t*)(ws + OFF_R2); bf16_t* R3 = (bf16_t*)(ws + OFF_R3); bf16_t* R4 = (bf16_t*)(ws + OFF_R4);
    float* rstd0 = (float*)(ws + OFF_RSTD0); float* rstd1 = (float*)(ws + OFF_RSTD1); float* ssp = (float*)(ws + OFF_SSP);
    const bf16_t* pb = (const bf16_t*)(ws + OFF_PB); bf16_t* E1b = (bf16_t*)(ws + OFF_E1);
#define PH(k) if (P.ph_lo <= (k) && (k) < P.ph_hi)
#define SYNC(k) if (fused) { if ((k) < 5) xcd_barrier(xb, [&]() { deferred_items(P, (float*)shm, (k)); }); else xcd_barrier(xb, []() {}); }
    const bool fused = (P.ph_hi - P.ph_lo) > 1;
    volatile LAS unsigned* st = (volatile LAS unsigned*)(lds + 131072);
    unsigned* bar = (unsigned*)(ws + OFF_BAR);
    if (fused) { if (threadIdx.x == 0) { st[0] = 0u; st[1] = 0u; } __syncthreads(); }
    XcdBarrier xb; xb.bar = bar; xb.x = 0u; xb.st = st;
    if (fused) xb = xcd_barrier_post(bar, st);
    PH(0) phase0(P, (float*)shm);
    SYNC(0)
    PH(1) { Epi1 E{R2, R3, rstd0}; run_gemm(lds, R1, (const bf16_t*)(ws + OFF_WIN1), M_TOK, 2048, 1024, E); }
    SYNC(1)
    PH(2) pool_phase(P);
    SYNC(2)
    PH(3) { EpiResB<true> E{P.x, nullptr, R2}; run_gemm(lds, R1, (const bf16_t*)(ws + OFF_WAOUT), M_TOK, 1024, 1024, E); }
    SYNC(3)
    PH(4) { SchedPG S{ws, 0, (int)gridDim.x, (int)blockIdx.x}; EpiPG<true> E{EpiE{E1b}, EpiGate<true>{R2, E1b, R3, rstd1, nullptr}}; pg8::gemm_stream(lds, S, E); }
    SYNC(4)
    PH(6) { SchedP6 S{ws, (int)gridDim.x, (int)blockIdx.x};
            EpiP6 E{EpiKQZ{R1, R2, R4 + (size_t)M_TOK * DM, rstd1, P.k_norm, P.b_q_norm}, EpiVT{R4, rstd1}}; pg8::gemm_stream(lds, S, E); }
    SYNC(6)
    PH(7) attn_phase(P, lds);
    SYNC(7)
    PH(8) { EpiResB<false> E{nullptr, R3, R2}; run_gemm(lds, (const bf16_t*)P.out, (const bf16_t*)(ws + OFF_WBOUT), M_TOK, 1024, 1024, E); }
    SYNC(8)
    PH(9) { SchedPG S{ws, 1, (int)gridDim.x, (int)blockIdx.x}; EpiPG<false> E{EpiE{E1b}, EpiGate<false>{R2, E1b, nullptr, nullptr, P.out}}; pg8::gemm_stream(lds, S, E); }
}

extern "C" void kernel_launch(void* const* d_in, const int* in_sizes, int n_in, void* d_out, int out_size, void* d_ws, size_t ws_size, hipStream_t stream) {
    static int grid = 0;
    if (grid == 0) {
        int dev = 0, cus = 0, per_cu = 0;
        if (n_in != 16 || out_size != M_TOK * DM || ws_size < WS_END) { fprintf(stderr, "kernel_launch: unexpected shapes (n_in %d out %d ws %zu)\n", n_in, out_size, ws_size); grid = -1; return; }
        (void)hipGetDevice(&dev); (void)hipDeviceGetAttribute(&cus, hipDeviceAttributeMultiprocessorCount, dev);
        if (hipFuncSetAttribute((const void*)yoco_fwd, hipFuncAttributeMaxDynamicSharedMemorySize, LDS_BYTES) != hipSuccess) { fprintf(stderr, "kernel_launch: hipFuncSetAttribute failed\n"); grid = -1; return; }
        (void)hipOccupancyMaxActiveBlocksPerMultiprocessor(&per_cu, (const void*)yoco_fwd, 512, LDS_BYTES);
        if (per_cu < 1) { fprintf(stderr, "kernel_launch: occupancy query says %d blocks per CU\n", per_cu); (void)hipGetLastError(); per_cu = 1; }
        grid = cus;
    }
    if (grid < 0) return;
    Params p{};
    const float** pp = (const float**)&p;
    for (int i = 0; i < 16; ++i) pp[i] = (const float*)d_in[i];
    p.out = (float*)d_out; p.ws = (unsigned char*)d_ws;
    p.ph_lo = 0; p.ph_hi = NPHASE;
    if (hipMemsetAsync((unsigned char*)d_ws + OFF_BAR, 0, XCD_BAR_WORDS * 4, stream) != hipSuccess) { fprintf(stderr, "kernel_launch: memset of the barrier words failed\n"); return; }
    void* args[] = {&p};
    hipError_t e = hipLaunchCooperativeKernel((const void*)yoco_fwd, dim3(grid), dim3(512), args, LDS_BYTES, stream);
    if (e != hipSuccess) fprintf(stderr, "kernel_launch: cooperative launch failed: %s (grid %d)\n", hipGetErrorString(e), grid);
}
```

```cpp
#include <hip/hip_runtime.h>
#include <cstdio>
namespace pg8 {
#define PG8_LAS __attribute__((address_space(3)))
typedef unsigned short bf16_t;
typedef short bf16x8 __attribute__((ext_vector_type(8)));
typedef float f32x4 __attribute__((ext_vector_type(4)));
typedef unsigned u32x4 __attribute__((ext_vector_type(4)));
constexpr int BM = 256, BK = 64, HALF = 128, HTB = HALF * BK * 2  , STAGE_BYTES = 8 * HTB, NXCD = 8, WGM = 8;

__host__ __device__ __forceinline__ int lds_byte(int r, int c) { const int st = (r >> 4) * 2 + (c >> 5), rr = r & 15, cc = c & 31, ob = rr * 64 + cc * 2; return st * 1024 + (ob ^ (((ob >> 9) & 1) << 5)); }
__host__ __device__ __forceinline__ void stage_rc(int b, int& R, int& C) { const int st = b / 1024, sb = b % 1024, swz = sb ^ (((sb >> 9) & 1) << 5); R = (st >> 1) * 16 + swz / 64; C = (st & 1) * 32 + (swz % 64) / 2; }
__host__ __device__ __forceinline__ int perm32(int rho) { const int n = rho >> 4, i = rho & 15; return 8 * (i >> 2) + 4 * n + (i & 3); }

struct Unit { int pm, pn; };
struct Gemm { const bf16_t* A; const bf16_t* Bt; int M, N, K; };
struct StaticOrder {
    int nM, nN, nwg, G, c;
    __host__ __device__ void init(int M, int N, int G_, int c_) { nM = M / BM; nN = N / BM; nwg = nM * nN; G = G_; c = c_; }
    __host__ __device__ bool next(int i, Unit& u) const {
        const long L = (long)i * G + c; if (L >= nwg) return false;
        int wgid = (int)L; { const int q = nwg / NXCD, r = nwg % NXCD, xcd = wgid % NXCD, off = wgid / NXCD; wgid = (xcd < r ? xcd * (q + 1) : r * (q + 1) + (xcd - r) * q) + off; }
        const int nig = WGM * nN, gid = wgid / nig, fm = gid * WGM, gsz = (nM - fm) < WGM ? (nM - fm) : WGM;
        u.pm = fm + ((wgid % nig) % gsz); u.pn = (wgid % nig) / gsz; return true;
    }
    __device__ __forceinline__ void a_ready(const Unit&) const {}
    __device__ __forceinline__ void done(const Unit&) const {}
};
template <class Epi, class Sched, bool STAMP = false>
__device__ __forceinline__ void gemm_phase(PG8_LAS unsigned char* lds, const Gemm g, const Sched& S, const Epi& E, unsigned long long* stamps) {
    const int tid = threadIdx.x, wid = __builtin_amdgcn_readfirstlane(tid >> 6), lane = tid & 63, wr = wid >> 2, wc = wid & 3, fr = lane & 15, fq = lane >> 4;
    const int K = g.K, nt = K / BK;
    int ts_lo = 0, ts_hi = 0, nts = 0; const unsigned long long rt_entry = STAMP ? (unsigned long long)wall_clock64() : 0ull;
#define PG8_STAMP() do { if (STAMP && wid == 0 && nts < 64) { const unsigned long long _c = (unsigned long long)clock64(); \
        ts_lo = (lane == nts) ? (int)(unsigned)_c : ts_lo; ts_hi = (lane == nts) ? (int)(unsigned)(_c >> 32) : ts_hi; ++nts; } } while (0)
    PG8_STAMP();
    unsigned voffA[2], voffB[2];
#pragma unroll
    for (int i = 0; i < 2; ++i) { int R, C; stage_rc(tid * 16 + i * 8192, R, C); const int Rb = Epi::PERM ? ((R & ~31) + perm32(R & 31)) : R;
        voffA[i] = (unsigned)(R * K + C) * 2u; voffB[i] = (unsigned)(Rb * K + C) * 2u; }
    const size_t kstep = (size_t)(BK * 2);
    const size_t hstep = (size_t)HALF * K * 2;
    const size_t tstep = 2 * hstep;
    const unsigned ldsw = (unsigned)wid * 1024u;
    const int aoff = lds_byte(wr * 64 + fr, fq * 8), boff = lds_byte(wc * 32 + fr, fq * 8);
#define PG8_SA(b, h) (((b) * 2 + (h)) * HTB)
#define PG8_SB(b, h) ((4 + (b) * 2 + (h)) * HTB)
#define PG8_STAGE(bufoff, gbase, voff) do { _Pragma("unroll") for (int _i = 0; _i < 2; ++_i) \
        __builtin_amdgcn_global_load_lds((const unsigned*)((const char*)(gbase) + (voff)[_i]), (PG8_LAS unsigned*)(lds + (bufoff) + ldsw + _i * 8192), 16, 0, 0); } while (0)
#define PG8_LDA(dst, b, h) do { _Pragma("unroll") for (int m = 0; m < 4; ++m) _Pragma("unroll") for (int k = 0; k < 2; ++k) dst[m][k] = *(const PG8_LAS bf16x8*)(lds + PG8_SA(b, h) + aoff + m * 2048 + k * 1024); } while (0)
#define PG8_LDB(dst, b, h) do { _Pragma("unroll") for (int n = 0; n < 2; ++n) _Pragma("unroll") for (int k = 0; k < 2; ++k) dst[n][k] = *(const PG8_LAS bf16x8*)(lds + PG8_SB(b, h) + boff + n * 2048 + k * 1024); } while (0)
#define PG8_MMA(ai, bj, At, Bt) do { __builtin_amdgcn_s_setprio(1); _Pragma("unroll") for (int m = 0; m < 4; ++m) _Pragma("unroll") for (int n = 0; n < 2; ++n) _Pragma("unroll") for (int k = 0; k < 2; ++k) \
        acc[ai][bj][m][n] = __builtin_amdgcn_mfma_f32_16x16x32_bf16(Bt[n][k], At[m][k], acc[ai][bj][m][n], 0, 0, 0); __builtin_amdgcn_s_setprio(0); } while (0)
#define PG8_WAIT_V(n) asm volatile("s_waitcnt vmcnt(" #n ")" ::: "memory")
#define PG8_WAIT_L(n) asm volatile("s_waitcnt lgkmcnt(" #n ")" ::: "memory")
#define PG8_BAR __builtin_amdgcn_s_barrier()
#define PG8_SCHED __builtin_amdgcn_sched_barrier(0)
    Unit cur, nxt; int ui = 0;
    if (!S.next(0, cur)) return;
    f32x4 acc[2][2][4][2];
#pragma unroll
    for (int a = 0; a < 2; ++a)
#pragma unroll
        for (int b = 0; b < 2; ++b)
#pragma unroll
            for (int m = 0; m < 4; ++m)
#pragma unroll
                for (int n = 0; n < 2; ++n) acc[a][b][m][n] = (f32x4){0.f, 0.f, 0.f, 0.f};
    bf16x8 At[4][2], B0[2][2], B1[2][2];
    const char* cA = (const char*)g.A + (size_t)cur.pm * tstep; const char* cB = (const char*)g.Bt + (size_t)cur.pn * tstep;
    S.a_ready(cur);
    PG8_STAGE(PG8_SB(0, 0), cB, voffB); PG8_STAGE(PG8_SA(0, 0), cA, voffA); PG8_STAGE(PG8_SB(0, 1), cB + hstep, voffB); PG8_STAGE(PG8_SA(0, 1), cA + hstep, voffA);
    if (wr == 1) PG8_BAR;
    PG8_WAIT_V(4); PG8_BAR;
    PG8_STAGE(PG8_SB(1, 0), cB + kstep, voffB); PG8_STAGE(PG8_SA(1, 0), cA + kstep, voffA); PG8_STAGE(PG8_SB(1, 1), cB + hstep + kstep, voffB);
    PG8_WAIT_V(6); PG8_BAR;
    PG8_STAMP();
    for (;;) {
        const bool has_next = S.next(ui + 1, nxt);
        const char* nA = has_next ? (const char*)g.A + (size_t)nxt.pm * tstep : cA; const char* nB = has_next ? (const char*)g.Bt + (size_t)nxt.pn * tstep : cB;
        for (int t = 0; t < nt; t += 2) {
            const bool last = (t == nt - 2);
            const char* a1 = cA + (size_t)(t + 1) * kstep;
            const char* a2 = last ? nA : cA + (size_t)(t + 2) * kstep; const char* b2 = last ? nB : cB + (size_t)(t + 2) * kstep;
            const char* a3 = a2 + kstep; const char* b3 = b2 + kstep;
            if (last && has_next) S.a_ready(nxt);
            PG8_LDB(B0, 0, 0); PG8_SCHED; PG8_LDA(At, 0, 0); PG8_STAGE(PG8_SA(1, 1), a1 + hstep, voffA);
            PG8_WAIT_L(8); PG8_BAR; PG8_WAIT_L(0); PG8_MMA(0, 0, At, B0); PG8_BAR; PG8_SCHED;
            PG8_LDB(B1, 0, 1); PG8_STAGE(PG8_SB(0, 0), b2, voffB);
            PG8_BAR; PG8_WAIT_L(0); PG8_MMA(0, 1, At, B1); PG8_BAR;
            PG8_LDA(At, 0, 1); PG8_STAGE(PG8_SA(0, 0), a2, voffA);
            PG8_BAR; PG8_WAIT_L(0); PG8_MMA(1, 0, At, B0); PG8_BAR; PG8_SCHED;
            PG8_STAGE(PG8_SB(0, 1), b2 + hstep, voffB);
            PG8_WAIT_V(6); PG8_BAR; PG8_MMA(1, 1, At, B1); PG8_BAR;
            PG8_LDB(B0, 1, 0); PG8_SCHED; PG8_LDA(At, 1, 0); PG8_STAGE(PG8_SA(0, 1), a2 + hstep, voffA);
            PG8_WAIT_L(8); PG8_BAR; PG8_WAIT_L(0); PG8_MMA(0, 0, At, B0); PG8_BAR; PG8_SCHED;
            PG8_LDB(B1, 1, 1); PG8_STAGE(PG8_SB(1, 0), b3, voffB);
            PG8_BAR; PG8_WAIT_L(0); PG8_MMA(0, 1, At, B1); PG8_BAR;
            PG8_LDA(At, 1, 1); PG8_STAGE(PG8_SA(1, 0), a3, voffA);
            PG8_BAR; PG8_WAIT_L(0); PG8_MMA(1, 0, At, B0); PG8_BAR; PG8_SCHED;
            PG8_STAGE(PG8_SB(1, 1), b3 + hstep, voffB);
            PG8_WAIT_V(6); PG8_BAR; PG8_MMA(1, 1, At, B1); PG8_BAR;
        }
        PG8_STAMP();
        if constexpr (!Epi::AFTER_DRAIN) { E(acc, cur, wr, wc, fr, fq); S.done(cur); }
        PG8_STAMP();
        if (!has_next) break;
#pragma unroll
        for (int a = 0; a < 2; ++a)
#pragma unroll
            for (int b = 0; b < 2; ++b)
#pragma unroll
                for (int m = 0; m < 4; ++m)
#pragma unroll
                    for (int n = 0; n < 2; ++n) acc[a][b][m][n] = (f32x4){0.f, 0.f, 0.f, 0.f};
        cur = nxt; cA = nA; cB = nB; ++ui;
    }
    PG8_WAIT_V(0);
    if (wr == 0) PG8_BAR;
    PG8_BAR;
    if constexpr (Epi::AFTER_DRAIN) { E.fused(acc, cur, wr, wc, fr, fq, lds, wid, lane); S.done(cur); }
    PG8_STAMP();
    if (STAMP && wid == 0) { stamps[lane] = lane < nts ? (((unsigned long long)(unsigned)ts_hi << 32) | (unsigned)ts_lo) : 0ull;
        if (lane == 62) stamps[62] = rt_entry; if (lane == 63) stamps[63] = (unsigned long long)wall_clock64(); }
#undef PG8_STAMP
#undef PG8_SA
#undef PG8_SB
#undef PG8_STAGE
#undef PG8_LDA
#undef PG8_LDB
#undef PG8_MMA
#undef PG8_WAIT_V
#undef PG8_WAIT_L
#undef PG8_BAR
#undef PG8_SCHED
}
}
namespace pg8 {
struct UnitX { int pm, pn, kind; };
struct GDesc { const bf16_t* A; const bf16_t* Bt; int ks; };
__device__ __forceinline__ void map_unit(int L, int nM, int nN, int& pm, int& pn) {
    const int nwg = nM * nN; int wgid = L; { const int q = nwg / NXCD, r = nwg % NXCD, xcd = wgid % NXCD, off = wgid / NXCD; wgid = (xcd < r ? xcd * (q + 1) : r * (q + 1) + (xcd - r) * q) + off; }
    const int nig = WGM * nN, gid = wgid / nig, fm = gid * WGM, gsz = (nM - fm) < WGM ? (nM - fm) : WGM;
    pm = fm + ((wgid % nig) % gsz); pn = (wgid % nig) / gsz;
}
template <class Epi, class Sched>
__device__ __forceinline__ void gemm_stream(PG8_LAS unsigned char* lds, const Sched& S, const Epi& E) {
    const int tid = threadIdx.x, wid = __builtin_amdgcn_readfirstlane(tid >> 6), lane = tid & 63, wr = wid >> 2, wc = wid & 3, fr = lane & 15, fq = lane >> 4;
    const size_t kstep = (size_t)(BK * 2);
    const unsigned ldsw = (unsigned)wid * 1024u;
    const int aoff = lds_byte(wr * 64 + fr, fq * 8), boff = lds_byte(wc * 32 + fr, fq * 8);
#define PG8_SA(b, h) (((b) * 2 + (h)) * HTB)
#define PG8_SB(b, h) ((4 + (b) * 2 + (h)) * HTB)
#define PG8_STAGE(bufoff, gbase, voff) do { _Pragma("unroll") for (int _i = 0; _i < 2; ++_i) \
        __builtin_amdgcn_global_load_lds((const unsigned*)((const char*)(gbase) + (voff)[_i]), (PG8_LAS unsigned*)(lds + (bufoff) + ldsw + _i * 8192), 16, 0, 0); } while (0)
#define PG8_LDA(dst, b, h) do { _Pragma("unroll") for (int m = 0; m < 4; ++m) _Pragma("unroll") for (int k = 0; k < 2; ++k) dst[m][k] = *(const PG8_LAS bf16x8*)(lds + PG8_SA(b, h) + aoff + m * 2048 + k * 1024); } while (0)
#define PG8_LDB(dst, b, h) do { _Pragma("unroll") for (int n = 0; n < 2; ++n) _Pragma("unroll") for (int k = 0; k < 2; ++k) dst[n][k] = *(const PG8_LAS bf16x8*)(lds + PG8_SB(b, h) + boff + n * 2048 + k * 1024); } while (0)
#define PG8_MMA(ai, bj, At, Bt) do { __builtin_amdgcn_s_setprio(1); _Pragma("unroll") for (int m = 0; m < 4; ++m) _Pragma("unroll") for (int n = 0; n < 2; ++n) _Pragma("unroll") for (int k = 0; k < 2; ++k) \
        acc[ai][bj][m][n] = __builtin_amdgcn_mfma_f32_16x16x32_bf16(Bt[n][k], At[m][k], acc[ai][bj][m][n], 0, 0, 0); __builtin_amdgcn_s_setprio(0); } while (0)
#define PG8_WAIT_V(n) asm volatile("s_waitcnt vmcnt(" #n ")" ::: "memory")
#define PG8_WAIT_L(n) asm volatile("s_waitcnt lgkmcnt(" #n ")" ::: "memory")
#define PG8_BAR __builtin_amdgcn_s_barrier()
#define PG8_SCHED __builtin_amdgcn_sched_barrier(0)
    UnitX cur, nxt; int ui = 0;
    if (!S.next(0, cur)) return;
    f32x4 acc[2][2][4][2];
#pragma unroll
    for (int a = 0; a < 2; ++a)
#pragma unroll
        for (int b = 0; b < 2; ++b)
#pragma unroll
            for (int m = 0; m < 4; ++m)
#pragma unroll
                for (int n = 0; n < 2; ++n) acc[a][b][m][n] = (f32x4){0.f, 0.f, 0.f, 0.f};
    bf16x8 At[4][2], B0[2][2], B1[2][2];
    GDesc dc = S.desc(cur.kind);
    int ksC = dc.ks; size_t hsC = (size_t)HALF * ksC * 2;
    unsigned vAc[2], vBc[2];
#pragma unroll
    for (int i = 0; i < 2; ++i) { int R, C; stage_rc(tid * 16 + i * 8192, R, C); const int Rb = (R & ~31) + perm32(R & 31);
        vAc[i] = (unsigned)(R * ksC + C) * 2u; vBc[i] = (unsigned)(Rb * ksC + C) * 2u; }
    int shC = 31 - __builtin_clz((unsigned)ksC * 2u);
    const char* cA = (const char*)dc.A + (size_t)cur.pm * 2 * hsC; const char* cB = (const char*)dc.Bt + (size_t)cur.pn * 2 * hsC;
    PG8_STAGE(PG8_SB(0, 0), cB, vBc); PG8_STAGE(PG8_SA(0, 0), cA, vAc); PG8_STAGE(PG8_SB(0, 1), cB + hsC, vBc); PG8_STAGE(PG8_SA(0, 1), cA + hsC, vAc);
    if (wr == 1) PG8_BAR;
    PG8_WAIT_V(4); PG8_BAR;
    PG8_STAGE(PG8_SB(1, 0), cB + kstep, vBc); PG8_STAGE(PG8_SA(1, 0), cA + kstep, vAc); PG8_STAGE(PG8_SB(1, 1), cB + hsC + kstep, vBc);
    PG8_WAIT_V(6); PG8_BAR;
    for (;;) {
        const bool has_next = S.next(ui + 1, nxt);
        const char* nA = cA; const char* nB = cB; int ksN = ksC; size_t hsN = hsC;
        if (has_next) { const GDesc dn = S.desc(nxt.kind); ksN = dn.ks; hsN = (size_t)HALF * ksN * 2;
            nA = (const char*)dn.A + (size_t)nxt.pm * 2 * hsN; nB = (const char*)dn.Bt + (size_t)nxt.pn * 2 * hsN; }
        const int shN = 31 - __builtin_clz((unsigned)ksN * 2u); const unsigned cmask = (unsigned)ksC * 2u - 1u;
        const int nt = ksC / BK;
        for (int t = 0; t < nt; t += 2) {
            const bool last = (t == nt - 2);
            const char* a1 = cA + (size_t)(t + 1) * kstep;
            const char* a2 = last ? nA : cA + (size_t)(t + 2) * kstep; const char* b2 = last ? nB : cB + (size_t)(t + 2) * kstep;
            const char* a3 = a2 + kstep; const char* b3 = b2 + kstep;
            const size_t hs2 = last ? hsN : hsC;
            unsigned vA2[2], vB2[2];
#pragma unroll
            for (int i = 0; i < 2; ++i) { vA2[i] = last ? (((vAc[i] >> shC) << shN) | (vAc[i] & cmask)) : vAc[i]; vB2[i] = last ? (((vBc[i] >> shC) << shN) | (vBc[i] & cmask)) : vBc[i]; }
            PG8_LDB(B0, 0, 0); PG8_SCHED; PG8_LDA(At, 0, 0); PG8_STAGE(PG8_SA(1, 1), a1 + hsC, vAc);
            PG8_WAIT_L(8); PG8_BAR; PG8_WAIT_L(0); PG8_MMA(0, 0, At, B0); PG8_BAR; PG8_SCHED;
            PG8_LDB(B1, 0, 1); PG8_STAGE(PG8_SB(0, 0), b2, vB2);
            PG8_BAR; PG8_WAIT_L(0); PG8_MMA(0, 1, At, B1); PG8_BAR;
            PG8_LDA(At, 0, 1); PG8_STAGE(PG8_SA(0, 0), a2, vA2);
            PG8_BAR; PG8_WAIT_L(0); PG8_MMA(1, 0, At, B0); PG8_BAR; PG8_SCHED;
            PG8_STAGE(PG8_SB(0, 1), b2 + hs2, vB2);
            PG8_WAIT_V(6); PG8_BAR; PG8_MMA(1, 1, At, B1); PG8_BAR;
            PG8_LDB(B0, 1, 0); PG8_SCHED; PG8_LDA(At, 1, 0); PG8_STAGE(PG8_SA(0, 1), a2 + hs2, vA2);
            PG8_WAIT_L(8); PG8_BAR; PG8_WAIT_L(0); PG8_MMA(0, 0, At, B0); PG8_BAR; PG8_SCHED;
            PG8_LDB(B1, 1, 1); PG8_STAGE(PG8_SB(1, 0), b3, vB2);
            PG8_BAR; PG8_WAIT_L(0); PG8_MMA(0, 1, At, B1); PG8_BAR;
            PG8_LDA(At, 1, 1); PG8_STAGE(PG8_SA(1, 0), a3, vA2);
            PG8_BAR; PG8_WAIT_L(0); PG8_MMA(1, 0, At, B0); PG8_BAR; PG8_SCHED;
            PG8_STAGE(PG8_SB(1, 1), b3 + hs2, vB2);
            PG8_WAIT_V(6); PG8_BAR; PG8_MMA(1, 1, At, B1); PG8_BAR;
        }
        E(acc, cur, wr, wc, fr, fq);
        if (!has_next) break;
#pragma unroll
        for (int a = 0; a < 2; ++a)
#pragma unroll
            for (int b = 0; b < 2; ++b)
#pragma unroll
                for (int m = 0; m < 4; ++m)
#pragma unroll
                    for (int n = 0; n < 2; ++n) acc[a][b][m][n] = (f32x4){0.f, 0.f, 0.f, 0.f};
#pragma unroll
        for (int i = 0; i < 2; ++i) { vAc[i] = ((vAc[i] >> shC) << shN) | (vAc[i] & cmask); vBc[i] = ((vBc[i] >> shC) << shN) | (vBc[i] & cmask); }
        cur = nxt; cA = nA; cB = nB; ksC = ksN; hsC = hsN; shC = shN; ++ui;
    }
    PG8_WAIT_V(0);
    if (wr == 0) PG8_BAR;
    PG8_BAR;
#undef PG8_SA
#undef PG8_SB
#undef PG8_STAGE
#undef PG8_LDA
#undef PG8_LDB
#undef PG8_MMA
#undef PG8_WAIT_V
#undef PG8_WAIT_L
#undef PG8_BAR
#undef PG8_SCHED
}
}
#define XB_TMO      128
#define XB_XCNT(j)  (256  + 64 * (j))
#define XB_XSUB(j)  (1280 + 64 * (j))
#define XB_XGEN(j)  (2304 + 64 * (j))
#define XB_TOP      3328
#define XB_TOPGEN   3392
#define XCD_BAR_WORDS 3456
#define XB_SPIN_CAP (1u << 18)
#define LAS __attribute__((address_space(3)))
__device__ __forceinline__ unsigned xb_ld(unsigned* p)              { return __hip_atomic_load(p, __ATOMIC_RELAXED, __HIP_MEMORY_SCOPE_AGENT); }
__device__ __forceinline__ unsigned xb_add(unsigned* p, unsigned v) { return __hip_atomic_fetch_add(p, v, __ATOMIC_RELAXED, __HIP_MEMORY_SCOPE_AGENT); }
__device__ __forceinline__ unsigned xb_xcc_id() { return (unsigned)__builtin_amdgcn_s_getreg((3 << 11) | 20) & 0xFu; }
#define XB_SPIN(cond, bar) do { unsigned _sp = 0; while (cond) { __builtin_amdgcn_s_sleep(1); \
    if ((++_sp & 255u) == 0u) { if (xb_ld(&(bar)[XB_TMO])) break; if (_sp > XB_SPIN_CAP) { atomicAdd(&(bar)[XB_TMO], 1u); break; } } } } while (0)

struct XcdBarrier {
    unsigned* bar; unsigned x;
    volatile LAS unsigned* st;
};

__device__ __forceinline__ XcdBarrier xcd_barrier_post(unsigned* bar, volatile LAS unsigned* st) {
    XcdBarrier b; b.bar = bar; b.x = xb_xcc_id(); b.st = st;
    if (threadIdx.x == 0) (void)xb_add(&bar[XB_XCNT(b.x)], 1u);
    return b;
}
__device__ __forceinline__ void xcd_barrier_complete(unsigned* bar, unsigned x, unsigned& nloc, unsigned& nx) {
    const unsigned G = gridDim.x * gridDim.y * gridDim.z;
    unsigned sum, cnt, mine, sp = 0u;
    for (;;) {
        sum = 0u; cnt = 0u; mine = 0u;
#pragma unroll
        for (unsigned j = 0; j < 16; ++j) { const unsigned c = xb_ld(&bar[XB_XCNT(j)]); sum += c; cnt += (c > 0u) ? 1u : 0u; mine = (j == x) ? c : mine; }
        if (sum == G) break;
        __builtin_amdgcn_s_sleep(1);
        if ((++sp & 255u) == 0u) { if (xb_ld(&bar[XB_TMO])) break; if (sp > XB_SPIN_CAP) { atomicAdd(&bar[XB_TMO], 1u); break; } }
    }
    nloc = mine > 0u ? mine : 1u; nx = cnt > 0u ? cnt : 1u;
}

template <class F> __device__ __forceinline__ void xcd_barrier(const XcdBarrier& b, F&& shadow) {
    asm volatile("s_waitcnt vmcnt(0)" ::: "memory");
    __syncthreads();
    if (threadIdx.x == 0) {
        unsigned* bar = b.bar;
        __builtin_amdgcn_s_waitcnt(0);
        unsigned nloc = b.st[0], nx = b.st[1];
        if (nloc == 0u) { xcd_barrier_complete(bar, b.x, nloc, nx); b.st[0] = nloc; b.st[1] = nx; }
        const unsigned old = xb_add(&bar[XB_XSUB(b.x)], 1u);
        const unsigned gen = old / nloc;
        if (old + 1u == (gen + 1u) * nloc) {
            __builtin_amdgcn_fence(__ATOMIC_RELEASE, "agent");
            asm volatile("s_waitcnt vmcnt(0)" ::: "memory");
            const unsigned og = xb_add(&bar[XB_TOP], 1u);
            const unsigned tg = og / nx;
            if (og + 1u == (tg + 1u) * nx) xb_add(&bar[XB_TOPGEN], 1u);
            else XB_SPIN(xb_ld(&bar[XB_TOPGEN]) == tg, bar);
            __builtin_amdgcn_fence(__ATOMIC_ACQUIRE, "agent");
            xb_add(&bar[XB_XGEN(b.x)], 1u);
            asm volatile("s_waitcnt vmcnt(0)" ::: "memory");
        } else {
            XB_SPIN(xb_ld(&bar[XB_XGEN(b.x)]) == gen, bar);
            __builtin_amdgcn_fence(__ATOMIC_ACQUIRE, "agent");
            asm volatile("s_waitcnt vmcnt(0)" ::: "memory");
        }
    } else if (threadIdx.x >= 64) shadow();
    __syncthreads();
}
using pg8::f32x4; using pg8::u32x4; using pg8::bf16_t; using pg8::Unit;
#define DI __device__ __forceinline__
constexpr int M_TOK = 16384, DM = 1024, SEQ = 2048, NPHASE = 10;
constexpr float EPS = 1e-6f;
constexpr int LDS_ST = 147456, LDS_BYTES = LDS_ST + 16;
constexpr size_t MiB = 1024 * 1024;
constexpr size_t OFF_WIN1 = 0, OFF_WAOUT = 4 * MiB, OFF_WPLE0 = 6 * MiB, OFF_WPLE1 = 6 * MiB + 512 * 1024, OFF_WG0 = 7 * MiB, OFF_WG1 = 9 * MiB,
                 OFF_WKQZ = 11 * MiB, OFF_WV = 17 * MiB, OFF_WBOUT = 19 * MiB, OFF_PB = 21 * MiB, OFF_R1 = 37 * MiB, OFF_R2 = 69 * MiB, OFF_R3 = 101 * MiB,
                 OFF_R4 = 133 * MiB, OFF_RSTD0 = 197 * MiB, OFF_RSTD1 = 197 * MiB + 65536, OFF_SSP = 197 * MiB + 131072, OFF_BAR = 199 * MiB, OFF_E1 = 200 * MiB, WS_END = 232 * MiB;

struct Params {
    const float *x, *p, *a_norm, *a_w_in, *a_w_group, *a_scale, *a_w_out, *kv_norm, *w_kv, *k_norm, *b_norm, *b_w_in, *b_q_norm, *b_w_out, *ple_w, *ple_gate_w;
    float* out; unsigned char* ws; int ph_lo, ph_hi;
};

typedef __bf16 bf16x2_t __attribute__((ext_vector_type(2)));
typedef float f32x2_t __attribute__((ext_vector_type(2)));
typedef unsigned u32x2_t __attribute__((ext_vector_type(2)));
typedef short s16x8 __attribute__((ext_vector_type(8)));
typedef short s16x4 __attribute__((ext_vector_type(4)));
typedef float f32x16 __attribute__((ext_vector_type(16)));
DI unsigned pk2(float lo, float hi) { f32x2_t v = {lo, hi}; bf16x2_t r = __builtin_convertvector(v, bf16x2_t); return __builtin_bit_cast(unsigned, r); }
DI float bflo(unsigned u) { return __uint_as_float(u << 16); }
DI float bfhi(unsigned u) { return __uint_as_float(u & 0xffff0000u); }
DI u32x4 pk8(f32x4 a, f32x4 b) { u32x4 w; w.x = pk2(a[0], a[1]); w.y = pk2(a[2], a[3]); w.z = pk2(b[0], b[1]); w.w = pk2(b[2], b[3]); return w; }
DI float wave_sum(float v) {
#pragma unroll
    for (int o = 1; o < 64; o <<= 1) v += __shfl_xor(v, o);
    return v;
}
DI float sigm(float v) { return __builtin_amdgcn_rcpf(1.f + __expf(-v)); }
DI f32x4 silu4(f32x4 v) { f32x4 r; r[0] = v[0] * sigm(v[0]); r[1] = v[1] * sigm(v[1]); r[2] = v[2] * sigm(v[2]); r[3] = v[3] * sigm(v[3]); return r; }
DI f32x4 sigm4(f32x4 v) { f32x4 r; r[0] = sigm(v[0]); r[1] = sigm(v[1]); r[2] = sigm(v[2]); r[3] = sigm(v[3]); return r; }

typedef const f32x4 (&AccRef)[2][2][4][2];

struct Epi1 {
    static constexpr bool PERM = true, AFTER_DRAIN = false;
    bf16_t* ug; bf16_t* sz; const float* rstd0;
    DI void operator()(AccRef acc, const Unit& u, int wr, int wc, int fr, int fq) const {
        const int row0 = u.pm * 256 + wr * 64 + fr; const bool isz = u.pn >= 4;
        bf16_t* base = (isz ? sz : ug) + (u.pn & 3) * 256 + wc * 32 + 8 * fq;
        float rsv[2][4];
#pragma unroll
        for (int ai = 0; ai < 2; ++ai)
#pragma unroll
            for (int m = 0; m < 4; ++m) rsv[ai][m] = rstd0[row0 + ai * 128 + m * 16];
#pragma unroll
        for (int ai = 0; ai < 2; ++ai)
#pragma unroll
            for (int m = 0; m < 4; ++m) { const int row = row0 + ai * 128 + m * 16; const float rs = rsv[ai][m]; bf16_t* rowp = base + (size_t)row * DM;
#pragma unroll
                for (int bj = 0; bj < 2; ++bj) { f32x4 v0 = acc[ai][bj][m][0] * rs, v1 = acc[ai][bj][m][1] * rs;
                    if (isz) { v0 = silu4(v0); v1 = silu4(v1); }
                    *(u32x4*)(rowp + bj * 128) = pk8(v0, v1); } }
    }
};
struct EpiE {
    static constexpr bool PERM = true, AFTER_DRAIN = false;
    bf16_t* e;
    DI void operator()(AccRef acc, const Unit& u, int wr, int wc, int fr, int fq) const {
        const int row0 = u.pm * 256 + wr * 64 + fr; bf16_t* base = e + u.pn * 256 + wc * 32 + 8 * fq;
#pragma unroll
        for (int ai = 0; ai < 2; ++ai)
#pragma unroll
            for (int m = 0; m < 4; ++m) { bf16_t* rowp = base + (size_t)(row0 + ai * 128 + m * 16) * DM;
#pragma unroll
                for (int bj = 0; bj < 2; ++bj) *(u32x4*)(rowp + bj * 128) = pk8(acc[ai][bj][m][0], acc[ai][bj][m][1]); }
    }
};
DI void unpk8(const u32x4 q, f32x4& lo, f32x4& hi) { lo = (f32x4){bflo(q.x), bfhi(q.x), bflo(q.y), bfhi(q.y)}; hi = (f32x4){bflo(q.z), bfhi(q.z), bflo(q.w), bfhi(q.w)}; }
template <bool SRCF32> struct EpiResB {
    static constexpr bool PERM = true, AFTER_DRAIN = false;
    const float* srcf; const bf16_t* srcb; bf16_t* xb;
    DI void operator()(AccRef acc, const Unit& u, int wr, int wc, int fr, int fq) const {
        const int row0 = u.pm * 256 + wr * 64 + fr, col0 = u.pn * 256 + wc * 32 + 8 * fq;
#pragma unroll
        for (int ai = 0; ai < 2; ++ai) {
            f32x4 a[4][2][2];
#pragma unroll
            for (int m = 0; m < 4; ++m) { const size_t o = (size_t)(row0 + ai * 128 + m * 16) * DM + col0;
#pragma unroll
                for (int bj = 0; bj < 2; ++bj) {
                    if (SRCF32) { a[m][bj][0] = *(const f32x4*)(srcf + o + bj * 128); a[m][bj][1] = *(const f32x4*)(srcf + o + bj * 128 + 4); }
                    else { const u32x4 q = *(const u32x4*)(srcb + o + bj * 128); unpk8(q, a[m][bj][0], a[m][bj][1]); } } }
#pragma unroll
            for (int m = 0; m < 4; ++m) { const size_t o = (size_t)(row0 + ai * 128 + m * 16) * DM + col0;
#pragma unroll
                for (int bj = 0; bj < 2; ++bj) *(u32x4*)(xb + o + bj * 128) = pk8(a[m][bj][0] + acc[ai][bj][m][0], a[m][bj][1] + acc[ai][bj][m][1]); }
        }
    }
};
template <bool NEXT> struct EpiGate {
    static constexpr bool PERM = true, AFTER_DRAIN = false;
    const bf16_t* xin; const bf16_t* e; bf16_t* xb; float* ssp; float* outf;
    DI void operator()(AccRef acc, const Unit& u, int wr, int wc, int fr, int fq) const {
        const int row0 = u.pm * 256 + wr * 64 + fr, col0 = u.pn * 256 + wc * 32 + 8 * fq;
#pragma unroll
        for (int ai = 0; ai < 2; ++ai) {
            u32x4 xv[4][2], ev[4][2];
#pragma unroll
            for (int m = 0; m < 4; ++m) { const size_t o = (size_t)(row0 + ai * 128 + m * 16) * DM + col0;
#pragma unroll
                for (int bj = 0; bj < 2; ++bj) { xv[m][bj] = *(const u32x4*)(xin + o + bj * 128); ev[m][bj] = *(const u32x4*)(e + o + bj * 128); } }
#pragma unroll
            for (int m = 0; m < 4; ++m) { const int row = row0 + ai * 128 + m * 16; const size_t o = (size_t)row * DM + col0; float ss = 0.f;
#pragma unroll
                for (int bj = 0; bj < 2; ++bj) { f32x4 a0, a1, e0, e1; unpk8(xv[m][bj], a0, a1); unpk8(ev[m][bj], e0, e1);
                    const f32x4 v0 = a0 + e0 * sigm4(acc[ai][bj][m][0]), v1 = a1 + e1 * sigm4(acc[ai][bj][m][1]);
                    if (NEXT) { *(u32x4*)(xb + o + bj * 128) = pk8(v0, v1);
                        ss += (v0[0] * v0[0] + v0[1] * v0[1]) + (v0[2] * v0[2] + v0[3] * v0[3]) + (v1[0] * v1[0] + v1[1] * v1[1]) + (v1[2] * v1[2] + v1[3] * v1[3]); }
                    else { *(f32x4*)(outf + o + bj * 128) = v0; *(f32x4*)(outf + o + bj * 128 + 4) = v1; } }
                if (NEXT) { ss += __shfl_xor(ss, 16); ss += __shfl_xor(ss, 32); if (fq == 0) atomicAdd(ssp + row, ss); } }
        }
    }
};
struct EpiKQZ {
    static constexpr bool PERM = true, AFTER_DRAIN = false;
    bf16_t *kk, *qq, *sz2; const float *rstd1, *k_norm, *q_norm;
    DI void operator()(AccRef acc, const Unit& u, int wr, int wc, int fr, int fq) const {
        const int row0 = u.pm * 256 + wr * 64 + fr, kind = u.pn >> 2, pq = u.pn & 3;
        float rsv[2][4];
#pragma unroll
        for (int ai = 0; ai < 2; ++ai)
#pragma unroll
            for (int m = 0; m < 4; ++m) rsv[ai][m] = rstd1[row0 + ai * 128 + m * 16];
        if (kind == 2) {
            bf16_t* base = sz2 + pq * 256 + 64 * wc + 8 * fq;
#pragma unroll
            for (int ai = 0; ai < 2; ++ai)
#pragma unroll
                for (int m = 0; m < 4; ++m) { const int row = row0 + ai * 128 + m * 16; const float rs = rsqrtf(rsv[ai][m] * (1.f / DM) + EPS); bf16_t* rowp = base + (size_t)row * DM;
#pragma unroll
                    for (int bj = 0; bj < 2; ++bj) *(u32x4*)(rowp + bj * 32) = pk8(silu4(acc[ai][bj][m][0] * rs), silu4(acc[ai][bj][m][1] * rs)); }
        } else {
            const float* gn = kind ? q_norm : k_norm; const float mul = kind ? 0.125f * 1.4426950408889634f : 1.f;
            bf16_t* dst = kind ? qq : kk; const int head = pq * 4 + wc;
            f32x4 g[2][2];
#pragma unroll
            for (int bj = 0; bj < 2; ++bj)
#pragma unroll
                for (int n = 0; n < 2; ++n) g[bj][n] = *(const f32x4*)(gn + 32 * bj + 8 * fq + 4 * n) * mul;
#pragma unroll
            for (int ai = 0; ai < 2; ++ai)
#pragma unroll
                for (int m = 0; m < 4; ++m) { const int row = row0 + ai * 128 + m * 16; const float rs = rsqrtf(rsv[ai][m] * (1.f / DM) + EPS); const int b = row >> 11, s = row & 2047;
                    f32x4 v[2][2]; float ss = 0.f;
#pragma unroll
                    for (int bj = 0; bj < 2; ++bj)
#pragma unroll
                        for (int n = 0; n < 2; ++n) { v[bj][n] = acc[ai][bj][m][n] * rs; ss += (v[bj][n][0] * v[bj][n][0] + v[bj][n][1] * v[bj][n][1]) + (v[bj][n][2] * v[bj][n][2] + v[bj][n][3] * v[bj][n][3]); }
                    ss += __shfl_xor(ss, 16); ss += __shfl_xor(ss, 32);
                    const float hr = rsqrtf(ss * (1.f / 64.f) + EPS);
                    bf16_t* rowp = dst + ((size_t)(b * 16 + head) * SEQ + s) * 64 + 8 * fq;
#pragma unroll
                    for (int bj = 0; bj < 2; ++bj) *(u32x4*)(rowp + 32 * bj) = pk8(v[bj][0] * hr * g[bj][0], v[bj][1] * hr * g[bj][1]); }
        }
    }
};
struct EpiVT {
    static constexpr bool PERM = true, AFTER_DRAIN = false;
    bf16_t* vt; const float* rstd1;
    DI void operator()(AccRef acc, const Unit& u, int wr, int wc, int fr, int fq) const {
        const int c0 = u.pm * 256 + wr * 64 + fr, tok0 = u.pn * 256 + wc * 32 + 8 * fq;
        f32x4 rs[2][2];
#pragma unroll
        for (int bj = 0; bj < 2; ++bj)
#pragma unroll
            for (int n = 0; n < 2; ++n) { const f32x4 q = *(const f32x4*)(rstd1 + tok0 + 128 * bj + 4 * n);
#pragma unroll
                for (int j = 0; j < 4; ++j) rs[bj][n][j] = rsqrtf(q[j] * (1.f / DM) + EPS); }
#pragma unroll
        for (int ai = 0; ai < 2; ++ai)
#pragma unroll
            for (int m = 0; m < 4; ++m) { const int c = c0 + ai * 128 + m * 16;
#pragma unroll
                for (int bj = 0; bj < 2; ++bj) { const int tok = tok0 + 128 * bj, b = tok >> 11, s = tok & 2047;
                    *(u32x4*)(vt + ((size_t)b * DM + c) * SEQ + s) = pk8(acc[ai][bj][m][0] * rs[bj][0], acc[ai][bj][m][1] * rs[bj][1]); } }
    }
};
template <class Epi> DI void run_gemm(PG8_LAS unsigned char* lds, const bf16_t* A, const bf16_t* Bt, int M, int N, int K, const Epi& E) {
    pg8::Gemm g{A, Bt, M, N, K}; pg8::StaticOrder S; S.init(M, N, (int)gridDim.x, (int)blockIdx.x);
    pg8::gemm_phase<Epi, pg8::StaticOrder, false>(lds, g, S, E, nullptr);
}

struct SchedPG {
    const unsigned char* ws; int layer, G, c;
    DI bool next(int i, pg8::UnitX& u) const { const int L = i * G + c; if (L >= 512) return false;
        pg8::map_unit(L & 255, 64, 4, u.pm, u.pn); u.kind = L >> 8; return true; }
    DI pg8::GDesc desc(int k) const { pg8::GDesc d;
        const size_t oa = k == 0 ? OFF_PB + (size_t)layer * M_TOK * 256 * 2 : OFF_R2, ob = k == 0 ? (layer ? OFF_WPLE1 : OFF_WPLE0) : (layer ? OFF_WG1 : OFF_WG0);
        d.A = (const bf16_t*)(ws + oa); d.Bt = (const bf16_t*)(ws + ob); d.ks = k == 0 ? 256 : 1024; return d; }
    DI void a_ready(const pg8::UnitX&) const {}
    DI void done(const pg8::UnitX&) const {}
};
template <bool NEXT> struct EpiPG {
    static constexpr bool PERM = true;
    EpiE e; EpiGate<NEXT> g;
    DI void operator()(AccRef acc, const pg8::UnitX& u, int wr, int wc, int fr, int fq) const { const Unit uu{u.pm, u.pn};
        if (u.kind == 0) e(acc, uu, wr, wc, fr, fq); else g(acc, uu, wr, wc, fr, fq); }
};
struct SchedP6 {
    const unsigned char* ws; int G, c;
    DI bool next(int i, pg8::UnitX& u) const { const int L = i * G + c; if (L >= 1024) return false;
        if (L < 768) { pg8::map_unit(L, 64, 12, u.pm, u.pn); u.kind = 0; } else { pg8::map_unit(L - 768, 4, 64, u.pm, u.pn); u.kind = 1; }
        return true; }
    DI pg8::GDesc desc(int k) const { pg8::GDesc d; d.A = (const bf16_t*)(ws + (k == 0 ? OFF_R3 : OFF_WV)); d.Bt = (const bf16_t*)(ws + (k == 0 ? OFF_WKQZ : OFF_R3)); d.ks = 1024; return d; }
};
struct EpiP6 {
    static constexpr bool PERM = true;
    EpiKQZ a; EpiVT b;
    DI void operator()(AccRef acc, const pg8::UnitX& u, int wr, int wc, int fr, int fq) const { const Unit uu{u.pm, u.pn};
        if (u.kind == 0) a(acc, uu, wr, wc, fr, fq); else b(acc, uu, wr, wc, fr, fq); }
};

DI int headperm(int cl) { const int o = cl & 255, wc = o >> 6, bj = (o >> 5) & 1, r = o & 31; return (cl & ~255) + 128 * bj + 32 * wc + r; }
DI void transpose_item(float* scr, const float* src, int ld, int K, int nT, const float* gain, bf16_t* dst, int rowoff, bool perm, int item, int lane) {
    const int kt = item / nT, nt = item - kt * nT, k0 = kt * 64, n0 = nt * 32, lr = lane >> 3, lc = lane & 7;
    float4 v[8];
#pragma unroll
    for (int i = 0; i < 8; ++i) v[i] = *(const float4*)(src + (size_t)(k0 + i * 8 + lr) * ld + n0 + lc * 4);
    float gk[8];
#pragma unroll
    for (int i = 0; i < 8; ++i) gk[i] = gain ? gain[k0 + 8 * lc + i] : 1.f;
#pragma unroll
    for (int i = 0; i < 8; ++i) { float* t = scr + (i * 8 + lr) * 33 + lc * 4; t[0] = v[i].x; t[1] = v[i].y; t[2] = v[i].z; t[3] = v[i].w; }
    asm volatile("s_waitcnt lgkmcnt(0)" ::: "memory");
#pragma unroll
    for (int j = 0; j < 4; ++j) { const int n = lr + 8 * j; const float* t = scr + (8 * lc) * 33 + n;
        int row = rowoff + n0 + n; if (perm) row = headperm(row);
        u32x4 w; w.x = pk2(t[0] * gk[0], t[33] * gk[1]); w.y = pk2(t[66] * gk[2], t[99] * gk[3]); w.z = pk2(t[132] * gk[4], t[165] * gk[5]); w.w = pk2(t[198] * gk[6], t[231] * gk[7]);
        *(u32x4*)(dst + (size_t)row * K + k0 + 8 * lc) = w; }
    asm volatile("s_waitcnt lgkmcnt(0)" ::: "memory");
}
DI void weff_job(float* L, const Params& P, bf16_t* dst, int job) {
    float* As = L; float* Bs = L + 64 * 129;
    const int tid = threadIdx.x, k0 = (job >> 4) * 64, n0 = (job & 15) * 64, g = n0 >> 8, d0 = n0 & 255, kk = tid >> 3, dg = tid & 7;
    float acc[8];
#pragma unroll
    for (int j = 0; j < 8; ++j) acc[j] = 0.f;
    for (int c0 = 0; c0 < 256; c0 += 128) {
        __syncthreads();
#pragma unroll
        for (int i = 0; i < 4; ++i) { const int idx = tid + 512 * i;
            { const int r = idx >> 5, c4 = idx & 31; const float4 v = *(const float4*)(P.a_w_in + (size_t)(k0 + r) * 2048 + g * 256 + c0 + c4 * 4);
              float* t = As + r * 129 + c4 * 4; t[0] = v.x; t[1] = v.y; t[2] = v.z; t[3] = v.w; }
            { const int cc = idx >> 4, d4 = idx & 15; *(float4*)(Bs + cc * 64 + d4 * 4) = *(const float4*)(P.a_w_group + (size_t)(g * 256 + c0 + cc) * 256 + d0 + d4 * 4); } }
        __syncthreads();
#pragma unroll 4
        for (int c = 0; c < 128; ++c) { const float a = As[kk * 129 + c]; const float4 b0 = *(const float4*)(Bs + c * 64 + dg * 8), b1 = *(const float4*)(Bs + c * 64 + dg * 8 + 4);
            acc[0] += a * b0.x; acc[1] += a * b0.y; acc[2] += a * b0.z; acc[3] += a * b0.w; acc[4] += a * b1.x; acc[5] += a * b1.y; acc[6] += a * b1.z; acc[7] += a * b1.w; }
    }
    const float an = P.a_norm[k0 + kk];
#pragma unroll
    for (int j = 0; j < 8; ++j) { const int n = n0 + dg * 8 + j; const float v = acc[j] * an * P.a_scale[n];
        dst[(size_t)n * DM + k0 + kk] = (bf16_t)(pk2(v, v) & 0xffffu); }
}
DI void shadow_p_convert(const Params& P, int half) {
    const float4* pp = (const float4*)P.p; u32x4* pb = (u32x4*)(P.ws + OFF_PB);
    const int HALFCH = M_TOK * 256 / 8, step = gridDim.x * 448, base = half * HALFCH;
    for (int i = blockIdx.x * 448 + ((int)threadIdx.x - 64); i < HALFCH; i += 5 * step) { float4 a[5], b[5];
#pragma unroll
        for (int q = 0; q < 5; ++q) if (i + q * step < HALFCH) { a[q] = pp[2 * (base + i + q * step)]; b[q] = pp[2 * (base + i + q * step) + 1]; }
#pragma unroll
        for (int q = 0; q < 5; ++q) if (i + q * step < HALFCH) { u32x4 u; u.x = pk2(a[q].x, a[q].y); u.y = pk2(a[q].z, a[q].w); u.z = pk2(b[q].x, b[q].y); u.w = pk2(b[q].z, b[q].w); pb[base + i + q * step] = u; } }
}
DI void deferred_items(const Params& P, float* L, int seam) {
    const int wid = threadIdx.x >> 6, lane = threadIdx.x & 63; unsigned char* ws = P.ws; float* scr = L + wid * (64 * 33);
    const int nitems = (seam == 0) ? 768 : (seam == 1 ? 512 : 1024);
    for (int t = blockIdx.x * 7 + (wid - 1); t < nitems; t += gridDim.x * 7) {
        const int r = t & 511, hi = t >> 9;
        if (seam == 0) { if (hi == 0) transpose_item(scr, P.a_w_out, 1024, 1024, 32, nullptr, (bf16_t*)(ws + OFF_WAOUT), 0, false, r, lane);
                         else if (r < 128) transpose_item(scr, P.ple_w, 1024, 256, 32, nullptr, (bf16_t*)(ws + OFF_WPLE0), 0, false, r, lane);
                         else transpose_item(scr, P.ple_w + 256 * 1024, 1024, 256, 32, nullptr, (bf16_t*)(ws + OFF_WPLE1), 0, false, r - 128, lane); }
        else if (seam == 1) transpose_item(scr, P.ple_gate_w, 1024, 1024, 32, nullptr, (bf16_t*)(ws + OFF_WG0), 0, false, r, lane);
        else if (seam == 2) { if (hi == 0) transpose_item(scr, P.w_kv, 2048, 1024, 32, P.kv_norm, (bf16_t*)(ws + OFF_WKQZ), 0, true, r, lane);
                              else transpose_item(scr, P.w_kv + 1024, 2048, 1024, 32, P.kv_norm, (bf16_t*)(ws + OFF_WV), 0, false, r, lane); }
        else if (seam == 3) transpose_item(scr, P.b_w_in, 2048, 1024, 64, P.b_norm, (bf16_t*)(ws + OFF_WKQZ), 1024, true, t, lane);
        else { if (hi == 0) transpose_item(scr, P.b_w_out, 1024, 1024, 32, nullptr, (bf16_t*)(ws + OFF_WBOUT), 0, false, r, lane);
               else transpose_item(scr, P.ple_gate_w + 1024 * 1024, 1024, 1024, 32, nullptr, (bf16_t*)(ws + OFF_WG1), 0, false, r, lane); }
    }
    if (seam < 2) shadow_p_convert(P, seam);
}
DI void phase0(const Params& P, float* L) {
    const int tid = threadIdx.x, wid = tid >> 6, lane = tid & 63, w = blockIdx.x, G = gridDim.x;
    unsigned char* ws = P.ws;
    { float* ss1 = (float*)(ws + OFF_RSTD1); for (int i = w * 512 + tid; i < M_TOK; i += G * 512) ss1[i] = 0.f; }
    if ((w & 1) == 0) { for (int job = w; job < 256; job += G) weff_job(L, P, (bf16_t*)(ws + OFF_WIN1), job); __syncthreads(); }
    { float* scr = L + wid * (64 * 33);
      for (int t = w * 8 + wid; t < 512; t += G * 8) transpose_item(scr, P.a_w_in + 1024, 2048, 1024, 32, P.a_norm, (bf16_t*)(ws + OFF_WIN1) + (size_t)1024 * 1024, 0, false, t, lane); }
    { bf16_t* xb = (bf16_t*)(ws + OFF_R1); float* rstd0 = (float*)(ws + OFF_RSTD0);
      for (int row = (w * 8 + wid) * 8; row < M_TOK; row += G * 64) {
          float4 v[8][4];
#pragma unroll
          for (int q = 0; q < 8; ++q)
#pragma unroll
              for (int j = 0; j < 4; ++j) v[q][j] = ((const float4*)(P.x + (size_t)(row + q) * DM) + lane)[64 * j];
#pragma unroll
          for (int q = 0; q < 8; ++q) { float s = 0.f;
#pragma unroll
              for (int j = 0; j < 4; ++j) s += (v[q][j].x * v[q][j].x + v[q][j].y * v[q][j].y) + (v[q][j].z * v[q][j].z + v[q][j].w * v[q][j].w);
              s = wave_sum(s);
              uint2* o = (uint2*)(xb + (size_t)(row + q) * DM) + lane;
#pragma unroll
              for (int j = 0; j < 4; ++j) { uint2 u; u.x = pk2(v[q][j].x, v[q][j].y); u.y = pk2(v[q][j].z, v[q][j].w); o[64 * j] = u; }
              if (lane == 0) rstd0[row + q] = rsqrtf(s * (1.f / DM) + EPS); } } }
    if ((w & 1) != 0) { __syncthreads(); for (int job = w; job < 256; job += G) weff_job(L, P, (bf16_t*)(ws + OFF_WIN1), job); }
}
DI void unpack8(const u32x4 q, float (&f)[8]) { f[0] = bflo(q.x); f[1] = bfhi(q.x); f[2] = bflo(q.y); f[3] = bfhi(q.y); f[4] = bflo(q.z); f[5] = bfhi(q.z); f[6] = bflo(q.w); f[7] = bfhi(q.w); }
DI void pool_phase(const Params& P) {
    const bf16_t* ug = (const bf16_t*)(P.ws + OFF_R2); const bf16_t* sz = (const bf16_t*)(P.ws + OFF_R3); bf16_t* Gd = (bf16_t*)(P.ws + OFF_R1);
    const int nth = gridDim.x * 512;
    for (int idx = blockIdx.x * 512 + threadIdx.x; idx < 131072; idx += nth) {
        const int chunk = idx & 127, run = idx >> 7, row0 = run * 16, t0 = row0 & (SEQ - 1), c0 = chunk * 8, wlen = 2 << (chunk >> 5);
        const u32x4* up = (const u32x4*)(ug + (size_t)row0 * DM + c0); const u32x4* zp = (const u32x4*)(sz + (size_t)row0 * DM + c0); u32x4* gp = (u32x4*)(Gd + (size_t)row0 * DM + c0);
        float s[8], c[8], z[8];
#pragma unroll
        for (int j = 0; j < 8; ++j) s[j] = 0.f;
        { const bool hist = t0 > 0;
#pragma unroll
          for (int j = 1; j <= 16; ++j) {
              const int jj = hist ? (j <= wlen ? j : wlen) : 0; const float mk = (hist && j <= wlen) ? 1.f : 0.f;
              unpack8(up[-(jj * 128)], c);
#pragma unroll
              for (int q = 0; q < 8; ++q) s[q] += mk * c[q]; } }
        const float inv_full = 1.f / (float)wlen;
#pragma unroll 4
        for (int rr = 0; rr < 16; ++rr) {
            const int t = t0 + rr;
            if (t >= wlen) { unpack8(up[(rr - wlen) * 128], c);
#pragma unroll
                for (int q = 0; q < 8; ++q) s[q] -= c[q]; }
            unpack8(up[rr * 128], c); unpack8(zp[rr * 128], z);
            const float inv = (t + 1 < wlen) ? 1.f / (float)(t + 1) : inv_full;
            float o[8];
#pragma unroll
            for (int q = 0; q < 8; ++q) { s[q] += c[q]; o[q] = (s[q] * inv - c[q]) * z[q]; }
            u32x4 w; w.x = pk2(o[0], o[1]); w.y = pk2(o[2], o[3]); w.z = pk2(o[4], o[5]); w.w = pk2(o[6], o[7]); gp[rr * 128] = w;
        }
    }
}
#define MFMA32(a, b, c) __builtin_amdgcn_mfma_f32_32x32x16_bf16((a), (b), (c), 0, 0, 0)
DI void attn_phase(const Params& P, PG8_LAS unsigned char* lds) {
    constexpr int HIST = 128, WIN = 384, KP = 144, VP = 776, NF = 6, VCH = 48;
    PG8_LAS unsigned char* Kl = lds; PG8_LAS unsigned char* Vl = lds + WIN * KP;
    const bf16_t* kk = (const bf16_t*)(P.ws + OFF_R1); const bf16_t* qq = (const bf16_t*)(P.ws + OFF_R2); const bf16_t* vt = (const bf16_t*)(P.ws + OFF_R4);
    const bf16_t* sz2 = (const bf16_t*)(P.ws + OFF_R4 + 32 * MiB); bf16_t* g2 = (bf16_t*)P.out;
    const int tid = threadIdx.x, wid = tid >> 6, lane = tid & 63, r = lane & 31, hh = lane >> 5;
#define ATT_LOAD_FILL(IT, KV, VV) do { const int _bh = (IT) >> 3, _wlo = ((IT) & 7) * 256 - HIST; const bf16_t* _Kg = kk + (size_t)_bh * SEQ * 64; const bf16_t* _Vg = vt + (size_t)_bh * 64 * SEQ; \
        _Pragma("unroll") for (int i = 0; i < NF; ++i) { const int c = tid + 512 * i, row = c >> 3, part = c & 7, key = _wlo + row; if (key >= 0) KV[i] = *(const u32x4*)(_Kg + (size_t)key * 64 + part * 8); } \
        _Pragma("unroll") for (int i = 0; i < NF; ++i) { const int c = tid + 512 * i, d = c / VCH, part = c - d * VCH, key0 = _wlo + part * 8; if (key0 >= 0) VV[i] = *(const u32x4*)(_Vg + (size_t)d * SEQ + key0); } } while (0)
#define ATT_LOAD_Q(IT, QF) do { const bf16_t* _Qp = qq + ((size_t)((IT) >> 3) * SEQ + ((IT) & 7) * 256 + 32 * wid + r) * 64 + hh * 8; \
        _Pragma("unroll") for (int ks = 0; ks < 4; ++ks) QF[ks] = *(const s16x8*)(_Qp + ks * 16); } while (0)
    u32x4 kv[NF], vv[NF];
    if ((int)blockIdx.x < 1024) { ATT_LOAD_FILL((int)blockIdx.x, kv, vv); }
    for (int item = blockIdx.x; item < 1024; item += gridDim.x) {
        const int qc = item & 7, bh = item >> 3, t0 = qc * 256, wlo = t0 - HIST, tq = t0 + 32 * wid;
        const bf16_t* Kg = kk + (size_t)bh * SEQ * 64; const bf16_t* Vg = vt + (size_t)bh * 64 * SEQ;
        const int b = bh >> 4, h = bh & 15; const size_t rowo = ((size_t)b * SEQ + tq + r) * DM + h * 64 + 4 * hh;
        s16x8 qf[4]; ATT_LOAD_Q(item, qf);
        __syncthreads();
#pragma unroll
        for (int i = 0; i < NF; ++i) { const int c = tid + 512 * i, row = c >> 3, part = c & 7, key = wlo + row;
            if (key >= 0) *(PG8_LAS u32x4*)(Kl + row * KP + part * 16) = kv[i]; }
#pragma unroll
        for (int i = 0; i < NF; ++i) { const int c = tid + 512 * i, d = c / VCH, part = c - d * VCH, key0 = wlo + part * 8;
            if (key0 >= 0) { PG8_LAS u32x2_t* w = (PG8_LAS u32x2_t*)(Vl + d * VP + part * 16); u32x2_t a = {vv[i].x, vv[i].y}, bb = {vv[i].z, vv[i].w}; w[0] = a; w[1] = bb; } }
        __syncthreads();
        const size_t rowc = ((size_t)b * SEQ + tq + (lane >> 3)) * DM + h * 64 + (lane & 7) * 8;
        u32x4 zc[4];
#pragma unroll
        for (int i = 0; i < 4; ++i) zc[i] = *(const u32x4*)(sz2 + rowc + (size_t)(8 * i) * DM);
        const int nitem = item + gridDim.x;
        u32x4 kvn[NF], vvn[NF];
        if (nitem < 1024) { ATT_LOAD_FILL(nitem, kvn, vvn); }
        f32x16 o0, o1;
#pragma unroll
        for (int i = 0; i < 16; ++i) { o0[i] = 0.f; o1[i] = 0.f; }
        float carry = 1.f;
        for (int s0 = tq; s0 >= 0; s0 -= 32) {
            s16x8 kf[4]; s16x4 vf[2][2][2];
            if (s0 >= wlo) {
                PG8_LAS const unsigned char* kp = Kl + (s0 - wlo + r) * KP + hh * 16; PG8_LAS const unsigned char* vp = Vl + r * VP + (s0 - wlo + 4 * hh) * 2;
#pragma unroll
                for (int ks = 0; ks < 4; ++ks) kf[ks] = *(PG8_LAS const s16x8*)(kp + ks * 32);
#pragma unroll
                for (int dt = 0; dt < 2; ++dt)
#pragma unroll
                    for (int s = 0; s < 2; ++s)
#pragma unroll
                        for (int pt = 0; pt < 2; ++pt) vf[dt][s][pt] = *(PG8_LAS const s16x4*)(vp + dt * 32 * VP + (16 * s + 8 * pt) * 2);
            } else {
                const bf16_t* kp = Kg + (size_t)(s0 + r) * 64 + hh * 8; const bf16_t* vp = Vg + (size_t)r * SEQ + s0 + 4 * hh;
#pragma unroll
                for (int ks = 0; ks < 4; ++ks) kf[ks] = *(const s16x8*)(kp + ks * 16);
#pragma unroll
                for (int dt = 0; dt < 2; ++dt)
#pragma unroll
                    for (int s = 0; s < 2; ++s)
#pragma unroll
                        for (int pt = 0; pt < 2; ++pt) vf[dt][s][pt] = *(const s16x4*)(vp + (size_t)dt * 32 * SEQ + 16 * s + 8 * pt);
            }
            f32x16 x;
#pragma unroll
            for (int i = 0; i < 16; ++i) x[i] = 0.f;
#pragma unroll
            for (int ks = 0; ks < 4; ++ks) x = MFMA32(kf[ks], qf[ks], x);
            float beta[16], keep[16];
            const bool diag = (s0 == tq);
#pragma unroll
            for (int i = 0; i < 16; ++i) {
                const float l = fmaxf(x[i], -120.f);
                const float e = __builtin_amdgcn_exp2f(-l);
                float bt = __builtin_amdgcn_rcpf(1.f + e), kp = e * bt;
                beta[i] = bt; keep[i] = kp;
            }
            if (diag) {
#pragma unroll
                for (int i = 0; i < 16; ++i) { const bool valid = ((i & 3) + 8 * (i >> 2) + 4 * hh) < r; beta[i] = valid ? beta[i] : 0.f; keep[i] = valid ? keep[i] : 1.f; }
            }
            float Gp[4], PG[4];
#pragma unroll
            for (int g = 0; g < 4; ++g) { Gp[g] = (keep[4 * g] * keep[4 * g + 1]) * (keep[4 * g + 2] * keep[4 * g + 3]); PG[g] = __shfl_xor(Gp[g], 32); }
            float base[4];
            { float so = 1.f, sp = 1.f;
#pragma unroll
              for (int g = 3; g >= 0; --g) { base[g] = carry * so * sp * (hh == 0 ? PG[g] : 1.f); so *= Gp[g]; sp *= PG[g]; }
              carry = carry * so * sp; }
            float a[16];
#pragma unroll
            for (int g = 0; g < 4; ++g) { float run = base[g];
                a[4 * g + 3] = beta[4 * g + 3] * run; run *= keep[4 * g + 3];
                a[4 * g + 2] = beta[4 * g + 2] * run; run *= keep[4 * g + 2];
                a[4 * g + 1] = beta[4 * g + 1] * run; run *= keep[4 * g + 1];
                a[4 * g] = beta[4 * g] * run; }
#pragma unroll
            for (int s = 0; s < 2; ++s) {
                u32x4 pw; pw.x = pk2(a[8 * s], a[8 * s + 1]); pw.y = pk2(a[8 * s + 2], a[8 * s + 3]); pw.z = pk2(a[8 * s + 4], a[8 * s + 5]); pw.w = pk2(a[8 * s + 6], a[8 * s + 7]);
                const s16x8 pf = __builtin_bit_cast(s16x8, pw);
                const s16x8 va = __builtin_shufflevector(vf[0][s][0], vf[0][s][1], 0, 1, 2, 3, 4, 5, 6, 7);
                const s16x8 vb = __builtin_shufflevector(vf[1][s][0], vf[1][s][1], 0, 1, 2, 3, 4, 5, 6, 7);
                o0 = MFMA32(va, pf, o0); o1 = MFMA32(vb, pf, o1);
            }
            if (__all(carry < 1e-12f)) break;
        }
        { PG8_LAS unsigned char* S = lds + WIN * KP + 64 * VP + wid * 4608;
#pragma unroll
          for (int i = 0; i < 4; ++i) *(PG8_LAS u32x4*)(S + ((lane >> 3) + 8 * i) * 144 + (lane & 7) * 16) = zc[i];
          asm volatile("s_waitcnt lgkmcnt(0)" ::: "memory");
          PG8_LAS unsigned char* Sr = S + r * 144 + 8 * hh;
#pragma unroll
          for (int g = 0; g < 4; ++g) {
              const u32x2_t z0 = *(PG8_LAS const u32x2_t*)(Sr + 16 * g), z1 = *(PG8_LAS const u32x2_t*)(Sr + 64 + 16 * g);
              u32x2_t w0, w1;
              w0.x = pk2(o0[4 * g] * bflo(z0.x), o0[4 * g + 1] * bfhi(z0.x)); w0.y = pk2(o0[4 * g + 2] * bflo(z0.y), o0[4 * g + 3] * bfhi(z0.y));
              w1.x = pk2(o1[4 * g] * bflo(z1.x), o1[4 * g + 1] * bfhi(z1.x)); w1.y = pk2(o1[4 * g + 2] * bflo(z1.y), o1[4 * g + 3] * bfhi(z1.y));
              *(PG8_LAS u32x2_t*)(Sr + 16 * g) = w0; *(PG8_LAS u32x2_t*)(Sr + 64 + 16 * g) = w1; }
          asm volatile("s_waitcnt lgkmcnt(0)" ::: "memory");
#pragma unroll
          for (int i = 0; i < 4; ++i) { const u32x4 v = *(PG8_LAS const u32x4*)(S + ((lane >> 3) + 8 * i) * 144 + (lane & 7) * 16); *(u32x4*)(g2 + rowc + (size_t)(8 * i) * DM) = v; }
          asm volatile("s_waitcnt lgkmcnt(0)" ::: "memory"); }
#pragma unroll
        for (int i = 0; i < NF; ++i) { kv[i] = kvn[i]; vv[i] = vvn[i]; }
    }
#undef ATT_LOAD_FILL
#undef ATT_LOAD_Q
}

__global__ __launch_bounds__(512, 2) void yoco_fwd(Params P) {
    extern __shared__ __attribute__((aligned(16))) unsigned char shm[];
    PG8_LAS unsigned char* lds = (PG8_LAS unsigned char*)shm;
    unsigned char* ws = P.ws;
    bf16_t* R1 = (bf16_t*)(ws + OFF_R1); bf16_t* R2 = (bf16_t*)(ws + OFF_R2); bf16_t* R3 = (bf16_t*)(ws + OFF_R3); bf16_t* R4 = (bf16_t*)(ws + OFF_R4);
    float* rstd0 = (float*)(ws + OFF_RSTD0); float* rstd1 = (float*)(ws + OFF_RSTD1); float* ssp = (float*)(ws + OFF_SSP);
    const bf16_t* pb = (const bf16_t*)(ws + OFF_PB); bf16_t* E1b = (bf16_t*)(ws + OFF_E1);
#define PH(k) if (P.ph_lo <= (k) && (k) < P.ph_hi)
#define SYNC(k) if (fused) { if ((k) < 5) xcd_barrier(xb, [&]() { deferred_items(P, (float*)shm, (k)); }); else xcd_barrier(xb, []() {}); }
    const bool fused = (P.ph_hi - P.ph_lo) > 1;
    volatile LAS unsigned* st = (volatile LAS unsigned*)(lds + LDS_ST);
    unsigned* bar = (unsigned*)(ws + OFF_BAR);
    if (fused) { if (threadIdx.x == 0) { st[0] = 0u; st[1] = 0u; } __syncthreads(); }
    XcdBarrier xb; xb.bar = bar; xb.x = 0u; xb.st = st;
    if (fused) xb = xcd_barrier_post(bar, st);
    PH(0) phase0(P, (float*)shm);
    SYNC(0)
    PH(1) { Epi1 E{R2, R3, rstd0}; run_gemm(lds, R1, (const bf16_t*)(ws + OFF_WIN1), M_TOK, 2048, 1024, E); }
    SYNC(1)
    PH(2) pool_phase(P);
    SYNC(2)
    PH(3) { EpiResB<true> E{P.x, nullptr, R2}; run_gemm(lds, R1, (const bf16_t*)(ws + OFF_WAOUT), M_TOK, 1024, 1024, E); }
    SYNC(3)
    PH(4) { SchedPG S{ws, 0, (int)gridDim.x, (int)blockIdx.x}; EpiPG<true> E{EpiE{E1b}, EpiGate<true>{R2, E1b, R3, rstd1, nullptr}}; pg8::gemm_stream(lds, S, E); }
    SYNC(4)
    PH(6) { SchedP6 S{ws, (int)gridDim.x, (int)blockIdx.x};
            EpiP6 E{EpiKQZ{R1, R2, R4 + (size_t)M_TOK * DM, rstd1, P.k_norm, P.b_q_norm}, EpiVT{R4, rstd1}}; pg8::gemm_stream(lds, S, E); }
    SYNC(6)
    PH(7) attn_phase(P, lds);
    SYNC(7)
    PH(8) { EpiResB<false> E{nullptr, R3, R2}; run_gemm(lds, (const bf16_t*)P.out, (const bf16_t*)(ws + OFF_WBOUT), M_TOK, 1024, 1024, E); }
    SYNC(8)
    PH(9) { SchedPG S{ws, 1, (int)gridDim.x, (int)blockIdx.x}; EpiPG<false> E{EpiE{E1b}, EpiGate<false>{R2, E1b, nullptr, nullptr, P.out}}; pg8::gemm_stream(lds, S, E); }
}

extern "C" void kernel_launch(void* const* d_in, const int* in_sizes, int n_in, void* d_out, int out_size, void* d_ws, size_t ws_size, hipStream_t stream) {
    static int grid = 0;
    if (grid == 0) {
        int dev = 0, cus = 0, per_cu = 0;
        if (n_in != 16 || out_size != M_TOK * DM || ws_size < WS_END) { fprintf(stderr, "kernel_launch: unexpected shapes (n_in %d out %d ws %zu)\n", n_in, out_size, ws_size); grid = -1; return; }
        (void)hipGetDevice(&dev); (void)hipDeviceGetAttribute(&cus, hipDeviceAttributeMultiprocessorCount, dev);
        if (hipFuncSetAttribute((const void*)yoco_fwd, hipFuncAttributeMaxDynamicSharedMemorySize, LDS_BYTES) != hipSuccess) { fprintf(stderr, "kernel_launch: hipFuncSetAttribute failed\n"); grid = -1; return; }
        (void)hipOccupancyMaxActiveBlocksPerMultiprocessor(&per_cu, (const void*)yoco_fwd, 512, LDS_BYTES);
        if (per_cu < 1) { fprintf(stderr, "kernel_launch: occupancy query says %d blocks per CU\n", per_cu); (void)hipGetLastError(); per_cu = 1; }
        grid = cus;
    }
    if (grid < 0) return;
    Params p{};
    const float** pp = (const float**)&p;
    for (int i = 0; i < 16; ++i) pp[i] = (const float*)d_in[i];
    p.out = (float*)d_out; p.ws = (unsigned char*)d_ws;
    p.ph_lo = 0; p.ph_hi = NPHASE;
    if (hipMemsetAsync((unsigned char*)d_ws + OFF_BAR, 0, XCD_BAR_WORDS * 4, stream) != hipSuccess) { fprintf(stderr, "kernel_launch: memset of the barrier words failed\n"); return; }
    void* args[] = {&p};
    hipError_t e = hipLaunchCooperativeKernel((const void*)yoco_fwd, dim3(grid), dim3(512), args, LDS_BYTES, stream);
    if (e != hipSuccess) fprintf(stderr, "kernel_launch: cooperative launch failed: %s (grid %d)\n", hipGetErrorString(e), grid);
}
```

```cpp
#include <hip/hip_runtime.h>
#include <cstdio>
namespace pg8 {
#define PG8_LAS __attribute__((address_space(3)))
typedef unsigned short bf16_t;
typedef short bf16x8 __attribute__((ext_vector_type(8)));
typedef float f32x4 __attribute__((ext_vector_type(4)));
typedef unsigned u32x4 __attribute__((ext_vector_type(4)));
constexpr int BM = 256, BK = 64, HALF = 128, HTB = HALF * BK * 2  , STAGE_BYTES = 8 * HTB, NXCD = 8, WGM = 8;

__host__ __device__ __forceinline__ int lds_byte(int r, int c) { const int st = (r >> 4) * 2 + (c >> 5), rr = r & 15, cc = c & 31, ob = rr * 64 + cc * 2; return st * 1024 + (ob ^ (((ob >> 9) & 1) << 5)); }
__host__ __device__ __forceinline__ void stage_rc(int b, int& R, int& C) { const int st = b / 1024, sb = b % 1024, swz = sb ^ (((sb >> 9) & 1) << 5); R = (st >> 1) * 16 + swz / 64; C = (st & 1) * 32 + (swz % 64) / 2; }
__host__ __device__ __forceinline__ int perm32(int rho) { const int n = rho >> 4, i = rho & 15; return 8 * (i >> 2) + 4 * n + (i & 3); }

struct Unit { int pm, pn; };
struct Gemm { const bf16_t* A; const bf16_t* Bt; int M, N, K; };
struct StaticOrder {
    int nM, nN, nwg, G, c;
    __host__ __device__ void init(int M, int N, int G_, int c_) { nM = M / BM; nN = N / BM; nwg = nM * nN; G = G_; c = c_; }
    __host__ __device__ bool next(int i, Unit& u) const {
        const long L = (long)i * G + c; if (L >= nwg) return false;
        int wgid = (int)L; { const int q = nwg / NXCD, r = nwg % NXCD, xcd = wgid % NXCD, off = wgid / NXCD; wgid = (xcd < r ? xcd * (q + 1) : r * (q + 1) + (xcd - r) * q) + off; }
        const int nig = WGM * nN, gid = wgid / nig, fm = gid * WGM, gsz = (nM - fm) < WGM ? (nM - fm) : WGM;
        u.pm = fm + ((wgid % nig) % gsz); u.pn = (wgid % nig) / gsz; return true;
    }
    __device__ __forceinline__ void a_ready(const Unit&) const {}
    __device__ __forceinline__ void done(const Unit&) const {}
};
template <class Epi, class Sched, bool STAMP = false>
__device__ __forceinline__ void gemm_phase(PG8_LAS unsigned char* lds, const Gemm g, const Sched& S, const Epi& E, unsigned long long* stamps) {
    const int tid = threadIdx.x, wid = __builtin_amdgcn_readfirstlane(tid >> 6), lane = tid & 63, wr = wid >> 2, wc = wid & 3, fr = lane & 15, fq = lane >> 4;
    const int K = g.K, nt = K / BK;
    int ts_lo = 0, ts_hi = 0, nts = 0; const unsigned long long rt_entry = STAMP ? (unsigned long long)wall_clock64() : 0ull;
#define PG8_STAMP() do { if (STAMP && wid == 0 && nts < 64) { const unsigned long long _c = (unsigned long long)clock64(); \
        ts_lo = (lane == nts) ? (int)(unsigned)_c : ts_lo; ts_hi = (lane == nts) ? (int)(unsigned)(_c >> 32) : ts_hi; ++nts; } } while (0)
    PG8_STAMP();
    unsigned voffA[2], voffB[2];
#pragma unroll
    for (int i = 0; i < 2; ++i) { int R, C; stage_rc(tid * 16 + i * 8192, R, C); const int Rb = Epi::PERM ? ((R & ~31) + perm32(R & 31)) : R;
        voffA[i] = (unsigned)(R * K + C) * 2u; voffB[i] = (unsigned)(Rb * K + C) * 2u; }
    const size_t kstep = (size_t)(BK * 2);
    const size_t hstep = (size_t)HALF * K * 2;
    const size_t tstep = 2 * hstep;
    const unsigned ldsw = (unsigned)wid * 1024u;
    const int aoff = lds_byte(wr * 64 + fr, fq * 8), boff = lds_byte(wc * 32 + fr, fq * 8);
#define PG8_SA(b, h) (((b) * 2 + (h)) * HTB)
#define PG8_SB(b, h) ((4 + (b) * 2 + (h)) * HTB)
#define PG8_STAGE(bufoff, gbase, voff) do { _Pragma("unroll") for (int _i = 0; _i < 2; ++_i) \
        __builtin_amdgcn_global_load_lds((const unsigned*)((const char*)(gbase) + (voff)[_i]), (PG8_LAS unsigned*)(lds + (bufoff) + ldsw + _i * 8192), 16, 0, 0); } while (0)
#define PG8_LDA(dst, b, h) do { _Pragma("unroll") for (int m = 0; m < 4; ++m) _Pragma("unroll") for (int k = 0; k < 2; ++k) dst[m][k] = *(const PG8_LAS bf16x8*)(lds + PG8_SA(b, h) + aoff + m * 2048 + k * 1024); } while (0)
#define PG8_LDB(dst, b, h) do { _Pragma("unroll") for (int n = 0; n < 2; ++n) _Pragma("unroll") for (int k = 0; k < 2; ++k) dst[n][k] = *(const PG8_LAS bf16x8*)(lds + PG8_SB(b, h) + boff + n * 2048 + k * 1024); } while (0)
#define PG8_MMA(ai, bj, At, Bt) do { __builtin_amdgcn_s_setprio(1); _Pragma("unroll") for (int m = 0; m < 4; ++m) _Pragma("unroll") for (int n = 0; n < 2; ++n) _Pragma("unroll") for (int k = 0; k < 2; ++k) \
        acc[ai][bj][m][n] = __builtin_amdgcn_mfma_f32_16x16x32_bf16(Bt[n][k], At[m][k], acc[ai][bj][m][n], 0, 0, 0); __builtin_amdgcn_s_setprio(0); } while (0)
#define PG8_WAIT_V(n) asm volatile("s_waitcnt vmcnt(" #n ")" ::: "memory")
#define PG8_WAIT_L(n) asm volatile("s_waitcnt lgkmcnt(" #n ")" ::: "memory")
#define PG8_BAR __builtin_amdgcn_s_barrier()
#define PG8_SCHED __builtin_amdgcn_sched_barrier(0)
    Unit cur, nxt; int ui = 0;
    if (!S.next(0, cur)) return;
    f32x4 acc[2][2][4][2];
#pragma unroll
    for (int a = 0; a < 2; ++a)
#pragma unroll
        for (int b = 0; b < 2; ++b)
#pragma unroll
            for (int m = 0; m < 4; ++m)
#pragma unroll
                for (int n = 0; n < 2; ++n) acc[a][b][m][n] = (f32x4){0.f, 0.f, 0.f, 0.f};
    bf16x8 At[4][2], B0[2][2], B1[2][2];
    const char* cA = (const char*)g.A + (size_t)cur.pm * tstep; const char* cB = (const char*)g.Bt + (size_t)cur.pn * tstep;
    S.a_ready(cur);
    PG8_STAGE(PG8_SB(0, 0), cB, voffB); PG8_STAGE(PG8_SA(0, 0), cA, voffA); PG8_STAGE(PG8_SB(0, 1), cB + hstep, voffB); PG8_STAGE(PG8_SA(0, 1), cA + hstep, voffA);
    if (wr == 1) PG8_BAR;
    PG8_WAIT_V(4); PG8_BAR;
    PG8_STAGE(PG8_SB(1, 0), cB + kstep, voffB); PG8_STAGE(PG8_SA(1, 0), cA + kstep, voffA); PG8_STAGE(PG8_SB(1, 1), cB + hstep + kstep, voffB);
    PG8_WAIT_V(6); PG8_BAR;
    PG8_STAMP();
    for (;;) {
        const bool has_next = S.next(ui + 1, nxt);
        const char* nA = has_next ? (const char*)g.A + (size_t)nxt.pm * tstep : cA; const char* nB = has_next ? (const char*)g.Bt + (size_t)nxt.pn * tstep : cB;
        for (int t = 0; t < nt; t += 2) {
            const bool last = (t == nt - 2);
            const char* a1 = cA + (size_t)(t + 1) * kstep;
            const char* a2 = last ? nA : cA + (size_t)(t + 2) * kstep; const char* b2 = last ? nB : cB + (size_t)(t + 2) * kstep;
            const char* a3 = a2 + kstep; const char* b3 = b2 + kstep;
            if (last && has_next) S.a_ready(nxt);
            PG8_LDB(B0, 0, 0); PG8_SCHED; PG8_LDA(At, 0, 0); PG8_STAGE(PG8_SA(1, 1), a1 + hstep, voffA);
            PG8_WAIT_L(8); PG8_BAR; PG8_WAIT_L(0); PG8_MMA(0, 0, At, B0); PG8_BAR; PG8_SCHED;
            PG8_LDB(B1, 0, 1); PG8_STAGE(PG8_SB(0, 0), b2, voffB);
            PG8_BAR; PG8_WAIT_L(0); PG8_MMA(0, 1, At, B1); PG8_BAR;
            PG8_LDA(At, 0, 1); PG8_STAGE(PG8_SA(0, 0), a2, voffA);
            PG8_BAR; PG8_WAIT_L(0); PG8_MMA(1, 0, At, B0); PG8_BAR; PG8_SCHED;
            PG8_STAGE(PG8_SB(0, 1), b2 + hstep, voffB);
            PG8_WAIT_V(6); PG8_BAR; PG8_MMA(1, 1, At, B1); PG8_BAR;
            PG8_LDB(B0, 1, 0); PG8_SCHED; PG8_LDA(At, 1, 0); PG8_STAGE(PG8_SA(0, 1), a2 + hstep, voffA);
            PG8_WAIT_L(8); PG8_BAR; PG8_WAIT_L(0); PG8_MMA(0, 0, At, B0); PG8_BAR; PG8_SCHED;
            PG8_LDB(B1, 1, 1); PG8_STAGE(PG8_SB(1, 0), b3, voffB);
            PG8_BAR; PG8_WAIT_L(0); PG8_MMA(0, 1, At, B1); PG8_BAR;
            PG8_LDA(At, 1, 1); PG8_STAGE(PG8_SA(1, 0), a3, voffA);
            PG8_BAR; PG8_WAIT_L(0); PG8_MMA(1, 0, At, B0); PG8_BAR; PG8_SCHED;
            PG8_STAGE(PG8_SB(1, 1), b3 + hstep, voffB);
            PG8_WAIT_V(6); PG8_BAR; PG8_MMA(1, 1, At, B1); PG8_BAR;
        }
        PG8_STAMP();
        if constexpr (!Epi::AFTER_DRAIN) { E(acc, cur, wr, wc, fr, fq); S.done(cur); }
        PG8_STAMP();
        if (!has_next) break;
#pragma unroll
        for (int a = 0; a < 2; ++a)
#pragma unroll
            for (int b = 0; b < 2; ++b)
#pragma unroll
                for (int m = 0; m < 4; ++m)
#pragma unroll
                    for (int n = 0; n < 2; ++n) acc[a][b][m][n] = (f32x4){0.f, 0.f, 0.f, 0.f};
        cur = nxt; cA = nA; cB = nB; ++ui;
    }
    PG8_WAIT_V(0);
    if (wr == 0) PG8_BAR;
    PG8_BAR;
    if constexpr (Epi::AFTER_DRAIN) { E.fused(acc, cur, wr, wc, fr, fq, lds, wid, lane); S.done(cur); }
    PG8_STAMP();
    if (STAMP && wid == 0) { stamps[lane] = lane < nts ? (((unsigned long long)(unsigned)ts_hi << 32) | (unsigned)ts_lo) : 0ull;
        if (lane == 62) stamps[62] = rt_entry; if (lane == 63) stamps[63] = (unsigned long long)wall_clock64(); }
#undef PG8_STAMP
#undef PG8_SA
#undef PG8_SB
#undef PG8_STAGE
#undef PG8_LDA
#undef PG8_LDB
#undef PG8_MMA
#undef PG8_WAIT_V
#undef PG8_WAIT_L
#undef PG8_BAR
#undef PG8_SCHED
}
}
namespace pg8 {
struct UnitX { int pm, pn, kind; };
struct GDesc { const bf16_t* A; const bf16_t* Bt; int ks; };
__device__ __forceinline__ void map_unit(int L, int nM, int nN, int& pm, int& pn) {
    const int nwg = nM * nN; int wgid = L; { const int q = nwg / NXCD, r = nwg % NXCD, xcd = wgid % NXCD, off = wgid / NXCD; wgid = (xcd < r ? xcd * (q + 1) : r * (q + 1) + (xcd - r) * q) + off; }
    const int nig = WGM * nN, gid = wgid / nig, fm = gid * WGM, gsz = (nM - fm) < WGM ? (nM - fm) : WGM;
    pm = fm + ((wgid % nig) % gsz); pn = (wgid % nig) / gsz;
}
template <class Epi, class Sched>
__device__ __forceinline__ void gemm_stream(PG8_LAS unsigned char* lds, const Sched& S, const Epi& E) {
    const int tid = threadIdx.x, wid = __builtin_amdgcn_readfirstlane(tid >> 6), lane = tid & 63, wr = wid >> 2, wc = wid & 3, fr = lane & 15, fq = lane >> 4;
    const size_t kstep = (size_t)(BK * 2);
    const unsigned ldsw = (unsigned)wid * 1024u;
    const int aoff = lds_byte(wr * 64 + fr, fq * 8), boff = lds_byte(wc * 32 + fr, fq * 8);
#define PG8_SA(b, h) (((b) * 2 + (h)) * HTB)
#define PG8_SB(b, h) ((4 + (b) * 2 + (h)) * HTB)
#define PG8_STAGE(bufoff, gbase, voff) do { _Pragma("unroll") for (int _i = 0; _i < 2; ++_i) \
        __builtin_amdgcn_global_load_lds((const unsigned*)((const char*)(gbase) + (voff)[_i]), (PG8_LAS unsigned*)(lds + (bufoff) + ldsw + _i * 8192), 16, 0, 0); } while (0)
#define PG8_LDA(dst, b, h) do { _Pragma("unroll") for (int m = 0; m < 4; ++m) _Pragma("unroll") for (int k = 0; k < 2; ++k) dst[m][k] = *(const PG8_LAS bf16x8*)(lds + PG8_SA(b, h) + aoff + m * 2048 + k * 1024); } while (0)
#define PG8_LDB(dst, b, h) do { _Pragma("unroll") for (int n = 0; n < 2; ++n) _Pragma("unroll") for (int k = 0; k < 2; ++k) dst[n][k] = *(const PG8_LAS bf16x8*)(lds + PG8_SB(b, h) + boff + n * 2048 + k * 1024); } while (0)
#define PG8_MMA(ai, bj, At, Bt) do { __builtin_amdgcn_s_setprio(1); _Pragma("unroll") for (int m = 0; m < 4; ++m) _Pragma("unroll") for (int n = 0; n < 2; ++n) _Pragma("unroll") for (int k = 0; k < 2; ++k) \
        acc[ai][bj][m][n] = __builtin_amdgcn_mfma_f32_16x16x32_bf16(Bt[n][k], At[m][k], acc[ai][bj][m][n], 0, 0, 0); __builtin_amdgcn_s_setprio(0); } while (0)
#define PG8_WAIT_V(n) asm volatile("s_waitcnt vmcnt(" #n ")" ::: "memory")
#define PG8_WAIT_L(n) asm volatile("s_waitcnt lgkmcnt(" #n ")" ::: "memory")
#define PG8_BAR __builtin_amdgcn_s_barrier()
#define PG8_SCHED __builtin_amdgcn_sched_barrier(0)
    UnitX cur, nxt; int ui = 0;
    if (!S.next(0, cur)) return;
    f32x4 acc[2][2][4][2];
#pragma unroll
    for (int a = 0; a < 2; ++a)
#pragma unroll
        for (int b = 0; b < 2; ++b)
#pragma unroll
            for (int m = 0; m < 4; ++m)
#pragma unroll
                for (int n = 0; n < 2; ++n) acc[a][b][m][n] = (f32x4){0.f, 0.f, 0.f, 0.f};
    bf16x8 At[4][2], B0[2][2], B1[2][2];
    GDesc dc = S.desc(cur.kind);
    int ksC = dc.ks; size_t hsC = (size_t)HALF * ksC * 2;
    unsigned vAc[2], vBc[2];
#pragma unroll
    for (int i = 0; i < 2; ++i) { int R, C; stage_rc(tid * 16 + i * 8192, R, C); const int Rb = (R & ~31) + perm32(R & 31);
        vAc[i] = (unsigned)(R * ksC + C) * 2u; vBc[i] = (unsigned)(Rb * ksC + C) * 2u; }
    int shC = 31 - __builtin_clz((unsigned)ksC * 2u);
    const char* cA = (const char*)dc.A + (size_t)cur.pm * 2 * hsC; const char* cB = (const char*)dc.Bt + (size_t)cur.pn * 2 * hsC;
    PG8_STAGE(PG8_SB(0, 0), cB, vBc); PG8_STAGE(PG8_SA(0, 0), cA, vAc); PG8_STAGE(PG8_SB(0, 1), cB + hsC, vBc); PG8_STAGE(PG8_SA(0, 1), cA + hsC, vAc);
    if (wr == 1) PG8_BAR;
    PG8_WAIT_V(4); PG8_BAR;
    PG8_STAGE(PG8_SB(1, 0), cB + kstep, vBc); PG8_STAGE(PG8_SA(1, 0), cA + kstep, vAc); PG8_STAGE(PG8_SB(1, 1), cB + hsC + kstep, vBc);
    PG8_WAIT_V(6); PG8_BAR;
    for (;;) {
        const bool has_next = S.next(ui + 1, nxt);
        const char* nA = cA; const char* nB = cB; int ksN = ksC; size_t hsN = hsC;
        if (has_next) { const GDesc dn = S.desc(nxt.kind); ksN = dn.ks; hsN = (size_t)HALF * ksN * 2;
            nA = (const char*)dn.A + (size_t)nxt.pm * 2 * hsN; nB = (const char*)dn.Bt + (size_t)nxt.pn * 2 * hsN; }
        const int shN = 31 - __builtin_clz((unsigned)ksN * 2u); const unsigned cmask = (unsigned)ksC * 2u - 1u;
        const int nt = ksC / BK;
        for (int t = 0; t < nt; t += 2) {
            const bool last = (t == nt - 2);
            const char* a1 = cA + (size_t)(t + 1) * kstep;
            const char* a2 = last ? nA : cA + (size_t)(t + 2) * kstep; const char* b2 = last ? nB : cB + (size_t)(t + 2) * kstep;
            const char* a3 = a2 + kstep; const char* b3 = b2 + kstep;
            const size_t hs2 = last ? hsN : hsC;
            unsigned vA2[2], vB2[2];
#pragma unroll
            for (int i = 0; i < 2; ++i) { vA2[i] = last ? (((vAc[i] >> shC) << shN) | (vAc[i] & cmask)) : vAc[i]; vB2[i] = last ? (((vBc[i] >> shC) << shN) | (vBc[i] & cmask)) : vBc[i]; }
            PG8_LDB(B0, 0, 0); PG8_SCHED; PG8_LDA(At, 0, 0); PG8_STAGE(PG8_SA(1, 1), a1 + hsC, vAc);
            PG8_WAIT_L(8); PG8_BAR; PG8_WAIT_L(0); PG8_MMA(0, 0, At, B0); PG8_BAR; PG8_SCHED;
            PG8_LDB(B1, 0, 1); PG8_STAGE(PG8_SB(0, 0), b2, vB2);
            PG8_BAR; PG8_WAIT_L(0); PG8_MMA(0, 1, At, B1); PG8_BAR;
            PG8_LDA(At, 0, 1); PG8_STAGE(PG8_SA(0, 0), a2, vA2);
            PG8_BAR; PG8_WAIT_L(0); PG8_MMA(1, 0, At, B0); PG8_BAR; PG8_SCHED;
            PG8_STAGE(PG8_SB(0, 1), b2 + hs2, vB2);
            PG8_WAIT_V(6); PG8_BAR; PG8_MMA(1, 1, At, B1); PG8_BAR;
            PG8_LDB(B0, 1, 0); PG8_SCHED; PG8_LDA(At, 1, 0); PG8_STAGE(PG8_SA(0, 1), a2 + hs2, vA2);
            PG8_WAIT_L(8); PG8_BAR; PG8_WAIT_L(0); PG8_MMA(0, 0, At, B0); PG8_BAR; PG8_SCHED;
            PG8_LDB(B1, 1, 1); PG8_STAGE(PG8_SB(1, 0), b3, vB2);
            PG8_BAR; PG8_WAIT_L(0); PG8_MMA(0, 1, At, B1); PG8_BAR;
            PG8_LDA(At, 1, 1); PG8_STAGE(PG8_SA(1, 0), a3, vA2);
            PG8_BAR; PG8_WAIT_L(0); PG8_MMA(1, 0, At, B0); PG8_BAR; PG8_SCHED;
            PG8_STAGE(PG8_SB(1, 1), b3 + hs2, vB2);
            PG8_WAIT_V(6); PG8_BAR; PG8_MMA(1, 1, At, B1); PG8_BAR;
        }
        E(acc, cur, wr, wc, fr, fq);
        if (!has_next) break;
#pragma unroll
        for (int a = 0; a < 2; ++a)
#pragma unroll
            for (int b = 0; b < 2; ++b)
#pragma unroll
                for (int m = 0; m < 4; ++m)
#pragma unroll
                    for (int n = 0; n < 2; ++n) acc[a][b][m][n] = (f32x4){0.f, 0.f, 0.f, 0.f};
#pragma unroll
        for (int i = 0; i < 2; ++i) { vAc[i] = ((vAc[i] >> shC) << shN) | (vAc[i] & cmask); vBc[i] = ((vBc[i] >> shC) << shN) | (vBc[i] & cmask); }
        cur = nxt; cA = nA; cB = nB; ksC = ksN; hsC = hsN; shC = shN; ++ui;
    }
    PG8_WAIT_V(0);
    if (wr == 0) PG8_BAR;
    PG8_BAR;
#undef PG8_SA
#undef PG8_SB
#undef PG8_STAGE
#undef PG8_LDA
#undef PG8_LDB
#undef PG8_MMA
#undef PG8_WAIT_V
#undef PG8_WAIT_L
#undef PG8_BAR
#undef PG8_SCHED
}
}
#define XB_TMO      128
#define XB_XCNT(j)  (256  + 64 * (j))
#define XB_XSUB(j)  (1280 + 64 * (j))
#define XB_XGEN(j)  (2304 + 64 * (j))
#define XB_TOP      3328
#define XB_TOPGEN   3392
#define XCD_BAR_WORDS 3456
#define XB_SPIN_CAP (1u << 18)
#define LAS __attribute__((address_space(3)))
__device__ __forceinline__ unsigned xb_ld(unsigned* p)              { return __hip_atomic_load(p, __ATOMIC_RELAXED, __HIP_MEMORY_SCOPE_AGENT); }
__device__ __forceinline__ unsigned xb_add(unsigned* p, unsigned v) { return __hip_atomic_fetch_add(p, v, __ATOMIC_RELAXED, __HIP_MEMORY_SCOPE_AGENT); }
__device__ __forceinline__ unsigned xb_xcc_id() { return (unsigned)__builtin_amdgcn_s_getreg((3 << 11) | 20) & 0xFu; }
#define XB_SPIN(cond, bar) do { unsigned _sp = 0; while (cond) { __builtin_amdgcn_s_sleep(1); \
    if ((++_sp & 255u) == 0u) { if (xb_ld(&(bar)[XB_TMO])) break; if (_sp > XB_SPIN_CAP) { atomicAdd(&(bar)[XB_TMO], 1u); break; } } } } while (0)

struct XcdBarrier {
    unsigned* bar; unsigned x;
    volatile LAS unsigned* st;
};

__device__ __forceinline__ XcdBarrier xcd_barrier_post(unsigned* bar, volatile LAS unsigned* st) {
    XcdBarrier b; b.bar = bar; b.x = xb_xcc_id(); b.st = st;
    if (threadIdx.x == 0) (void)xb_add(&bar[XB_XCNT(b.x)], 1u);
    return b;
}
__device__ __forceinline__ void xcd_barrier_complete(unsigned* bar, unsigned x, unsigned& nloc, unsigned& nx) {
    const unsigned G = gridDim.x * gridDim.y * gridDim.z;
    unsigned sum, cnt, mine, sp = 0u;
    for (;;) {
        sum = 0u; cnt = 0u; mine = 0u;
#pragma unroll
        for (unsigned j = 0; j < 16; ++j) { const unsigned c = xb_ld(&bar[XB_XCNT(j)]); sum += c; cnt += (c > 0u) ? 1u : 0u; mine = (j == x) ? c : mine; }
        if (sum == G) break;
        __builtin_amdgcn_s_sleep(1);
        if ((++sp & 255u) == 0u) { if (xb_ld(&bar[XB_TMO])) break; if (sp > XB_SPIN_CAP) { atomicAdd(&bar[XB_TMO], 1u); break; } }
    }
    nloc = mine > 0u ? mine : 1u; nx = cnt > 0u ? cnt : 1u;
}

template <class F> __device__ __forceinline__ void xcd_barrier(const XcdBarrier& b, F&& shadow) {
    asm volatile("s_waitcnt vmcnt(0)" ::: "memory");
    __syncthreads();
    if (threadIdx.x == 0) {
        unsigned* bar = b.bar;
        __builtin_amdgcn_s_waitcnt(0);
        unsigned nloc = b.st[0], nx = b.st[1];
        if (nloc == 0u) { xcd_barrier_complete(bar, b.x, nloc, nx); b.st[0] = nloc; b.st[1] = nx; }
        const unsigned old = xb_add(&bar[XB_XSUB(b.x)], 1u);
        const unsigned gen = old / nloc;
        if (old + 1u == (gen + 1u) * nloc) {
            __builtin_amdgcn_fence(__ATOMIC_RELEASE, "agent");
            asm volatile("s_waitcnt vmcnt(0)" ::: "memory");
            const unsigned og = xb_add(&bar[XB_TOP], 1u);
            const unsigned tg = og / nx;
            if (og + 1u == (tg + 1u) * nx) xb_add(&bar[XB_TOPGEN], 1u);
            else XB_SPIN(xb_ld(&bar[XB_TOPGEN]) == tg, bar);
            __builtin_amdgcn_fence(__ATOMIC_ACQUIRE, "agent");
            xb_add(&bar[XB_XGEN(b.x)], 1u);
            asm volatile("s_waitcnt vmcnt(0)" ::: "memory");
        } else {
            XB_SPIN(xb_ld(&bar[XB_XGEN(b.x)]) == gen, bar);
            __builtin_amdgcn_fence(__ATOMIC_ACQUIRE, "agent");
            asm volatile("s_waitcnt vmcnt(0)" ::: "memory");
        }
    } else if (threadIdx.x >= 64) shadow();
    __syncthreads();
}
using pg8::f32x4; using pg8::u32x4; using pg8::bf16_t; using pg8::Unit;
#define DI __device__ __forceinline__
constexpr int M_TOK = 16384, DM = 1024, SEQ = 2048, NPHASE = 10;
constexpr float EPS = 1e-6f;
constexpr int LDS_ST = 147456, LDS_BYTES = LDS_ST + 16;
constexpr size_t MiB = 1024 * 1024;
constexpr size_t OFF_WIN1 = 0, OFF_WAOUT = 4 * MiB, OFF_WPLE0 = 6 * MiB, OFF_WPLE1 = 6 * MiB + 512 * 1024, OFF_WG0 = 7 * MiB, OFF_WG1 = 9 * MiB,
                 OFF_WKQZ = 11 * MiB, OFF_WV = 17 * MiB, OFF_WBOUT = 19 * MiB, OFF_PB = 21 * MiB, OFF_R1 = 37 * MiB, OFF_R2 = 69 * MiB, OFF_R3 = 101 * MiB,
                 OFF_R4 = 133 * MiB, OFF_RSTD0 = 197 * MiB, OFF_RSTD1 = 197 * MiB + 65536, OFF_SSP = 197 * MiB + 131072, OFF_BAR = 199 * MiB, OFF_E1 = 200 * MiB, WS_END = 232 * MiB;

struct Params {
    const float *x, *p, *a_norm, *a_w_in, *a_w_group, *a_scale, *a_w_out, *kv_norm, *w_kv, *k_norm, *b_norm, *b_w_in, *b_q_norm, *b_w_out, *ple_w, *ple_gate_w;
    float* out; unsigned char* ws; int ph_lo, ph_hi;
};

typedef __bf16 bf16x2_t __attribute__((ext_vector_type(2)));
typedef float f32x2_t __attribute__((ext_vector_type(2)));
typedef unsigned u32x2_t __attribute__((ext_vector_type(2)));
typedef short s16x8 __attribute__((ext_vector_type(8)));
typedef short s16x4 __attribute__((ext_vector_type(4)));
typedef float f32x16 __attribute__((ext_vector_type(16)));
DI unsigned pk2(float lo, float hi) { f32x2_t v = {lo, hi}; bf16x2_t r = __builtin_convertvector(v, bf16x2_t); return __builtin_bit_cast(unsigned, r); }
DI float bflo(unsigned u) { return __uint_as_float(u << 16); }
DI float bfhi(unsigned u) { return __uint_as_float(u & 0xffff0000u); }
DI u32x4 pk8(f32x4 a, f32x4 b) { u32x4 w; w.x = pk2(a[0], a[1]); w.y = pk2(a[2], a[3]); w.z = pk2(b[0], b[1]); w.w = pk2(b[2], b[3]); return w; }
DI float wave_sum(float v) {
#pragma unroll
    for (int o = 1; o < 64; o <<= 1) v += __shfl_xor(v, o);
    return v;
}
DI float sigm(float v) { return __builtin_amdgcn_rcpf(1.f + __expf(-v)); }
DI f32x4 silu4(f32x4 v) { f32x4 r; r[0] = v[0] * sigm(v[0]); r[1] = v[1] * sigm(v[1]); r[2] = v[2] * sigm(v[2]); r[3] = v[3] * sigm(v[3]); return r; }
DI f32x4 sigm4(f32x4 v) { f32x4 r; r[0] = sigm(v[0]); r[1] = sigm(v[1]); r[2] = sigm(v[2]); r[3] = sigm(v[3]); return r; }

typedef const f32x4 (&AccRef)[2][2][4][2];

struct Epi1 {
    static constexpr bool PERM = true, AFTER_DRAIN = false;
    bf16_t* ug; bf16_t* sz; const float* rstd0;
    DI void operator()(AccRef acc, const Unit& u, int wr, int wc, int fr, int fq) const {
        const int row0 = u.pm * 256 + wr * 64 + fr; const bool isz = u.pn >= 4;
        bf16_t* base = (isz ? sz : ug) + (u.pn & 3) * 256 + wc * 32 + 8 * fq;
        float rsv[2][4];
#pragma unroll
        for (int ai = 0; ai < 2; ++ai)
#pragma unroll
            for (int m = 0; m < 4; ++m) rsv[ai][m] = rstd0[row0 + ai * 128 + m * 16];
#pragma unroll
        for (int ai = 0; ai < 2; ++ai)
#pragma unroll
            for (int m = 0; m < 4; ++m) { const int row = row0 + ai * 128 + m * 16; const float rs = rsv[ai][m]; bf16_t* rowp = base + (size_t)row * DM;
#pragma unroll
                for (int bj = 0; bj < 2; ++bj) { f32x4 v0 = acc[ai][bj][m][0] * rs, v1 = acc[ai][bj][m][1] * rs;
                    if (isz) { v0 = silu4(v0); v1 = silu4(v1); }
                    *(u32x4*)(rowp + bj * 128) = pk8(v0, v1); } }
    }
};
struct EpiE {
    static constexpr bool PERM = true, AFTER_DRAIN = false;
    bf16_t* e;
    DI void operator()(AccRef acc, const Unit& u, int wr, int wc, int fr, int fq) const {
        const int row0 = u.pm * 256 + wr * 64 + fr; bf16_t* base = e + u.pn * 256 + wc * 32 + 8 * fq;
#pragma unroll
        for (int ai = 0; ai < 2; ++ai)
#pragma unroll
            for (int m = 0; m < 4; ++m) { bf16_t* rowp = base + (size_t)(row0 + ai * 128 + m * 16) * DM;
#pragma unroll
                for (int bj = 0; bj < 2; ++bj) *(u32x4*)(rowp + bj * 128) = pk8(acc[ai][bj][m][0], acc[ai][bj][m][1]); }
    }
};
DI void unpk8(const u32x4 q, f32x4& lo, f32x4& hi) { lo = (f32x4){bflo(q.x), bfhi(q.x), bflo(q.y), bfhi(q.y)}; hi = (f32x4){bflo(q.z), bfhi(q.z), bflo(q.w), bfhi(q.w)}; }
template <bool SRCF32> struct EpiResB {
    static constexpr bool PERM = true, AFTER_DRAIN = false;
    const float* srcf; const bf16_t* srcb; bf16_t* xb;
    DI void operator()(AccRef acc, const Unit& u, int wr, int wc, int fr, int fq) const {
        const int row0 = u.pm * 256 + wr * 64 + fr, col0 = u.pn * 256 + wc * 32 + 8 * fq;
#pragma unroll
        for (int ai = 0; ai < 2; ++ai) {
            f32x4 a[4][2][2];
#pragma unroll
            for (int m = 0; m < 4; ++m) { const size_t o = (size_t)(row0 + ai * 128 + m * 16) * DM + col0;
#pragma unroll
                for (int bj = 0; bj < 2; ++bj) {
                    if (SRCF32) { a[m][bj][0] = __builtin_nontemporal_load((const f32x4*)(srcf + o + bj * 128)); a[m][bj][1] = __builtin_nontemporal_load((const f32x4*)(srcf + o + bj * 128 + 4)); }
                    else { const u32x4 q = *(const u32x4*)(srcb + o + bj * 128); unpk8(q, a[m][bj][0], a[m][bj][1]); } } }
#pragma unroll
            for (int m = 0; m < 4; ++m) { const size_t o = (size_t)(row0 + ai * 128 + m * 16) * DM + col0;
#pragma unroll
                for (int bj = 0; bj < 2; ++bj) *(u32x4*)(xb + o + bj * 128) = pk8(a[m][bj][0] + acc[ai][bj][m][0], a[m][bj][1] + acc[ai][bj][m][1]); }
        }
    }
};
template <bool NEXT> struct EpiGate {
    static constexpr bool PERM = true, AFTER_DRAIN = false;
    const bf16_t* xin; const bf16_t* e; bf16_t* xb; float* ssp; float* outf;
    DI void operator()(AccRef acc, const Unit& u, int wr, int wc, int fr, int fq) const {
        const int row0 = u.pm * 256 + wr * 64 + fr, col0 = u.pn * 256 + wc * 32 + 8 * fq;
#pragma unroll
        for (int ai = 0; ai < 2; ++ai) {
            u32x4 xv[4][2], ev[4][2];
#pragma unroll
            for (int m = 0; m < 4; ++m) { const size_t o = (size_t)(row0 + ai * 128 + m * 16) * DM + col0;
#pragma unroll
                for (int bj = 0; bj < 2; ++bj) { xv[m][bj] = *(const u32x4*)(xin + o + bj * 128); ev[m][bj] = *(const u32x4*)(e + o + bj * 128); } }
#pragma unroll
            for (int m = 0; m < 4; ++m) { const int row = row0 + ai * 128 + m * 16; const size_t o = (size_t)row * DM + col0; float ss = 0.f;
#pragma unroll
                for (int bj = 0; bj < 2; ++bj) { f32x4 a0, a1, e0, e1; unpk8(xv[m][bj], a0, a1); unpk8(ev[m][bj], e0, e1);
                    const f32x4 v0 = a0 + e0 * sigm4(acc[ai][bj][m][0]), v1 = a1 + e1 * sigm4(acc[ai][bj][m][1]);
                    if (NEXT) { *(u32x4*)(xb + o + bj * 128) = pk8(v0, v1);
                        ss += (v0[0] * v0[0] + v0[1] * v0[1]) + (v0[2] * v0[2] + v0[3] * v0[3]) + (v1[0] * v1[0] + v1[1] * v1[1]) + (v1[2] * v1[2] + v1[3] * v1[3]); }
                    else { __builtin_nontemporal_store(v0, (f32x4*)(outf + o + bj * 128)); __builtin_nontemporal_store(v1, (f32x4*)(outf + o + bj * 128 + 4)); } }
                if (NEXT) { ss += __shfl_xor(ss, 16); ss += __shfl_xor(ss, 32); if (fq == 0) atomicAdd(ssp + row, ss); } }
        }
    }
};
struct EpiKQZ {
    static constexpr bool PERM = true, AFTER_DRAIN = false;
    bf16_t *kk, *qq, *sz2; const float *rstd1, *k_norm, *q_norm;
    DI void operator()(AccRef acc, const Unit& u, int wr, int wc, int fr, int fq) const {
        const int row0 = u.pm * 256 + wr * 64 + fr, kind = u.pn >> 2, pq = u.pn & 3;
        float rsv[2][4];
#pragma unroll
        for (int ai = 0; ai < 2; ++ai)
#pragma unroll
            for (int m = 0; m < 4; ++m) rsv[ai][m] = rstd1[row0 + ai * 128 + m * 16];
        if (kind == 2) {
            bf16_t* base = sz2 + pq * 256 + 64 * wc + 8 * fq;
#pragma unroll
            for (int ai = 0; ai < 2; ++ai)
#pragma unroll
                for (int m = 0; m < 4; ++m) { const int row = row0 + ai * 128 + m * 16; const float rs = rsqrtf(rsv[ai][m] * (1.f / DM) + EPS); bf16_t* rowp = base + (size_t)row * DM;
#pragma unroll
                    for (int bj = 0; bj < 2; ++bj) *(u32x4*)(rowp + bj * 32) = pk8(silu4(acc[ai][bj][m][0] * rs), silu4(acc[ai][bj][m][1] * rs)); }
        } else {
            const float* gn = kind ? q_norm : k_norm; const float mul = kind ? 0.125f * 1.4426950408889634f : 1.f;
            bf16_t* dst = kind ? qq : kk; const int head = pq * 4 + wc;
            f32x4 g[2][2];
#pragma unroll
            for (int bj = 0; bj < 2; ++bj)
#pragma unroll
                for (int n = 0; n < 2; ++n) g[bj][n] = *(const f32x4*)(gn + 32 * bj + 8 * fq + 4 * n) * mul;
#pragma unroll
            for (int ai = 0; ai < 2; ++ai)
#pragma unroll
                for (int m = 0; m < 4; ++m) { const int row = row0 + ai * 128 + m * 16; const float rs = rsqrtf(rsv[ai][m] * (1.f / DM) + EPS); const int b = row >> 11, s = row & 2047;
                    f32x4 v[2][2]; float ss = 0.f;
#pragma unroll
                    for (int bj = 0; bj < 2; ++bj)
#pragma unroll
                        for (int n = 0; n < 2; ++n) { v[bj][n] = acc[ai][bj][m][n] * rs; ss += (v[bj][n][0] * v[bj][n][0] + v[bj][n][1] * v[bj][n][1]) + (v[bj][n][2] * v[bj][n][2] + v[bj][n][3] * v[bj][n][3]); }
                    ss += __shfl_xor(ss, 16); ss += __shfl_xor(ss, 32);
                    const float hr = rsqrtf(ss * (1.f / 64.f) + EPS);
                    bf16_t* rowp = dst + ((size_t)(b * 16 + head) * SEQ + s) * 64 + 8 * fq;
#pragma unroll
                    for (int bj = 0; bj < 2; ++bj) *(u32x4*)(rowp + 32 * bj) = pk8(v[bj][0] * hr * g[bj][0], v[bj][1] * hr * g[bj][1]); }
        }
    }
};
struct EpiVT {
    static constexpr bool PERM = true, AFTER_DRAIN = false;
    bf16_t* vt; const float* rstd1;
    DI void operator()(AccRef acc, const Unit& u, int wr, int wc, int fr, int fq) const {
        const int c0 = u.pm * 256 + wr * 64 + fr, tok0 = u.pn * 256 + wc * 32 + 8 * fq;
        f32x4 rs[2][2];
#pragma unroll
        for (int bj = 0; bj < 2; ++bj)
#pragma unroll
            for (int n = 0; n < 2; ++n) { const f32x4 q = *(const f32x4*)(rstd1 + tok0 + 128 * bj + 4 * n);
#pragma unroll
                for (int j = 0; j < 4; ++j) rs[bj][n][j] = rsqrtf(q[j] * (1.f / DM) + EPS); }
#pragma unroll
        for (int ai = 0; ai < 2; ++ai)
#pragma unroll
            for (int m = 0; m < 4; ++m) { const int c = c0 + ai * 128 + m * 16;
#pragma unroll
                for (int bj = 0; bj < 2; ++bj) { const int tok = tok0 + 128 * bj, b = tok >> 11, s = tok & 2047;
                    *(u32x4*)(vt + ((size_t)b * DM + c) * SEQ + s) = pk8(acc[ai][bj][m][0] * rs[bj][0], acc[ai][bj][m][1] * rs[bj][1]); } }
    }
};
template <class Epi> DI void run_gemm(PG8_LAS unsigned char* lds, const bf16_t* A, const bf16_t* Bt, int M, int N, int K, const Epi& E) {
    pg8::Gemm g{A, Bt, M, N, K}; pg8::StaticOrder S; S.init(M, N, (int)gridDim.x, (int)blockIdx.x);
    pg8::gemm_phase<Epi, pg8::StaticOrder, false>(lds, g, S, E, nullptr);
}

struct SchedPG {
    const unsigned char* ws; int layer, G, c;
    DI bool next(int i, pg8::UnitX& u) const { const int L = i * G + c; if (L >= 512) return false;
        pg8::map_unit(L & 255, 64, 4, u.pm, u.pn); u.kind = L >> 8; return true; }
    DI pg8::GDesc desc(int k) const { pg8::GDesc d;
        const size_t oa = k == 0 ? OFF_PB + (size_t)layer * M_TOK * 256 * 2 : OFF_R2, ob = k == 0 ? (layer ? OFF_WPLE1 : OFF_WPLE0) : (layer ? OFF_WG1 : OFF_WG0);
        d.A = (const bf16_t*)(ws + oa); d.Bt = (const bf16_t*)(ws + ob); d.ks = k == 0 ? 256 : 1024; return d; }
    DI void a_ready(const pg8::UnitX&) const {}
    DI void done(const pg8::UnitX&) const {}
};
template <bool NEXT> struct EpiPG {
    static constexpr bool PERM = true;
    EpiE e; EpiGate<NEXT> g;
    DI void operator()(AccRef acc, const pg8::UnitX& u, int wr, int wc, int fr, int fq) const { const Unit uu{u.pm, u.pn};
        if (u.kind == 0) e(acc, uu, wr, wc, fr, fq); else g(acc, uu, wr, wc, fr, fq); }
};
struct SchedP6 {
    const unsigned char* ws; int G, c;
    DI bool next(int i, pg8::UnitX& u) const { const int L = i * G + c; if (L >= 1024) return false;
        if (L < 768) { pg8::map_unit(L, 64, 12, u.pm, u.pn); u.kind = 0; } else { pg8::map_unit(L - 768, 4, 64, u.pm, u.pn); u.kind = 1; }
        return true; }
    DI pg8::GDesc desc(int k) const { pg8::GDesc d; d.A = (const bf16_t*)(ws + (k == 0 ? OFF_R3 : OFF_WV)); d.Bt = (const bf16_t*)(ws + (k == 0 ? OFF_WKQZ : OFF_R3)); d.ks = 1024; return d; }
};
struct EpiP6 {
    static constexpr bool PERM = true;
    EpiKQZ a; EpiVT b;
    DI void operator()(AccRef acc, const pg8::UnitX& u, int wr, int wc, int fr, int fq) const { const Unit uu{u.pm, u.pn};
        if (u.kind == 0) a(acc, uu, wr, wc, fr, fq); else b(acc, uu, wr, wc, fr, fq); }
};

DI int headperm(int cl) { const int o = cl & 255, wc = o >> 6, bj = (o >> 5) & 1, r = o & 31; return (cl & ~255) + 128 * bj + 32 * wc + r; }
DI void transpose_item(float* scr, const float* src, int ld, int K, int nT, const float* gain, bf16_t* dst, int rowoff, bool perm, int item, int lane) {
    const int kt = item / nT, nt = item - kt * nT, k0 = kt * 64, n0 = nt * 32, lr = lane >> 3, lc = lane & 7;
    float4 v[8];
#pragma unroll
    for (int i = 0; i < 8; ++i) v[i] = *(const float4*)(src + (size_t)(k0 + i * 8 + lr) * ld + n0 + lc * 4);
    float gk[8];
#pragma unroll
    for (int i = 0; i < 8; ++i) gk[i] = gain ? gain[k0 + 8 * lc + i] : 1.f;
#pragma unroll
    for (int i = 0; i < 8; ++i) { float* t = scr + (i * 8 + lr) * 33 + lc * 4; t[0] = v[i].x; t[1] = v[i].y; t[2] = v[i].z; t[3] = v[i].w; }
    asm volatile("s_waitcnt lgkmcnt(0)" ::: "memory");
#pragma unroll
    for (int j = 0; j < 4; ++j) { const int n = lr + 8 * j; const float* t = scr + (8 * lc) * 33 + n;
        int row = rowoff + n0 + n; if (perm) row = headperm(row);
        u32x4 w; w.x = pk2(t[0] * gk[0], t[33] * gk[1]); w.y = pk2(t[66] * gk[2], t[99] * gk[3]); w.z = pk2(t[132] * gk[4], t[165] * gk[5]); w.w = pk2(t[198] * gk[6], t[231] * gk[7]);
        *(u32x4*)(dst + (size_t)row * K + k0 + 8 * lc) = w; }
    asm volatile("s_waitcnt lgkmcnt(0)" ::: "memory");
}
DI void weff_job(float* L, const Params& P, bf16_t* dst, int job) {
    float* As = L; float* Bs = L + 64 * 129;
    const int tid = threadIdx.x, k0 = (job >> 4) * 64, n0 = (job & 15) * 64, g = n0 >> 8, d0 = n0 & 255, kk = tid >> 3, dg = tid & 7;
    float acc[8];
#pragma unroll
    for (int j = 0; j < 8; ++j) acc[j] = 0.f;
    for (int c0 = 0; c0 < 256; c0 += 128) {
        __syncthreads();
#pragma unroll
        for (int i = 0; i < 4; ++i) { const int idx = tid + 512 * i;
            { const int r = idx >> 5, c4 = idx & 31; const float4 v = *(const float4*)(P.a_w_in + (size_t)(k0 + r) * 2048 + g * 256 + c0 + c4 * 4);
              float* t = As + r * 129 + c4 * 4; t[0] = v.x; t[1] = v.y; t[2] = v.z; t[3] = v.w; }
            { const int cc = idx >> 4, d4 = idx & 15; *(float4*)(Bs + cc * 64 + d4 * 4) = *(const float4*)(P.a_w_group + (size_t)(g * 256 + c0 + cc) * 256 + d0 + d4 * 4); } }
        __syncthreads();
#pragma unroll 4
        for (int c = 0; c < 128; ++c) { const float a = As[kk * 129 + c]; const float4 b0 = *(const float4*)(Bs + c * 64 + dg * 8), b1 = *(const float4*)(Bs + c * 64 + dg * 8 + 4);
            acc[0] += a * b0.x; acc[1] += a * b0.y; acc[2] += a * b0.z; acc[3] += a * b0.w; acc[4] += a * b1.x; acc[5] += a * b1.y; acc[6] += a * b1.z; acc[7] += a * b1.w; }
    }
    const float an = P.a_norm[k0 + kk];
#pragma unroll
    for (int j = 0; j < 8; ++j) { const int n = n0 + dg * 8 + j; const float v = acc[j] * an * P.a_scale[n];
        dst[(size_t)n * DM + k0 + kk] = (bf16_t)(pk2(v, v) & 0xffffu); }
}
DI void shadow_p_convert(const Params& P, int half) {
    const float4* pp = (const float4*)P.p; u32x4* pb = (u32x4*)(P.ws + OFF_PB);
    const int HALFCH = M_TOK * 256 / 8, step = gridDim.x * 448, base = half * HALFCH;
    for (int i = blockIdx.x * 448 + ((int)threadIdx.x - 64); i < HALFCH; i += 5 * step) { float4 a[5], b[5];
#pragma unroll
        for (int q = 0; q < 5; ++q) if (i + q * step < HALFCH) { a[q] = pp[2 * (base + i + q * step)]; b[q] = pp[2 * (base + i + q * step) + 1]; }
#pragma unroll
        for (int q = 0; q < 5; ++q) if (i + q * step < HALFCH) { u32x4 u; u.x = pk2(a[q].x, a[q].y); u.y = pk2(a[q].z, a[q].w); u.z = pk2(b[q].x, b[q].y); u.w = pk2(b[q].z, b[q].w); pb[base + i + q * step] = u; } }
}
DI void deferred_items(const Params& P, float* L, int seam) {
    const int wid = threadIdx.x >> 6, lane = threadIdx.x & 63; unsigned char* ws = P.ws; float* scr = L + wid * (64 * 33);
    const int nitems = (seam == 0) ? 768 : (seam == 1 ? 512 : 1024);
    for (int t = blockIdx.x * 7 + (wid - 1); t < nitems; t += gridDim.x * 7) {
        const int r = t & 511, hi = t >> 9;
        if (seam == 0) { if (hi == 0) transpose_item(scr, P.a_w_out, 1024, 1024, 32, nullptr, (bf16_t*)(ws + OFF_WAOUT), 0, false, r, lane);
                         else if (r < 128) transpose_item(scr, P.ple_w, 1024, 256, 32, nullptr, (bf16_t*)(ws + OFF_WPLE0), 0, false, r, lane);
                         else transpose_item(scr, P.ple_w + 256 * 1024, 1024, 256, 32, nullptr, (bf16_t*)(ws + OFF_WPLE1), 0, false, r - 128, lane); }
        else if (seam == 1) transpose_item(scr, P.ple_gate_w, 1024, 1024, 32, nullptr, (bf16_t*)(ws + OFF_WG0), 0, false, r, lane);
        else if (seam == 2) { if (hi == 0) transpose_item(scr, P.w_kv, 2048, 1024, 32, P.kv_norm, (bf16_t*)(ws + OFF_WKQZ), 0, true, r, lane);
                              else transpose_item(scr, P.w_kv + 1024, 2048, 1024, 32, P.kv_norm, (bf16_t*)(ws + OFF_WV), 0, false, r, lane); }
        else if (seam == 3) transpose_item(scr, P.b_w_in, 2048, 1024, 64, P.b_norm, (bf16_t*)(ws + OFF_WKQZ), 1024, true, t, lane);
        else { if (hi == 0) transpose_item(scr, P.b_w_out, 1024, 1024, 32, nullptr, (bf16_t*)(ws + OFF_WBOUT), 0, false, r, lane);
               else transpose_item(scr, P.ple_gate_w + 1024 * 1024, 1024, 1024, 32, nullptr, (bf16_t*)(ws + OFF_WG1), 0, false, r, lane); }
    }
    if (seam < 2) shadow_p_convert(P, seam);
}
DI void phase0(const Params& P, float* L) {
    const int tid = threadIdx.x, wid = tid >> 6, lane = tid & 63, w = blockIdx.x, G = gridDim.x;
    unsigned char* ws = P.ws;
    { float* ss1 = (float*)(ws + OFF_RSTD1); for (int i = w * 512 + tid; i < M_TOK; i += G * 512) ss1[i] = 0.f; }
    if ((w & 1) == 0) { for (int job = w; job < 256; job += G) weff_job(L, P, (bf16_t*)(ws + OFF_WIN1), job); __syncthreads(); }
    { float* scr = L + wid * (64 * 33);
      for (int t = w * 8 + wid; t < 512; t += G * 8) transpose_item(scr, P.a_w_in + 1024, 2048, 1024, 32, P.a_norm, (bf16_t*)(ws + OFF_WIN1) + (size_t)1024 * 1024, 0, false, t, lane); }
    { bf16_t* xb = (bf16_t*)(ws + OFF_R1); float* rstd0 = (float*)(ws + OFF_RSTD0);
      for (int row = (w * 8 + wid) * 8; row < M_TOK; row += G * 64) {
          float4 v[8][4];
#pragma unroll
          for (int q = 0; q < 8; ++q)
#pragma unroll
              for (int j = 0; j < 4; ++j) v[q][j] = ((const float4*)(P.x + (size_t)(row + q) * DM) + lane)[64 * j];
#pragma unroll
          for (int q = 0; q < 8; ++q) { float s = 0.f;
#pragma unroll
              for (int j = 0; j < 4; ++j) s += (v[q][j].x * v[q][j].x + v[q][j].y * v[q][j].y) + (v[q][j].z * v[q][j].z + v[q][j].w * v[q][j].w);
              s = wave_sum(s);
              uint2* o = (uint2*)(xb + (size_t)(row + q) * DM) + lane;
#pragma unroll
              for (int j = 0; j < 4; ++j) { uint2 u; u.x = pk2(v[q][j].x, v[q][j].y); u.y = pk2(v[q][j].z, v[q][j].w); o[64 * j] = u; }
              if (lane == 0) rstd0[row + q] = rsqrtf(s * (1.f / DM) + EPS); } } }
    if ((w & 1) != 0) { __syncthreads(); for (int job = w; job < 256; job += G) weff_job(L, P, (bf16_t*)(ws + OFF_WIN1), job); }
}
DI void unpack8(const u32x4 q, float (&f)[8]) { f[0] = bflo(q.x); f[1] = bfhi(q.x); f[2] = bflo(q.y); f[3] = bfhi(q.y); f[4] = bflo(q.z); f[5] = bfhi(q.z); f[6] = bflo(q.w); f[7] = bfhi(q.w); }
DI void pool_phase(const Params& P) {
    const bf16_t* ug = (const bf16_t*)(P.ws + OFF_R2); const bf16_t* sz = (const bf16_t*)(P.ws + OFF_R3); bf16_t* Gd = (bf16_t*)(P.ws + OFF_R1);
    const int nth = gridDim.x * 512;
    for (int idx = blockIdx.x * 512 + threadIdx.x; idx < 131072; idx += nth) {
        const int chunk = idx & 127, run = idx >> 7, row0 = run * 16, t0 = row0 & (SEQ - 1), c0 = chunk * 8, wlen = 2 << (chunk >> 5);
        const u32x4* up = (const u32x4*)(ug + (size_t)row0 * DM + c0); const u32x4* zp = (const u32x4*)(sz + (size_t)row0 * DM + c0); u32x4* gp = (u32x4*)(Gd + (size_t)row0 * DM + c0);
        float s[8], c[8], z[8];
#pragma unroll
        for (int j = 0; j < 8; ++j) s[j] = 0.f;
        { const bool hist = t0 > 0;
#pragma unroll
          for (int j = 1; j <= 16; ++j) {
              const int jj = hist ? (j <= wlen ? j : wlen) : 0; const float mk = (hist && j <= wlen) ? 1.f : 0.f;
              unpack8(up[-(jj * 128)], c);
#pragma unroll
              for (int q = 0; q < 8; ++q) s[q] += mk * c[q]; } }
        const float inv_full = 1.f / (float)wlen;
#pragma unroll 4
        for (int rr = 0; rr < 16; ++rr) {
            const int t = t0 + rr;
            if (t >= wlen) { unpack8(up[(rr - wlen) * 128], c);
#pragma unroll
                for (int q = 0; q < 8; ++q) s[q] -= c[q]; }
            unpack8(up[rr * 128], c); unpack8(zp[rr * 128], z);
            const float inv = (t + 1 < wlen) ? 1.f / (float)(t + 1) : inv_full;
            float o[8];
#pragma unroll
            for (int q = 0; q < 8; ++q) { s[q] += c[q]; o[q] = (s[q] * inv - c[q]) * z[q]; }
            u32x4 w; w.x = pk2(o[0], o[1]); w.y = pk2(o[2], o[3]); w.z = pk2(o[4], o[5]); w.w = pk2(o[6], o[7]); gp[rr * 128] = w;
        }
    }
}
#define MFMA32(a, b, c) __builtin_amdgcn_mfma_f32_32x32x16_bf16((a), (b), (c), 0, 0, 0)
DI void attn_phase(const Params& P, PG8_LAS unsigned char* lds) {
    constexpr int HIST = 128, WIN = 384, KP = 144, VP = 776, NF = 6, VCH = 48;
    PG8_LAS unsigned char* Kl = lds; PG8_LAS unsigned char* Vl = lds + WIN * KP;
    const bf16_t* kk = (const bf16_t*)(P.ws + OFF_R1); const bf16_t* qq = (const bf16_t*)(P.ws + OFF_R2); const bf16_t* vt = (const bf16_t*)(P.ws + OFF_R4);
    const bf16_t* sz2 = (const bf16_t*)(P.ws + OFF_R4 + 32 * MiB); bf16_t* g2 = (bf16_t*)P.out;
    const int tid = threadIdx.x, wid = tid >> 6, lane = tid & 63, r = lane & 31, hh = lane >> 5;
#define ATT_LOAD_FILL(IT, KV, VV) do { const int _bh = (IT) >> 3, _wlo = ((IT) & 7) * 256 - HIST; const bf16_t* _Kg = kk + (size_t)_bh * SEQ * 64; const bf16_t* _Vg = vt + (size_t)_bh * 64 * SEQ; \
        _Pragma("unroll") for (int i = 0; i < NF; ++i) { const int c = tid + 512 * i, row = c >> 3, part = c & 7, key = _wlo + row; if (key >= 0) KV[i] = *(const u32x4*)(_Kg + (size_t)key * 64 + part * 8); } \
        _Pragma("unroll") for (int i = 0; i < NF; ++i) { const int c = tid + 512 * i, d = c / VCH, part = c - d * VCH, key0 = _wlo + part * 8; if (key0 >= 0) VV[i] = *(const u32x4*)(_Vg + (size_t)d * SEQ + key0); } } while (0)
#define ATT_LOAD_Q(IT, QF) do { const bf16_t* _Qp = qq + ((size_t)((IT) >> 3) * SEQ + ((IT) & 7) * 256 + 32 * wid + r) * 64 + hh * 8; \
        _Pragma("unroll") for (int ks = 0; ks < 4; ++ks) QF[ks] = *(const s16x8*)(_Qp + ks * 16); } while (0)
    u32x4 kv[NF], vv[NF];
    if ((int)blockIdx.x < 1024) { ATT_LOAD_FILL((int)blockIdx.x, kv, vv); }
    for (int item = blockIdx.x; item < 1024; item += gridDim.x) {
        const int qc = item & 7, bh = item >> 3, t0 = qc * 256, wlo = t0 - HIST, tq = t0 + 32 * wid;
        const bf16_t* Kg = kk + (size_t)bh * SEQ * 64; const bf16_t* Vg = vt + (size_t)bh * 64 * SEQ;
        const int b = bh >> 4, h = bh & 15; const size_t rowo = ((size_t)b * SEQ + tq + r) * DM + h * 64 + 4 * hh;
        s16x8 qf[4]; ATT_LOAD_Q(item, qf);
        __syncthreads();
#pragma unroll
        for (int i = 0; i < NF; ++i) { const int c = tid + 512 * i, row = c >> 3, part = c & 7, key = wlo + row;
            if (key >= 0) *(PG8_LAS u32x4*)(Kl + row * KP + part * 16) = kv[i]; }
#pragma unroll
        for (int i = 0; i < NF; ++i) { const int c = tid + 512 * i, d = c / VCH, part = c - d * VCH, key0 = wlo + part * 8;
            if (key0 >= 0) { PG8_LAS u32x2_t* w = (PG8_LAS u32x2_t*)(Vl + d * VP + part * 16); u32x2_t a = {vv[i].x, vv[i].y}, bb = {vv[i].z, vv[i].w}; w[0] = a; w[1] = bb; } }
        __syncthreads();
        const size_t rowc = ((size_t)b * SEQ + tq + (lane >> 3)) * DM + h * 64 + (lane & 7) * 8;
        u32x4 zc[4];
#pragma unroll
        for (int i = 0; i < 4; ++i) zc[i] = *(const u32x4*)(sz2 + rowc + (size_t)(8 * i) * DM);
        const int nitem = item + gridDim.x;
        u32x4 kvn[NF], vvn[NF];
        if (nitem < 1024) { ATT_LOAD_FILL(nitem, kvn, vvn); }
        f32x16 o0, o1;
#pragma unroll
        for (int i = 0; i < 16; ++i) { o0[i] = 0.f; o1[i] = 0.f; }
        float carry = 1.f;
        for (int s0 = tq; s0 >= 0; s0 -= 32) {
            s16x8 kf[4]; s16x4 vf[2][2][2];
            if (s0 >= wlo) {
                PG8_LAS const unsigned char* kp = Kl + (s0 - wlo + r) * KP + hh * 16; PG8_LAS const unsigned char* vp = Vl + r * VP + (s0 - wlo + 4 * hh) * 2;
#pragma unroll
                for (int ks = 0; ks < 4; ++ks) kf[ks] = *(PG8_LAS const s16x8*)(kp + ks * 32);
#pragma unroll
                for (int dt = 0; dt < 2; ++dt)
#pragma unroll
                    for (int s = 0; s < 2; ++s)
#pragma unroll
                        for (int pt = 0; pt < 2; ++pt) vf[dt][s][pt] = *(PG8_LAS const s16x4*)(vp + dt * 32 * VP + (16 * s + 8 * pt) * 2);
            } else {
                const bf16_t* kp = Kg + (size_t)(s0 + r) * 64 + hh * 8; const bf16_t* vp = Vg + (size_t)r * SEQ + s0 + 4 * hh;
#pragma unroll
                for (int ks = 0; ks < 4; ++ks) kf[ks] = *(const s16x8*)(kp + ks * 16);
#pragma unroll
                for (int dt = 0; dt < 2; ++dt)
#pragma unroll
                    for (int s = 0; s < 2; ++s)
#pragma unroll
                        for (int pt = 0; pt < 2; ++pt) vf[dt][s][pt] = *(const s16x4*)(vp + (size_t)dt * 32 * SEQ + 16 * s + 8 * pt);
            }
            f32x16 x;
#pragma unroll
            for (int i = 0; i < 16; ++i) x[i] = 0.f;
#pragma unroll
            for (int ks = 0; ks < 4; ++ks) x = MFMA32(kf[ks], qf[ks], x);
            float beta[16], keep[16];
            const bool diag = (s0 == tq);
#pragma unroll
            for (int i = 0; i < 16; ++i) {
                const float l = fmaxf(x[i], -120.f);
                const float e = __builtin_amdgcn_exp2f(-l);
                float bt = __builtin_amdgcn_rcpf(1.f + e), kp = e * bt;
                beta[i] = bt; keep[i] = kp;
            }
            if (diag) {
#pragma unroll
                for (int i = 0; i < 16; ++i) { const bool valid = ((i & 3) + 8 * (i >> 2) + 4 * hh) < r; beta[i] = valid ? beta[i] : 0.f; keep[i] = valid ? keep[i] : 1.f; }
            }
            float Gp[4], PG[4];
#pragma unroll
            for (int g = 0; g < 4; ++g) { Gp[g] = (keep[4 * g] * keep[4 * g + 1]) * (keep[4 * g + 2] * keep[4 * g + 3]); PG[g] = __shfl_xor(Gp[g], 32); }
            float base[4];
            { float so = 1.f, sp = 1.f;
#pragma unroll
              for (int g = 3; g >= 0; --g) { base[g] = carry * so * sp * (hh == 0 ? PG[g] : 1.f); so *= Gp[g]; sp *= PG[g]; }
              carry = carry * so * sp; }
            float a[16];
#pragma unroll
            for (int g = 0; g < 4; ++g) { float run = base[g];
                a[4 * g + 3] = beta[4 * g + 3] * run; run *= keep[4 * g + 3];
                a[4 * g + 2] = beta[4 * g + 2] * run; run *= keep[4 * g + 2];
                a[4 * g + 1] = beta[4 * g + 1] * run; run *= keep[4 * g + 1];
                a[4 * g] = beta[4 * g] * run; }
#pragma unroll
            for (int s = 0; s < 2; ++s) {
                u32x4 pw; pw.x = pk2(a[8 * s], a[8 * s + 1]); pw.y = pk2(a[8 * s + 2], a[8 * s + 3]); pw.z = pk2(a[8 * s + 4], a[8 * s + 5]); pw.w = pk2(a[8 * s + 6], a[8 * s + 7]);
                const s16x8 pf = __builtin_bit_cast(s16x8, pw);
                const s16x8 va = __builtin_shufflevector(vf[0][s][0], vf[0][s][1], 0, 1, 2, 3, 4, 5, 6, 7);
                const s16x8 vb = __builtin_shufflevector(vf[1][s][0], vf[1][s][1], 0, 1, 2, 3, 4, 5, 6, 7);
                o0 = MFMA32(va, pf, o0); o1 = MFMA32(vb, pf, o1);
            }
            if (__all(carry < 1e-12f)) break;
        }
        { PG8_LAS unsigned char* S = lds + WIN * KP + 64 * VP + wid * 4608;
#pragma unroll
          for (int i = 0; i < 4; ++i) *(PG8_LAS u32x4*)(S + ((lane >> 3) + 8 * i) * 144 + (lane & 7) * 16) = zc[i];
          asm volatile("s_waitcnt lgkmcnt(0)" ::: "memory");
          PG8_LAS unsigned char* Sr = S + r * 144 + 8 * hh;
#pragma unroll
          for (int g = 0; g < 4; ++g) {
              const u32x2_t z0 = *(PG8_LAS const u32x2_t*)(Sr + 16 * g), z1 = *(PG8_LAS const u32x2_t*)(Sr + 64 + 16 * g);
              u32x2_t w0, w1;
              w0.x = pk2(o0[4 * g] * bflo(z0.x), o0[4 * g + 1] * bfhi(z0.x)); w0.y = pk2(o0[4 * g + 2] * bflo(z0.y), o0[4 * g + 3] * bfhi(z0.y));
              w1.x = pk2(o1[4 * g] * bflo(z1.x), o1[4 * g + 1] * bfhi(z1.x)); w1.y = pk2(o1[4 * g + 2] * bflo(z1.y), o1[4 * g + 3] * bfhi(z1.y));
              *(PG8_LAS u32x2_t*)(Sr + 16 * g) = w0; *(PG8_LAS u32x2_t*)(Sr + 64 + 16 * g) = w1; }
          asm volatile("s_waitcnt lgkmcnt(0)" ::: "memory");
#pragma unroll
          for (int i = 0; i < 4; ++i) { const u32x4 v = *(PG8_LAS const u32x4*)(S + ((lane >> 3) + 8 * i) * 144 + (lane & 7) * 16); *(u32x4*)(g2 + rowc + (size_t)(8 * i) * DM) = v; }
          asm volatile("s_waitcnt lgkmcnt(0)" ::: "memory"); }
#pragma unroll
        for (int i = 0; i < NF; ++i) { kv[i] = kvn[i]; vv[i] = vvn[i]; }
    }
#undef ATT_LOAD_FILL
#undef ATT_LOAD_Q
}

__global__ __launch_bounds__(512, 2) void yoco_fwd(Params P) {
    extern __shared__ __attribute__((aligned(16))) unsigned char shm[];
    PG8_LAS unsigned char* lds = (PG8_LAS unsigned char*)shm;
    unsigned char* ws = P.ws;
    bf16_t* R1 = (bf16_t*)(ws + OFF_R1); bf16_t* R2 = (bf16_t*)(ws + OFF_R2); bf16_t* R3 = (bf16_t*)(ws + OFF_R3); bf16_t* R4 = (bf16_t*)(ws + OFF_R4);
    float* rstd0 = (float*)(ws + OFF_RSTD0); float* rstd1 = (float*)(ws + OFF_RSTD1); float* ssp = (float*)(ws + OFF_SSP);
    const bf16_t* pb = (const bf16_t*)(ws + OFF_PB); bf16_t* E1b = (bf16_t*)(ws + OFF_E1);
#define PH(k) if (P.ph_lo <= (k) && (k) < P.ph_hi)
#define SYNC(k) if (fused) { if ((k) < 5) xcd_barrier(xb, [&]() { deferred_items(P, (float*)shm, (k)); }); else xcd_barrier(xb, []() {}); }
    const bool fused = (P.ph_hi - P.ph_lo) > 1;
    volatile LAS unsigned* st = (volatile LAS unsigned*)(lds + LDS_ST);
    unsigned* bar = (unsigned*)(ws + OFF_BAR);
    if (fused) { if (threadIdx.x == 0) { st[0] = 0u; st[1] = 0u; } __syncthreads(); }
    XcdBarrier xb; xb.bar = bar; xb.x = 0u; xb.st = st;
    if (fused) xb = xcd_barrier_post(bar, st);
    PH(0) phase0(P, (float*)shm);
    SYNC(0)
    PH(1) { Epi1 E{R2, R3, rstd0}; run_gemm(lds, R1, (const bf16_t*)(ws + OFF_WIN1), M_TOK, 2048, 1024, E); }
    SYNC(1)
    PH(2) pool_phase(P);
    SYNC(2)
    PH(3) { EpiResB<true> E{P.x, nullptr, R2}; run_gemm(lds, R1, (const bf16_t*)(ws + OFF_WAOUT), M_TOK, 1024, 1024, E); }
    SYNC(3)
    PH(4) { SchedPG S{ws, 0, (int)gridDim.x, (int)blockIdx.x}; EpiPG<true> E{EpiE{E1b}, EpiGate<true>{R2, E1b, R3, rstd1, nullptr}}; pg8::gemm_stream(lds, S, E); }
    SYNC(4)
    PH(6) { SchedP6 S{ws, (int)gridDim.x, (int)blockIdx.x};
            EpiP6 E{EpiKQZ{R1, R2, R4 + (size_t)M_TOK * DM, rstd1, P.k_norm, P.b_q_norm}, EpiVT{R4, rstd1}}; pg8::gemm_stream(lds, S, E); }
    SYNC(6)
    PH(7) attn_phase(P, lds);
    SYNC(7)
    PH(8) { EpiResB<false> E{nullptr, R3, R2}; run_gemm(lds, (const bf16_t*)P.out, (const bf16_t*)(ws + OFF_WBOUT), M_TOK, 1024, 1024, E); }
    SYNC(8)
    PH(9) { SchedPG S{ws, 1, (int)gridDim.x, (int)blockIdx.x}; EpiPG<false> E{EpiE{E1b}, EpiGate<false>{R2, E1b, nullptr, nullptr, P.out}}; pg8::gemm_stream(lds, S, E); }
}

extern "C" void kernel_launch(void* const* d_in, const int* in_sizes, int n_in, void* d_out, int out_size, void* d_ws, size_t ws_size, hipStream_t stream) {
    static int grid = 0;
    if (grid == 0) {
        int dev = 0, cus = 0, per_cu = 0;
        if (n_in != 16 || out_size != M_TOK * DM || ws_size < WS_END) { fprintf(stderr, "kernel_launch: unexpected shapes (n_in %d out %d ws %zu)\n", n_in, out_size, ws_size); grid = -1; return; }
        (void)hipGetDevice(&dev); (void)hipDeviceGetAttribute(&cus, hipDeviceAttributeMultiprocessorCount, dev);
        if (hipFuncSetAttribute((const void*)yoco_fwd, hipFuncAttributeMaxDynamicSharedMemorySize, LDS_BYTES) != hipSuccess) { fprintf(stderr, "kernel_launch: hipFuncSetAttribute failed\n"); grid = -1; return; }
        (void)hipOccupancyMaxActiveBlocksPerMultiprocessor(&per_cu, (const void*)yoco_fwd, 512, LDS_BYTES);
        if (per_cu < 1) { fprintf(stderr, "kernel_launch: occupancy query says %d blocks per CU\n", per_cu); (void)hipGetLastError(); per_cu = 1; }
        grid = cus;
    }
    if (grid < 0) return;
    Params p{};
    const float** pp = (const float**)&p;
    for (int i = 0; i < 16; ++i) pp[i] = (const float*)d_in[i];
    p.out = (float*)d_out; p.ws = (unsigned char*)d_ws;
    p.ph_lo = 0; p.ph_hi = NPHASE;
    if (hipMemsetAsync((unsigned char*)d_ws + OFF_BAR, 0, XCD_BAR_WORDS * 4, stream) != hipSuccess) { fprintf(stderr, "kernel_launch: memset of the barrier words failed\n"); return; }
    void* args[] = {&p};
    hipError_t e = hipLaunchCooperativeKernel((const void*)yoco_fwd, dim3(grid), dim3(512), args, LDS_BYTES, stream);
    if (e != hipSuccess) fprintf(stderr, "kernel_launch: cooperative launch failed: %s (grid %d)\n", hipGetErrorString(e), grid);
}
```

```cpp
#include <hip/hip_runtime.h>
#include <cstdio>
namespace pg8 {
#define PG8_LAS __attribute__((address_space(3)))
typedef unsigned short bf16_t;
typedef short bf16x8 __attribute__((ext_vector_type(8)));
typedef float f32x4 __attribute__((ext_vector_type(4)));
typedef unsigned u32x4 __attribute__((ext_vector_type(4)));
constexpr int BM = 256, BK = 64, HALF = 128, HTB = HALF * BK * 2  , STAGE_BYTES = 8 * HTB, NXCD = 8, WGM = 8;

__host__ __device__ __forceinline__ int lds_byte(int r, int c) { const int st = (r >> 4) * 2 + (c >> 5), rr = r & 15, cc = c & 31, ob = rr * 64 + cc * 2; return st * 1024 + (ob ^ (((ob >> 9) & 1) << 5)); }
__host__ __device__ __forceinline__ void stage_rc(int b, int& R, int& C) { const int st = b / 1024, sb = b % 1024, swz = sb ^ (((sb >> 9) & 1) << 5); R = (st >> 1) * 16 + swz / 64; C = (st & 1) * 32 + (swz % 64) / 2; }
__host__ __device__ __forceinline__ int perm32(int rho) { const int n = rho >> 4, i = rho & 15; return 8 * (i >> 2) + 4 * n + (i & 3); }

struct Unit { int pm, pn; };
struct Gemm { const bf16_t* A; const bf16_t* Bt; int M, N, K; };
struct StaticOrder {
    int nM, nN, nwg, G, c;
    __host__ __device__ void init(int M, int N, int G_, int c_) { nM = M / BM; nN = N / BM; nwg = nM * nN; G = G_; c = c_; }
    __host__ __device__ bool next(int i, Unit& u) const {
        const long L = (long)i * G + c; if (L >= nwg) return false;
        int wgid = (int)L; { const int q = nwg / NXCD, r = nwg % NXCD, xcd = wgid % NXCD, off = wgid / NXCD; wgid = (xcd < r ? xcd * (q + 1) : r * (q + 1) + (xcd - r) * q) + off; }
        const int nig = WGM * nN, gid = wgid / nig, fm = gid * WGM, gsz = (nM - fm) < WGM ? (nM - fm) : WGM;
        u.pm = fm + ((wgid % nig) % gsz); u.pn = (wgid % nig) / gsz; return true;
    }
    __device__ __forceinline__ void a_ready(const Unit&) const {}
    __device__ __forceinline__ void done(const Unit&) const {}
};
template <class Epi, class Sched, bool STAMP = false>
__device__ __forceinline__ void gemm_phase(PG8_LAS unsigned char* lds, const Gemm g, const Sched& S, const Epi& E, unsigned long long* stamps) {
    const int tid = threadIdx.x, wid = __builtin_amdgcn_readfirstlane(tid >> 6), lane = tid & 63, wr = wid >> 2, wc = wid & 3, fr = lane & 15, fq = lane >> 4;
    const int K = g.K, nt = K / BK;
    int ts_lo = 0, ts_hi = 0, nts = 0; const unsigned long long rt_entry = STAMP ? (unsigned long long)wall_clock64() : 0ull;
#define PG8_STAMP() do { if (STAMP && wid == 0 && nts < 64) { const unsigned long long _c = (unsigned long long)clock64(); \
        ts_lo = (lane == nts) ? (int)(unsigned)_c : ts_lo; ts_hi = (lane == nts) ? (int)(unsigned)(_c >> 32) : ts_hi; ++nts; } } while (0)
    PG8_STAMP();
    unsigned voffA[2], voffB[2];
#pragma unroll
    for (int i = 0; i < 2; ++i) { int R, C; stage_rc(tid * 16 + i * 8192, R, C); const int Rb = Epi::PERM ? ((R & ~31) + perm32(R & 31)) : R;
        voffA[i] = (unsigned)(R * K + C) * 2u; voffB[i] = (unsigned)(Rb * K + C) * 2u; }
    const size_t kstep = (size_t)(BK * 2);
    const size_t hstep = (size_t)HALF * K * 2;
    const size_t tstep = 2 * hstep;
    const unsigned ldsw = (unsigned)wid * 1024u;
    const int aoff = lds_byte(wr * 64 + fr, fq * 8), boff = lds_byte(wc * 32 + fr, fq * 8);
#define PG8_SA(b, h) (((b) * 2 + (h)) * HTB)
#define PG8_SB(b, h) ((4 + (b) * 2 + (h)) * HTB)
#define PG8_STAGE(bufoff, gbase, voff) do { _Pragma("unroll") for (int _i = 0; _i < 2; ++_i) \
        __builtin_amdgcn_global_load_lds((const unsigned*)((const char*)(gbase) + (voff)[_i]), (PG8_LAS unsigned*)(lds + (bufoff) + ldsw + _i * 8192), 16, 0, 0); } while (0)
#define PG8_LDA(dst, b, h) do { _Pragma("unroll") for (int m = 0; m < 4; ++m) _Pragma("unroll") for (int k = 0; k < 2; ++k) dst[m][k] = *(const PG8_LAS bf16x8*)(lds + PG8_SA(b, h) + aoff + m * 2048 + k * 1024); } while (0)
#define PG8_LDB(dst, b, h) do { _Pragma("unroll") for (int n = 0; n < 2; ++n) _Pragma("unroll") for (int k = 0; k < 2; ++k) dst[n][k] = *(const PG8_LAS bf16x8*)(lds + PG8_SB(b, h) + boff + n * 2048 + k * 1024); } while (0)
#define PG8_MMA(ai, bj, At, Bt) do { __builtin_amdgcn_s_setprio(1); _Pragma("unroll") for (int m = 0; m < 4; ++m) _Pragma("unroll") for (int n = 0; n < 2; ++n) _Pragma("unroll") for (int k = 0; k < 2; ++k) \
        acc[ai][bj][m][n] = __builtin_amdgcn_mfma_f32_16x16x32_bf16(Bt[n][k], At[m][k], acc[ai][bj][m][n], 0, 0, 0); __builtin_amdgcn_s_setprio(0); } while (0)
#define PG8_WAIT_V(n) asm volatile("s_waitcnt vmcnt(" #n ")" ::: "memory")
#define PG8_WAIT_L(n) asm volatile("s_waitcnt lgkmcnt(" #n ")" ::: "memory")
#define PG8_BAR __builtin_amdgcn_s_barrier()
#define PG8_SCHED __builtin_amdgcn_sched_barrier(0)
    Unit cur, nxt; int ui = 0;
    if (!S.next(0, cur)) return;
    f32x4 acc[2][2][4][2];
#pragma unroll
    for (int a = 0; a < 2; ++a)
#pragma unroll
        for (int b = 0; b < 2; ++b)
#pragma unroll
            for (int m = 0; m < 4; ++m)
#pragma unroll
                for (int n = 0; n < 2; ++n) acc[a][b][m][n] = (f32x4){0.f, 0.f, 0.f, 0.f};
    bf16x8 At[4][2], B0[2][2], B1[2][2];
    const char* cA = (const char*)g.A + (size_t)cur.pm * tstep; const char* cB = (const char*)g.Bt + (size_t)cur.pn * tstep;
    S.a_ready(cur);
    PG8_STAGE(PG8_SB(0, 0), cB, voffB); PG8_STAGE(PG8_SA(0, 0), cA, voffA); PG8_STAGE(PG8_SB(0, 1), cB + hstep, voffB); PG8_STAGE(PG8_SA(0, 1), cA + hstep, voffA);
    if (wr == 1) PG8_BAR;
    PG8_WAIT_V(4); PG8_BAR;
    PG8_STAGE(PG8_SB(1, 0), cB + kstep, voffB); PG8_STAGE(PG8_SA(1, 0), cA + kstep, voffA); PG8_STAGE(PG8_SB(1, 1), cB + hstep + kstep, voffB);
    PG8_WAIT_V(6); PG8_BAR;
    PG8_STAMP();
    for (;;) {
        const bool has_next = S.next(ui + 1, nxt);
        const char* nA = has_next ? (const char*)g.A + (size_t)nxt.pm * tstep : cA; const char* nB = has_next ? (const char*)g.Bt + (size_t)nxt.pn * tstep : cB;
        for (int t = 0; t < nt; t += 2) {
            const bool last = (t == nt - 2);
            const char* a1 = cA + (size_t)(t + 1) * kstep;
            const char* a2 = last ? nA : cA + (size_t)(t + 2) * kstep; const char* b2 = last ? nB : cB + (size_t)(t + 2) * kstep;
            const char* a3 = a2 + kstep; const char* b3 = b2 + kstep;
            if (last && has_next) S.a_ready(nxt);
            PG8_LDB(B0, 0, 0); PG8_SCHED; PG8_LDA(At, 0, 0); PG8_STAGE(PG8_SA(1, 1), a1 + hstep, voffA);
            PG8_WAIT_L(8); PG8_BAR; PG8_WAIT_L(0); PG8_MMA(0, 0, At, B0); PG8_BAR; PG8_SCHED;
            PG8_LDB(B1, 0, 1); PG8_STAGE(PG8_SB(0, 0), b2, voffB);
            PG8_BAR; PG8_WAIT_L(0); PG8_MMA(0, 1, At, B1); PG8_BAR;
            PG8_LDA(At, 0, 1); PG8_STAGE(PG8_SA(0, 0), a2, voffA);
            PG8_BAR; PG8_WAIT_L(0); PG8_MMA(1, 0, At, B0); PG8_BAR; PG8_SCHED;
            PG8_STAGE(PG8_SB(0, 1), b2 + hstep, voffB);
            PG8_WAIT_V(6); PG8_BAR; PG8_MMA(1, 1, At, B1); PG8_BAR;
            PG8_LDB(B0, 1, 0); PG8_SCHED; PG8_LDA(At, 1, 0); PG8_STAGE(PG8_SA(0, 1), a2 + hstep, voffA);
            PG8_WAIT_L(8); PG8_BAR; PG8_WAIT_L(0); PG8_MMA(0, 0, At, B0); PG8_BAR; PG8_SCHED;
            PG8_LDB(B1, 1, 1); PG8_STAGE(PG8_SB(1, 0), b3, voffB);
            PG8_BAR; PG8_WAIT_L(0); PG8_MMA(0, 1, At, B1); PG8_BAR;
            PG8_LDA(At, 1, 1); PG8_STAGE(PG8_SA(1, 0), a3, voffA);
            PG8_BAR; PG8_WAIT_L(0); PG8_MMA(1, 0, At, B0); PG8_BAR; PG8_SCHED;
            PG8_STAGE(PG8_SB(1, 1), b3 + hstep, voffB);
            PG8_WAIT_V(6); PG8_BAR; PG8_MMA(1, 1, At, B1); PG8_BAR;
        }
        PG8_STAMP();
        if constexpr (!Epi::AFTER_DRAIN) { E(acc, cur, wr, wc, fr, fq); S.done(cur); }
        PG8_STAMP();
        if (!has_next) break;
#pragma unroll
        for (int a = 0; a < 2; ++a)
#pragma unroll
            for (int b = 0; b < 2; ++b)
#pragma unroll
                for (int m = 0; m < 4; ++m)
#pragma unroll
                    for (int n = 0; n < 2; ++n) acc[a][b][m][n] = (f32x4){0.f, 0.f, 0.f, 0.f};
        cur = nxt; cA = nA; cB = nB; ++ui;
    }
    PG8_WAIT_V(0);
    if (wr == 0) PG8_BAR;
    PG8_BAR;
    if constexpr (Epi::AFTER_DRAIN) { E.fused(acc, cur, wr, wc, fr, fq, lds, wid, lane); S.done(cur); }
    PG8_STAMP();
    if (STAMP && wid == 0) { stamps[lane] = lane < nts ? (((unsigned long long)(unsigned)ts_hi << 32) | (unsigned)ts_lo) : 0ull;
        if (lane == 62) stamps[62] = rt_entry; if (lane == 63) stamps[63] = (unsigned long long)wall_clock64(); }
#undef PG8_STAMP
#undef PG8_SA
#undef PG8_SB
#undef PG8_STAGE
#undef PG8_LDA
#undef PG8_LDB
#undef PG8_MMA
#undef PG8_WAIT_V
#undef PG8_WAIT_L
#undef PG8_BAR
#undef PG8_SCHED
}
}
namespace pg8 {
struct UnitX { int pm, pn, kind; };
struct GDesc { const bf16_t* A; const bf16_t* Bt; int ks; };
__device__ __forceinline__ void map_unit(int L, int nM, int nN, int& pm, int& pn) {
    const int nwg = nM * nN; int wgid = L; { const int q = nwg / NXCD, r = nwg % NXCD, xcd = wgid % NXCD, off = wgid / NXCD; wgid = (xcd < r ? xcd * (q + 1) : r * (q + 1) + (xcd - r) * q) + off; }
    const int nig = WGM * nN, gid = wgid / nig, fm = gid * WGM, gsz = (nM - fm) < WGM ? (nM - fm) : WGM;
    pm = fm + ((wgid % nig) % gsz); pn = (wgid % nig) / gsz;
}
template <class Epi, class Sched>
__device__ __forceinline__ void gemm_stream(PG8_LAS unsigned char* lds, const Sched& S, const Epi& E) {
    const int tid = threadIdx.x, wid = __builtin_amdgcn_readfirstlane(tid >> 6), lane = tid & 63, wr = wid >> 2, wc = wid & 3, fr = lane & 15, fq = lane >> 4;
    const size_t kstep = (size_t)(BK * 2);
    const unsigned ldsw = (unsigned)wid * 1024u;
    const int aoff = lds_byte(wr * 64 + fr, fq * 8), boff = lds_byte(wc * 32 + fr, fq * 8);
#define PG8_SA(b, h) (((b) * 2 + (h)) * HTB)
#define PG8_SB(b, h) ((4 + (b) * 2 + (h)) * HTB)
#define PG8_STAGE(bufoff, gbase, voff) do { _Pragma("unroll") for (int _i = 0; _i < 2; ++_i) \
        __builtin_amdgcn_global_load_lds((const unsigned*)((const char*)(gbase) + (voff)[_i]), (PG8_LAS unsigned*)(lds + (bufoff) + ldsw + _i * 8192), 16, 0, 0); } while (0)
#define PG8_LDA(dst, b, h) do { _Pragma("unroll") for (int m = 0; m < 4; ++m) _Pragma("unroll") for (int k = 0; k < 2; ++k) dst[m][k] = *(const PG8_LAS bf16x8*)(lds + PG8_SA(b, h) + aoff + m * 2048 + k * 1024); } while (0)
#define PG8_LDB(dst, b, h) do { _Pragma("unroll") for (int n = 0; n < 2; ++n) _Pragma("unroll") for (int k = 0; k < 2; ++k) dst[n][k] = *(const PG8_LAS bf16x8*)(lds + PG8_SB(b, h) + boff + n * 2048 + k * 1024); } while (0)
#define PG8_MMA(ai, bj, At, Bt) do { __builtin_amdgcn_s_setprio(1); _Pragma("unroll") for (int m = 0; m < 4; ++m) _Pragma("unroll") for (int n = 0; n < 2; ++n) _Pragma("unroll") for (int k = 0; k < 2; ++k) \
        acc[ai][bj][m][n] = __builtin_amdgcn_mfma_f32_16x16x32_bf16(Bt[n][k], At[m][k], acc[ai][bj][m][n], 0, 0, 0); __builtin_amdgcn_s_setprio(0); } while (0)
#define PG8_WAIT_V(n) asm volatile("s_waitcnt vmcnt(" #n ")" ::: "memory")
#define PG8_WAIT_L(n) asm volatile("s_waitcnt lgkmcnt(" #n ")" ::: "memory")
#define PG8_BAR __builtin_amdgcn_s_barrier()
#define PG8_SCHED __builtin_amdgcn_sched_barrier(0)
    UnitX cur, nxt; int ui = 0;
    if (!S.next(0, cur)) return;
    f32x4 acc[2][2][4][2];
#pragma unroll
    for (int a = 0; a < 2; ++a)
#pragma unroll
        for (int b = 0; b < 2; ++b)
#pragma unroll
            for (int m = 0; m < 4; ++m)
#pragma unroll
                for (int n = 0; n < 2; ++n) acc[a][b][m][n] = (f32x4){0.f, 0.f, 0.f, 0.f};
    bf16x8 At[4][2], B0[2][2], B1[2][2];
    GDesc dc = S.desc(cur.kind);
    int ksC = dc.ks; size_t hsC = (size_t)HALF * ksC * 2;
    unsigned vAc[2], vBc[2];
#pragma unroll
    for (int i = 0; i < 2; ++i) { int R, C; stage_rc(tid * 16 + i * 8192, R, C); const int Rb = (R & ~31) + perm32(R & 31);
        vAc[i] = (unsigned)(R * ksC + C) * 2u; vBc[i] = (unsigned)(Rb * ksC + C) * 2u; }
    int shC = 31 - __builtin_clz((unsigned)ksC * 2u);
    const char* cA = (const char*)dc.A + (size_t)cur.pm * 2 * hsC; const char* cB = (const char*)dc.Bt + (size_t)cur.pn * 2 * hsC;
    PG8_STAGE(PG8_SB(0, 0), cB, vBc); PG8_STAGE(PG8_SA(0, 0), cA, vAc); PG8_STAGE(PG8_SB(0, 1), cB + hsC, vBc); PG8_STAGE(PG8_SA(0, 1), cA + hsC, vAc);
    if (wr == 1) PG8_BAR;
    PG8_WAIT_V(4); PG8_BAR;
    PG8_STAGE(PG8_SB(1, 0), cB + kstep, vBc); PG8_STAGE(PG8_SA(1, 0), cA + kstep, vAc); PG8_STAGE(PG8_SB(1, 1), cB + hsC + kstep, vBc);
    PG8_WAIT_V(6); PG8_BAR;
    for (;;) {
        const bool has_next = S.next(ui + 1, nxt);
        const char* nA = cA; const char* nB = cB; int ksN = ksC; size_t hsN = hsC;
        if (has_next) { const GDesc dn = S.desc(nxt.kind); ksN = dn.ks; hsN = (size_t)HALF * ksN * 2;
            nA = (const char*)dn.A + (size_t)nxt.pm * 2 * hsN; nB = (const char*)dn.Bt + (size_t)nxt.pn * 2 * hsN; }
        const int shN = 31 - __builtin_clz((unsigned)ksN * 2u); const unsigned cmask = (unsigned)ksC * 2u - 1u;
        const int nt = ksC / BK;
        for (int t = 0; t < nt; t += 2) {
            const bool last = (t == nt - 2);
            const char* a1 = cA + (size_t)(t + 1) * kstep;
            const char* a2 = last ? nA : cA + (size_t)(t + 2) * kstep; const char* b2 = last ? nB : cB + (size_t)(t + 2) * kstep;
            const char* a3 = a2 + kstep; const char* b3 = b2 + kstep;
            const size_t hs2 = last ? hsN : hsC;
            unsigned vA2[2], vB2[2];
#pragma unroll
            for (int i = 0; i < 2; ++i) { vA2[i] = last ? (((vAc[i] >> shC) << shN) | (vAc[i] & cmask)) : vAc[i]; vB2[i] = last ? (((vBc[i] >> shC) << shN) | (vBc[i] & cmask)) : vBc[i]; }
            PG8_LDB(B0, 0, 0); PG8_SCHED; PG8_LDA(At, 0, 0); PG8_STAGE(PG8_SA(1, 1), a1 + hsC, vAc);
            PG8_WAIT_L(8); PG8_BAR; PG8_WAIT_L(0); PG8_MMA(0, 0, At, B0); PG8_BAR; PG8_SCHED;
            PG8_LDB(B1, 0, 1); PG8_STAGE(PG8_SB(0, 0), b2, vB2);
            PG8_BAR; PG8_WAIT_L(0); PG8_MMA(0, 1, At, B1); PG8_BAR;
            PG8_LDA(At, 0, 1); PG8_STAGE(PG8_SA(0, 0), a2, vA2);
            PG8_BAR; PG8_WAIT_L(0); PG8_MMA(1, 0, At, B0); PG8_BAR; PG8_SCHED;
            PG8_STAGE(PG8_SB(0, 1), b2 + hs2, vB2);
            PG8_WAIT_V(6); PG8_BAR; PG8_MMA(1, 1, At, B1); PG8_BAR;
            PG8_LDB(B0, 1, 0); PG8_SCHED; PG8_LDA(At, 1, 0); PG8_STAGE(PG8_SA(0, 1), a2 + hs2, vA2);
            PG8_WAIT_L(8); PG8_BAR; PG8_WAIT_L(0); PG8_MMA(0, 0, At, B0); PG8_BAR; PG8_SCHED;
            PG8_LDB(B1, 1, 1); PG8_STAGE(PG8_SB(1, 0), b3, vB2);
            PG8_BAR; PG8_WAIT_L(0); PG8_MMA(0, 1, At, B1); PG8_BAR;
            PG8_LDA(At, 1, 1); PG8_STAGE(PG8_SA(1, 0), a3, vA2);
            PG8_BAR; PG8_WAIT_L(0); PG8_MMA(1, 0, At, B0); PG8_BAR; PG8_SCHED;
            PG8_STAGE(PG8_SB(1, 1), b3 + hs2, vB2);
            PG8_WAIT_V(6); PG8_BAR; PG8_MMA(1, 1, At, B1); PG8_BAR;
        }
        E(acc, cur, wr, wc, fr, fq);
        if (!has_next) break;
#pragma unroll
        for (int a = 0; a < 2; ++a)
#pragma unroll
            for (int b = 0; b < 2; ++b)
#pragma unroll
                for (int m = 0; m < 4; ++m)
#pragma unroll
                    for (int n = 0; n < 2; ++n) acc[a][b][m][n] = (f32x4){0.f, 0.f, 0.f, 0.f};
#pragma unroll
        for (int i = 0; i < 2; ++i) { vAc[i] = ((vAc[i] >> shC) << shN) | (vAc[i] & cmask); vBc[i] = ((vBc[i] >> shC) << shN) | (vBc[i] & cmask); }
        cur = nxt; cA = nA; cB = nB; ksC = ksN; hsC = hsN; shC = shN; ++ui;
    }
    PG8_WAIT_V(0);
    if (wr == 0) PG8_BAR;
    PG8_BAR;
#undef PG8_SA
#undef PG8_SB
#undef PG8_STAGE
#undef PG8_LDA
#undef PG8_LDB
#undef PG8_MMA
#undef PG8_WAIT_V
#undef PG8_WAIT_L
#undef PG8_BAR
#undef PG8_SCHED
}
}
#define XB_TMO      128
#define XB_XCNT(j)  (256  + 64 * (j))
#define XB_XSUB(j)  (1280 + 64 * (j))
#define XB_XGEN(j)  (2304 + 64 * (j))
#define XB_TOP      3328
#define XB_TOPGEN   3392
#define XCD_BAR_WORDS 3456
#define XB_SPIN_CAP (1u << 18)
#define LAS __attribute__((address_space(3)))
__device__ __forceinline__ unsigned xb_ld(unsigned* p)              { return __hip_atomic_load(p, __ATOMIC_RELAXED, __HIP_MEMORY_SCOPE_AGENT); }
__device__ __forceinline__ unsigned xb_add(unsigned* p, unsigned v) { return __hip_atomic_fetch_add(p, v, __ATOMIC_RELAXED, __HIP_MEMORY_SCOPE_AGENT); }
__device__ __forceinline__ unsigned xb_xcc_id() { return (unsigned)__builtin_amdgcn_s_getreg((3 << 11) | 20) & 0xFu; }
#define XB_SPIN(cond, bar) do { unsigned _sp = 0; while (cond) { __builtin_amdgcn_s_sleep(1); \
    if ((++_sp & 255u) == 0u) { if (xb_ld(&(bar)[XB_TMO])) break; if (_sp > XB_SPIN_CAP) { atomicAdd(&(bar)[XB_TMO], 1u); break; } } } } while (0)

struct XcdBarrier {
    unsigned* bar; unsigned x;
    volatile LAS unsigned* st;
};

__device__ __forceinline__ XcdBarrier xcd_barrier_post(unsigned* bar, volatile LAS unsigned* st) {
    XcdBarrier b; b.bar = bar; b.x = xb_xcc_id(); b.st = st;
    if (threadIdx.x == 0) (void)xb_add(&bar[XB_XCNT(b.x)], 1u);
    return b;
}
__device__ __forceinline__ void xcd_barrier_complete(unsigned* bar, unsigned x, unsigned& nloc, unsigned& nx) {
    const unsigned G = gridDim.x * gridDim.y * gridDim.z;
    unsigned sum, cnt, mine, sp = 0u;
    for (;;) {
        sum = 0u; cnt = 0u; mine = 0u;
#pragma unroll
        for (unsigned j = 0; j < 16; ++j) { const unsigned c = xb_ld(&bar[XB_XCNT(j)]); sum += c; cnt += (c > 0u) ? 1u : 0u; mine = (j == x) ? c : mine; }
        if (sum == G) break;
        __builtin_amdgcn_s_sleep(1);
        if ((++sp & 255u) == 0u) { if (xb_ld(&bar[XB_TMO])) break; if (sp > XB_SPIN_CAP) { atomicAdd(&bar[XB_TMO], 1u); break; } }
    }
    nloc = mine > 0u ? mine : 1u; nx = cnt > 0u ? cnt : 1u;
}

template <class F> __device__ __forceinline__ void xcd_barrier(const XcdBarrier& b, F&& shadow) {
    asm volatile("s_waitcnt vmcnt(0)" ::: "memory");
    __syncthreads();
    if (threadIdx.x == 0) {
        unsigned* bar = b.bar;
        __builtin_amdgcn_s_waitcnt(0);
        unsigned nloc = b.st[0], nx = b.st[1];
        if (nloc == 0u) { xcd_barrier_complete(bar, b.x, nloc, nx); b.st[0] = nloc; b.st[1] = nx; }
        const unsigned old = xb_add(&bar[XB_XSUB(b.x)], 1u);
        const unsigned gen = old / nloc;
        if (old + 1u == (gen + 1u) * nloc) {
            __builtin_amdgcn_fence(__ATOMIC_RELEASE, "agent");
            asm volatile("s_waitcnt vmcnt(0)" ::: "memory");
            const unsigned og = xb_add(&bar[XB_TOP], 1u);
            const unsigned tg = og / nx;
            if (og + 1u == (tg + 1u) * nx) xb_add(&bar[XB_TOPGEN], 1u);
            else XB_SPIN(xb_ld(&bar[XB_TOPGEN]) == tg, bar);
            __builtin_amdgcn_fence(__ATOMIC_ACQUIRE, "agent");
            xb_add(&bar[XB_XGEN(b.x)], 1u);
            asm volatile("s_waitcnt vmcnt(0)" ::: "memory");
        } else {
            XB_SPIN(xb_ld(&bar[XB_XGEN(b.x)]) == gen, bar);
            __builtin_amdgcn_fence(__ATOMIC_ACQUIRE, "agent");
            asm volatile("s_waitcnt vmcnt(0)" ::: "memory");
        }
    } else if (threadIdx.x >= 64) shadow();
    __syncthreads();
}
using pg8::f32x4; using pg8::u32x4; using pg8::bf16_t; using pg8::Unit;
#define DI __device__ __forceinline__
constexpr int M_TOK = 16384, DM = 1024, SEQ = 2048, NPHASE = 10;
constexpr float EPS = 1e-6f;
constexpr int LDS_ST = 147456, LDS_BYTES = LDS_ST + 16;
constexpr size_t MiB = 1024 * 1024;
constexpr size_t OFF_WIN1 = 0, OFF_WAOUT = 4 * MiB, OFF_WPLE0 = 6 * MiB, OFF_WPLE1 = 6 * MiB + 512 * 1024, OFF_WG0 = 7 * MiB, OFF_WG1 = 9 * MiB,
                 OFF_WKQZ = 11 * MiB, OFF_WV = 17 * MiB, OFF_WBOUT = 19 * MiB, OFF_PB = 21 * MiB, OFF_R1 = 37 * MiB, OFF_R2 = 69 * MiB, OFF_R3 = 101 * MiB,
                 OFF_R4 = 133 * MiB, OFF_RSTD0 = 197 * MiB, OFF_RSTD1 = 197 * MiB + 65536, OFF_SSP = 197 * MiB + 131072, OFF_BAR = 199 * MiB, OFF_E1 = 200 * MiB, WS_END = 232 * MiB;

struct Params {
    const float *x, *p, *a_norm, *a_w_in, *a_w_group, *a_scale, *a_w_out, *kv_norm, *w_kv, *k_norm, *b_norm, *b_w_in, *b_q_norm, *b_w_out, *ple_w, *ple_gate_w;
    float* out; unsigned char* ws; int ph_lo, ph_hi;
};

typedef __bf16 bf16x2_t __attribute__((ext_vector_type(2)));
typedef float f32x2_t __attribute__((ext_vector_type(2)));
typedef unsigned u32x2_t __attribute__((ext_vector_type(2)));
typedef short s16x8 __attribute__((ext_vector_type(8)));
typedef short s16x4 __attribute__((ext_vector_type(4)));
typedef float f32x16 __attribute__((ext_vector_type(16)));
DI unsigned pk2(float lo, float hi) { f32x2_t v = {lo, hi}; bf16x2_t r = __builtin_convertvector(v, bf16x2_t); return __builtin_bit_cast(unsigned, r); }
DI float bflo(unsigned u) { return __uint_as_float(u << 16); }
DI float bfhi(unsigned u) { return __uint_as_float(u & 0xffff0000u); }
DI u32x4 pk8(f32x4 a, f32x4 b) { u32x4 w; w.x = pk2(a[0], a[1]); w.y = pk2(a[2], a[3]); w.z = pk2(b[0], b[1]); w.w = pk2(b[2], b[3]); return w; }
DI float wave_sum(float v) {
#pragma unroll
    for (int o = 1; o < 64; o <<= 1) v += __shfl_xor(v, o);
    return v;
}
DI float sigm(float v) { return __builtin_amdgcn_rcpf(1.f + __expf(-v)); }
DI f32x4 silu4(f32x4 v) { f32x4 r; r[0] = v[0] * sigm(v[0]); r[1] = v[1] * sigm(v[1]); r[2] = v[2] * sigm(v[2]); r[3] = v[3] * sigm(v[3]); return r; }
DI f32x4 sigm4(f32x4 v) { f32x4 r; r[0] = sigm(v[0]); r[1] = sigm(v[1]); r[2] = sigm(v[2]); r[3] = sigm(v[3]); return r; }

typedef const f32x4 (&AccRef)[2][2][4][2];

struct Epi1 {
    static constexpr bool PERM = true, AFTER_DRAIN = false;
    bf16_t* ug; bf16_t* sz; const float* rstd0;
    DI void operator()(AccRef acc, const Unit& u, int wr, int wc, int fr, int fq) const {
        const int row0 = u.pm * 256 + wr * 64 + fr; const bool isz = u.pn >= 4;
        bf16_t* base = (isz ? sz : ug) + (u.pn & 3) * 256 + wc * 32 + 8 * fq;
        float rsv[2][4];
#pragma unroll
        for (int ai = 0; ai < 2; ++ai)
#pragma unroll
            for (int m = 0; m < 4; ++m) rsv[ai][m] = rstd0[row0 + ai * 128 + m * 16];
#pragma unroll
        for (int ai = 0; ai < 2; ++ai)
#pragma unroll
            for (int m = 0; m < 4; ++m) { const int row = row0 + ai * 128 + m * 16; const float rs = rsv[ai][m]; bf16_t* rowp = base + (size_t)row * DM;
#pragma unroll
                for (int bj = 0; bj < 2; ++bj) { f32x4 v0 = acc[ai][bj][m][0] * rs, v1 = acc[ai][bj][m][1] * rs;
                    if (isz) { v0 = silu4(v0); v1 = silu4(v1); }
                    *(u32x4*)(rowp + bj * 128) = pk8(v0, v1); } }
    }
};
struct EpiE {
    static constexpr bool PERM = true, AFTER_DRAIN = false;
    bf16_t* e;
    DI void operator()(AccRef acc, const Unit& u, int wr, int wc, int fr, int fq) const {
        const int row0 = u.pm * 256 + wr * 64 + fr; bf16_t* base = e + u.pn * 256 + wc * 32 + 8 * fq;
#pragma unroll
        for (int ai = 0; ai < 2; ++ai)
#pragma unroll
            for (int m = 0; m < 4; ++m) { bf16_t* rowp = base + (size_t)(row0 + ai * 128 + m * 16) * DM;
#pragma unroll
                for (int bj = 0; bj < 2; ++bj) *(u32x4*)(rowp + bj * 128) = pk8(acc[ai][bj][m][0], acc[ai][bj][m][1]); }
    }
};
DI void unpk8(const u32x4 q, f32x4& lo, f32x4& hi) { lo = (f32x4){bflo(q.x), bfhi(q.x), bflo(q.y), bfhi(q.y)}; hi = (f32x4){bflo(q.z), bfhi(q.z), bflo(q.w), bfhi(q.w)}; }
template <bool SRCF32> struct EpiResB {
    static constexpr bool PERM = true, AFTER_DRAIN = false;
    const float* srcf; const bf16_t* srcb; bf16_t* xb;
    DI void operator()(AccRef acc, const Unit& u, int wr, int wc, int fr, int fq) const {
        const int row0 = u.pm * 256 + wr * 64 + fr, col0 = u.pn * 256 + wc * 32 + 8 * fq;
#pragma unroll
        for (int ai = 0; ai < 2; ++ai) {
            f32x4 a[4][2][2];
#pragma unroll
            for (int m = 0; m < 4; ++m) { const size_t o = (size_t)(row0 + ai * 128 + m * 16) * DM + col0;
#pragma unroll
                for (int bj = 0; bj < 2; ++bj) {
                    if (SRCF32) { a[m][bj][0] = __builtin_nontemporal_load((const f32x4*)(srcf + o + bj * 128)); a[m][bj][1] = __builtin_nontemporal_load((const f32x4*)(srcf + o + bj * 128 + 4)); }
                    else { const u32x4 q = *(const u32x4*)(srcb + o + bj * 128); unpk8(q, a[m][bj][0], a[m][bj][1]); } } }
#pragma unroll
            for (int m = 0; m < 4; ++m) { const size_t o = (size_t)(row0 + ai * 128 + m * 16) * DM + col0;
#pragma unroll
                for (int bj = 0; bj < 2; ++bj) *(u32x4*)(xb + o + bj * 128) = pk8(a[m][bj][0] + acc[ai][bj][m][0], a[m][bj][1] + acc[ai][bj][m][1]); }
        }
    }
};
template <bool NEXT> struct EpiGate {
    static constexpr bool PERM = true, AFTER_DRAIN = false;
    const bf16_t* xin; const bf16_t* e; bf16_t* xb; float* ssp; float* outf;
    DI void operator()(AccRef acc, const Unit& u, int wr, int wc, int fr, int fq) const {
        const int row0 = u.pm * 256 + wr * 64 + fr, col0 = u.pn * 256 + wc * 32 + 8 * fq;
#pragma unroll
        for (int ai = 0; ai < 2; ++ai) {
            u32x4 xv[4][2], ev[4][2];
#pragma unroll
            for (int m = 0; m < 4; ++m) { const size_t o = (size_t)(row0 + ai * 128 + m * 16) * DM + col0;
#pragma unroll
                for (int bj = 0; bj < 2; ++bj) { xv[m][bj] = *(const u32x4*)(xin + o + bj * 128); ev[m][bj] = *(const u32x4*)(e + o + bj * 128); } }
#pragma unroll
            for (int m = 0; m < 4; ++m) { const int row = row0 + ai * 128 + m * 16; const size_t o = (size_t)row * DM + col0; float ss = 0.f;
#pragma unroll
                for (int bj = 0; bj < 2; ++bj) { f32x4 a0, a1, e0, e1; unpk8(xv[m][bj], a0, a1); unpk8(ev[m][bj], e0, e1);
                    const f32x4 v0 = a0 + e0 * sigm4(acc[ai][bj][m][0]), v1 = a1 + e1 * sigm4(acc[ai][bj][m][1]);
                    if (NEXT) { *(u32x4*)(xb + o + bj * 128) = pk8(v0, v1);
                        ss += (v0[0] * v0[0] + v0[1] * v0[1]) + (v0[2] * v0[2] + v0[3] * v0[3]) + (v1[0] * v1[0] + v1[1] * v1[1]) + (v1[2] * v1[2] + v1[3] * v1[3]); }
                    else { __builtin_nontemporal_store(v0, (f32x4*)(outf + o + bj * 128)); __builtin_nontemporal_store(v1, (f32x4*)(outf + o + bj * 128 + 4)); } }
                if (NEXT) { ss += __shfl_xor(ss, 16); ss += __shfl_xor(ss, 32); if (fq == 0) atomicAdd(ssp + row, ss); } }
        }
    }
};
struct EpiKQZ {
    static constexpr bool PERM = true, AFTER_DRAIN = false;
    bf16_t *kk, *qq, *sz2; const float *rstd1, *k_norm, *q_norm;
    DI void operator()(AccRef acc, const Unit& u, int wr, int wc, int fr, int fq) const {
        const int row0 = u.pm * 256 + wr * 64 + fr, kind = u.pn >> 2, pq = u.pn & 3;
        float rsv[2][4];
#pragma unroll
        for (int ai = 0; ai < 2; ++ai)
#pragma unroll
            for (int m = 0; m < 4; ++m) rsv[ai][m] = rstd1[row0 + ai * 128 + m * 16];
        if (kind == 2) {
            bf16_t* base = sz2 + pq * 256 + 64 * wc + 8 * fq;
#pragma unroll
            for (int ai = 0; ai < 2; ++ai)
#pragma unroll
                for (int m = 0; m < 4; ++m) { const int row = row0 + ai * 128 + m * 16; const float rs = rsqrtf(rsv[ai][m] * (1.f / DM) + EPS); bf16_t* rowp = base + (size_t)row * DM;
#pragma unroll
                    for (int bj = 0; bj < 2; ++bj) *(u32x4*)(rowp + bj * 32) = pk8(silu4(acc[ai][bj][m][0] * rs), silu4(acc[ai][bj][m][1] * rs)); }
        } else {
            const float* gn = kind ? q_norm : k_norm; const float mul = kind ? 0.125f * 1.4426950408889634f : 1.f;
            bf16_t* dst = kind ? qq : kk; const int head = pq * 4 + wc;
            f32x4 g[2][2];
#pragma unroll
            for (int bj = 0; bj < 2; ++bj)
#pragma unroll
                for (int n = 0; n < 2; ++n) g[bj][n] = *(const f32x4*)(gn + 32 * bj + 8 * fq + 4 * n) * mul;
#pragma unroll
            for (int ai = 0; ai < 2; ++ai)
#pragma unroll
                for (int m = 0; m < 4; ++m) { const int row = row0 + ai * 128 + m * 16; const float rs = rsqrtf(rsv[ai][m] * (1.f / DM) + EPS); const int b = row >> 11, s = row & 2047;
                    f32x4 v[2][2]; float ss = 0.f;
#pragma unroll
                    for (int bj = 0; bj < 2; ++bj)
#pragma unroll
                        for (int n = 0; n < 2; ++n) { v[bj][n] = acc[ai][bj][m][n] * rs; ss += (v[bj][n][0] * v[bj][n][0] + v[bj][n][1] * v[bj][n][1]) + (v[bj][n][2] * v[bj][n][2] + v[bj][n][3] * v[bj][n][3]); }
                    ss += __shfl_xor(ss, 16); ss += __shfl_xor(ss, 32);
                    const float hr = rsqrtf(ss * (1.f / 64.f) + EPS);
                    bf16_t* rowp = dst + ((size_t)(b * 16 + head) * SEQ + s) * 64 + 8 * fq;
#pragma unroll
                    for (int bj = 0; bj < 2; ++bj) *(u32x4*)(rowp + 32 * bj) = pk8(v[bj][0] * hr * g[bj][0], v[bj][1] * hr * g[bj][1]); }
        }
    }
};
struct EpiVT {
    static constexpr bool PERM = true, AFTER_DRAIN = false;
    bf16_t* vt; const float* rstd1;
    DI void operator()(AccRef acc, const Unit& u, int wr, int wc, int fr, int fq) const {
        const int c0 = u.pm * 256 + wr * 64 + fr, tok0 = u.pn * 256 + wc * 32 + 8 * fq;
        f32x4 rs[2][2];
#pragma unroll
        for (int bj = 0; bj < 2; ++bj)
#pragma unroll
            for (int n = 0; n < 2; ++n) { const f32x4 q = *(const f32x4*)(rstd1 + tok0 + 128 * bj + 4 * n);
#pragma unroll
                for (int j = 0; j < 4; ++j) rs[bj][n][j] = rsqrtf(q[j] * (1.f / DM) + EPS); }
#pragma unroll
        for (int ai = 0; ai < 2; ++ai)
#pragma unroll
            for (int m = 0; m < 4; ++m) { const int c = c0 + ai * 128 + m * 16;
#pragma unroll
                for (int bj = 0; bj < 2; ++bj) { const int tok = tok0 + 128 * bj, b = tok >> 11, s = tok & 2047;
                    *(u32x4*)(vt + ((size_t)b * DM + c) * SEQ + s) = pk8(acc[ai][bj][m][0] * rs[bj][0], acc[ai][bj][m][1] * rs[bj][1]); } }
    }
};
template <class Epi> DI void run_gemm(PG8_LAS unsigned char* lds, const bf16_t* A, const bf16_t* Bt, int M, int N, int K, const Epi& E) {
    pg8::Gemm g{A, Bt, M, N, K}; pg8::StaticOrder S; S.init(M, N, (int)gridDim.x, (int)blockIdx.x);
    pg8::gemm_phase<Epi, pg8::StaticOrder, false>(lds, g, S, E, nullptr);
}

struct SchedPG {
    const unsigned char* ws; int layer, G, c;
    DI bool next(int i, pg8::UnitX& u) const { const int L = i * G + c; if (L >= 512) return false;
        pg8::map_unit(L & 255, 64, 4, u.pm, u.pn); u.kind = L >> 8; return true; }
    DI pg8::GDesc desc(int k) const { pg8::GDesc d;
        const size_t oa = k == 0 ? OFF_PB + (size_t)layer * M_TOK * 256 * 2 : OFF_R2, ob = k == 0 ? (layer ? OFF_WPLE1 : OFF_WPLE0) : (layer ? OFF_WG1 : OFF_WG0);
        d.A = (const bf16_t*)(ws + oa); d.Bt = (const bf16_t*)(ws + ob); d.ks = k == 0 ? 256 : 1024; return d; }
    DI void a_ready(const pg8::UnitX&) const {}
    DI void done(const pg8::UnitX&) const {}
};
template <bool NEXT> struct EpiPG {
    static constexpr bool PERM = true;
    EpiE e; EpiGate<NEXT> g;
    DI void operator()(AccRef acc, const pg8::UnitX& u, int wr, int wc, int fr, int fq) const { const Unit uu{u.pm, u.pn};
        if (u.kind == 0) e(acc, uu, wr, wc, fr, fq); else g(acc, uu, wr, wc, fr, fq); }
};
struct SchedP6 {
    const unsigned char* ws; int G, c;
    DI bool next(int i, pg8::UnitX& u) const { const int L = i * G + c; if (L >= 1024) return false;
        if (L < 768) { pg8::map_unit(L, 64, 12, u.pm, u.pn); u.kind = 0; } else { pg8::map_unit(L - 768, 4, 64, u.pm, u.pn); u.kind = 1; }
        return true; }
    DI pg8::GDesc desc(int k) const { pg8::GDesc d; d.A = (const bf16_t*)(ws + (k == 0 ? OFF_R3 : OFF_WV)); d.Bt = (const bf16_t*)(ws + (k == 0 ? OFF_WKQZ : OFF_R3)); d.ks = 1024; return d; }
};
struct EpiP6 {
    static constexpr bool PERM = true;
    EpiKQZ a; EpiVT b;
    DI void operator()(AccRef acc, const pg8::UnitX& u, int wr, int wc, int fr, int fq) const { const Unit uu{u.pm, u.pn};
        if (u.kind == 0) a(acc, uu, wr, wc, fr, fq); else b(acc, uu, wr, wc, fr, fq); }
};

DI int headperm(int cl) { const int o = cl & 255, wc = o >> 6, bj = (o >> 5) & 1, r = o & 31; return (cl & ~255) + 128 * bj + 32 * wc + r; }
DI void transpose_item(float* scr, const float* src, int ld, int K, int nT, const float* gain, bf16_t* dst, int rowoff, bool perm, int item, int lane) {
    const int kt = item / nT, nt = item - kt * nT, k0 = kt * 64, n0 = nt * 32, lr = lane >> 3, lc = lane & 7;
    float4 v[8];
#pragma unroll
    for (int i = 0; i < 8; ++i) v[i] = *(const float4*)(src + (size_t)(k0 + i * 8 + lr) * ld + n0 + lc * 4);
    float gk[8];
#pragma unroll
    for (int i = 0; i < 8; ++i) gk[i] = gain ? gain[k0 + 8 * lc + i] : 1.f;
#pragma unroll
    for (int i = 0; i < 8; ++i) { float* t = scr + (i * 8 + lr) * 33 + lc * 4; t[0] = v[i].x; t[1] = v[i].y; t[2] = v[i].z; t[3] = v[i].w; }
    asm volatile("s_waitcnt lgkmcnt(0)" ::: "memory");
#pragma unroll
    for (int j = 0; j < 4; ++j) { const int n = lr + 8 * j; const float* t = scr + (8 * lc) * 33 + n;
        int row = rowoff + n0 + n; if (perm) row = headperm(row);
        u32x4 w; w.x = pk2(t[0] * gk[0], t[33] * gk[1]); w.y = pk2(t[66] * gk[2], t[99] * gk[3]); w.z = pk2(t[132] * gk[4], t[165] * gk[5]); w.w = pk2(t[198] * gk[6], t[231] * gk[7]);
        *(u32x4*)(dst + (size_t)row * K + k0 + 8 * lc) = w; }
    asm volatile("s_waitcnt lgkmcnt(0)" ::: "memory");
}
DI void weff_job(float* L, const Params& P, bf16_t* dst, int job) {
    float* As = L; float* Bs = L + 64 * 129;
    const int tid = threadIdx.x, k0 = (job >> 4) * 64, n0 = (job & 15) * 64, g = n0 >> 8, d0 = n0 & 255, kk = tid >> 3, dg = tid & 7;
    float acc[8];
#pragma unroll
    for (int j = 0; j < 8; ++j) acc[j] = 0.f;
    for (int c0 = 0; c0 < 256; c0 += 128) {
        __syncthreads();
#pragma unroll
        for (int i = 0; i < 4; ++i) { const int idx = tid + 512 * i;
            { const int r = idx >> 5, c4 = idx & 31; const float4 v = *(const float4*)(P.a_w_in + (size_t)(k0 + r) * 2048 + g * 256 + c0 + c4 * 4);
              float* t = As + r * 129 + c4 * 4; t[0] = v.x; t[1] = v.y; t[2] = v.z; t[3] = v.w; }
            { const int cc = idx >> 4, d4 = idx & 15; *(float4*)(Bs + cc * 64 + d4 * 4) = *(const float4*)(P.a_w_group + (size_t)(g * 256 + c0 + cc) * 256 + d0 + d4 * 4); } }
        __syncthreads();
#pragma unroll 4
        for (int c = 0; c < 128; ++c) { const float a = As[kk * 129 + c]; const float4 b0 = *(const float4*)(Bs + c * 64 + dg * 8), b1 = *(const float4*)(Bs + c * 64 + dg * 8 + 4);
            acc[0] += a * b0.x; acc[1] += a * b0.y; acc[2] += a * b0.z; acc[3] += a * b0.w; acc[4] += a * b1.x; acc[5] += a * b1.y; acc[6] += a * b1.z; acc[7] += a * b1.w; }
    }
    const float an = P.a_norm[k0 + kk];
#pragma unroll
    for (int j = 0; j < 8; ++j) { const int n = n0 + dg * 8 + j; const float v = acc[j] * an * P.a_scale[n];
        dst[(size_t)n * DM + k0 + kk] = (bf16_t)(pk2(v, v) & 0xffffu); }
}
DI void shadow_p_convert(const Params& P, int half) {
    const float4* pp = (const float4*)P.p; u32x4* pb = (u32x4*)(P.ws + OFF_PB);
    const int HALFCH = M_TOK * 256 / 8, step = gridDim.x * 448, base = half * HALFCH;
    for (int i = blockIdx.x * 448 + ((int)threadIdx.x - 64); i < HALFCH; i += 5 * step) { float4 a[5], b[5];
#pragma unroll
        for (int q = 0; q < 5; ++q) if (i + q * step < HALFCH) { a[q] = pp[2 * (base + i + q * step)]; b[q] = pp[2 * (base + i + q * step) + 1]; }
#pragma unroll
        for (int q = 0; q < 5; ++q) if (i + q * step < HALFCH) { u32x4 u; u.x = pk2(a[q].x, a[q].y); u.y = pk2(a[q].z, a[q].w); u.z = pk2(b[q].x, b[q].y); u.w = pk2(b[q].z, b[q].w); pb[base + i + q * step] = u; } }
}
DI void deferred_items(const Params& P, float* L, int seam) {
    const int wid = threadIdx.x >> 6, lane = threadIdx.x & 63; unsigned char* ws = P.ws; float* scr = L + wid * (64 * 33);
    const int nitems = (seam == 0) ? 768 : (seam == 1 ? 512 : 1024);
    for (int t = blockIdx.x * 7 + (wid - 1); t < nitems; t += gridDim.x * 7) {
        const int r = t & 511, hi = t >> 9;
        if (seam == 0) { if (hi == 0) transpose_item(scr, P.a_w_out, 1024, 1024, 32, nullptr, (bf16_t*)(ws + OFF_WAOUT), 0, false, r, lane);
                         else if (r < 128) transpose_item(scr, P.ple_w, 1024, 256, 32, nullptr, (bf16_t*)(ws + OFF_WPLE0), 0, false, r, lane);
                         else transpose_item(scr, P.ple_w + 256 * 1024, 1024, 256, 32, nullptr, (bf16_t*)(ws + OFF_WPLE1), 0, false, r - 128, lane); }
        else if (seam == 1) transpose_item(scr, P.ple_gate_w, 1024, 1024, 32, nullptr, (bf16_t*)(ws + OFF_WG0), 0, false, r, lane);
        else if (seam == 2) { if (hi == 0) transpose_item(scr, P.w_kv, 2048, 1024, 32, P.kv_norm, (bf16_t*)(ws + OFF_WKQZ), 0, true, r, lane);
                              else transpose_item(scr, P.w_kv + 1024, 2048, 1024, 32, P.kv_norm, (bf16_t*)(ws + OFF_WV), 0, false, r, lane); }
        else if (seam == 3) transpose_item(scr, P.b_w_in, 2048, 1024, 64, P.b_norm, (bf16_t*)(ws + OFF_WKQZ), 1024, true, t, lane);
        else { if (hi == 0) transpose_item(scr, P.b_w_out, 1024, 1024, 32, nullptr, (bf16_t*)(ws + OFF_WBOUT), 0, false, r, lane);
               else transpose_item(scr, P.ple_gate_w + 1024 * 1024, 1024, 1024, 32, nullptr, (bf16_t*)(ws + OFF_WG1), 0, false, r, lane); }
    }
    if (seam < 2) shadow_p_convert(P, seam);
}
DI void phase0(const Params& P, float* L) {
    const int tid = threadIdx.x, wid = tid >> 6, lane = tid & 63, w = blockIdx.x, G = gridDim.x;
    unsigned char* ws = P.ws;
    { float* ss1 = (float*)(ws + OFF_RSTD1); for (int i = w * 512 + tid; i < M_TOK; i += G * 512) ss1[i] = 0.f; }
    if ((w & 1) == 0) { for (int job = w; job < 256; job += G) weff_job(L, P, (bf16_t*)(ws + OFF_WIN1), job); __syncthreads(); }
    { float* scr = L + wid * (64 * 33);
      for (int t = w * 8 + wid; t < 512; t += G * 8) transpose_item(scr, P.a_w_in + 1024, 2048, 1024, 32, P.a_norm, (bf16_t*)(ws + OFF_WIN1) + (size_t)1024 * 1024, 0, false, t, lane); }
    { bf16_t* xb = (bf16_t*)(ws + OFF_R1); float* rstd0 = (float*)(ws + OFF_RSTD0);
      for (int row = (w * 8 + wid) * 8; row < M_TOK; row += G * 64) {
          float4 v[8][4];
#pragma unroll
          for (int q = 0; q < 8; ++q)
#pragma unroll
              for (int j = 0; j < 4; ++j) v[q][j] = ((const float4*)(P.x + (size_t)(row + q) * DM) + lane)[64 * j];
#pragma unroll
          for (int q = 0; q < 8; ++q) { float s = 0.f;
#pragma unroll
              for (int j = 0; j < 4; ++j) s += (v[q][j].x * v[q][j].x + v[q][j].y * v[q][j].y) + (v[q][j].z * v[q][j].z + v[q][j].w * v[q][j].w);
              s = wave_sum(s);
              uint2* o = (uint2*)(xb + (size_t)(row + q) * DM) + lane;
#pragma unroll
              for (int j = 0; j < 4; ++j) { uint2 u; u.x = pk2(v[q][j].x, v[q][j].y); u.y = pk2(v[q][j].z, v[q][j].w); o[64 * j] = u; }
              if (lane == 0) rstd0[row + q] = rsqrtf(s * (1.f / DM) + EPS); } } }
    if ((w & 1) != 0) { __syncthreads(); for (int job = w; job < 256; job += G) weff_job(L, P, (bf16_t*)(ws + OFF_WIN1), job); }
}
DI void unpack8(const u32x4 q, float (&f)[8]) { f[0] = bflo(q.x); f[1] = bfhi(q.x); f[2] = bflo(q.y); f[3] = bfhi(q.y); f[4] = bflo(q.z); f[5] = bfhi(q.z); f[6] = bflo(q.w); f[7] = bfhi(q.w); }
DI void pool_phase(const Params& P) {
    const bf16_t* ug = (const bf16_t*)(P.ws + OFF_R2); const bf16_t* sz = (const bf16_t*)(P.ws + OFF_R3); bf16_t* Gd = (bf16_t*)(P.ws + OFF_R1);
    const int nth = gridDim.x * 512;
    for (int idx = blockIdx.x * 512 + threadIdx.x; idx < 131072; idx += nth) {
        const int chunk = idx & 127, run = idx >> 7, row0 = run * 16, t0 = row0 & (SEQ - 1), c0 = chunk * 8, wlen = 2 << (chunk >> 5);
        const u32x4* up = (const u32x4*)(ug + (size_t)row0 * DM + c0); const u32x4* zp = (const u32x4*)(sz + (size_t)row0 * DM + c0); u32x4* gp = (u32x4*)(Gd + (size_t)row0 * DM + c0);
        float s[8], c[8], z[8];
#pragma unroll
        for (int j = 0; j < 8; ++j) s[j] = 0.f;
        { const bool hist = t0 > 0;
#pragma unroll
          for (int j = 1; j <= 16; ++j) {
              const int jj = hist ? (j <= wlen ? j : wlen) : 0; const float mk = (hist && j <= wlen) ? 1.f : 0.f;
              unpack8(up[-(jj * 128)], c);
#pragma unroll
              for (int q = 0; q < 8; ++q) s[q] += mk * c[q]; } }
        const float inv_full = 1.f / (float)wlen;
#pragma unroll 4
        for (int rr = 0; rr < 16; ++rr) {
            const int t = t0 + rr;
            if (t >= wlen) { unpack8(up[(rr - wlen) * 128], c);
#pragma unroll
                for (int q = 0; q < 8; ++q) s[q] -= c[q]; }
            unpack8(up[rr * 128], c); unpack8(zp[rr * 128], z);
            const float inv = (t + 1 < wlen) ? 1.f / (float)(t + 1) : inv_full;
            float o[8];
#pragma unroll
            for (int q = 0; q < 8; ++q) { s[q] += c[q]; o[q] = (s[q] * inv - c[q]) * z[q]; }
            u32x4 w; w.x = pk2(o[0], o[1]); w.y = pk2(o[2], o[3]); w.z = pk2(o[4], o[5]); w.w = pk2(o[6], o[7]); gp[rr * 128] = w;
        }
    }
}
#define MFMA32(a, b, c) __builtin_amdgcn_mfma_f32_32x32x16_bf16((a), (b), (c), 0, 0, 0)
DI void attn_phase(const Params& P, PG8_LAS unsigned char* lds) {
    constexpr int HIST = 128, WIN = 384, KP = 144, VP = 776, NF = 6, VCH = 48;
    PG8_LAS unsigned char* Kl = lds; PG8_LAS unsigned char* Vl = lds + WIN * KP;
    const bf16_t* kk = (const bf16_t*)(P.ws + OFF_R1); const bf16_t* qq = (const bf16_t*)(P.ws + OFF_R2); const bf16_t* vt = (const bf16_t*)(P.ws + OFF_R4);
    const bf16_t* sz2 = (const bf16_t*)(P.ws + OFF_R4 + 32 * MiB); bf16_t* g2 = (bf16_t*)P.out;
    const int tid = threadIdx.x, wid = tid >> 6, lane = tid & 63, r = lane & 31, hh = lane >> 5;
#define ATT_LOAD_FILL(IT, KV, VV) do { const int _bh = (IT) >> 3, _wlo = ((IT) & 7) * 256 - HIST; const bf16_t* _Kg = kk + (size_t)_bh * SEQ * 64; const bf16_t* _Vg = vt + (size_t)_bh * 64 * SEQ; \
        _Pragma("unroll") for (int i = 0; i < NF; ++i) { const int c = tid + 512 * i, row = c >> 3, part = c & 7, key = _wlo + row; if (key >= 0) KV[i] = *(const u32x4*)(_Kg + (size_t)key * 64 + part * 8); } \
        _Pragma("unroll") for (int i = 0; i < NF; ++i) { const int c = tid + 512 * i, d = c / VCH, part = c - d * VCH, key0 = _wlo + part * 8; if (key0 >= 0) VV[i] = *(const u32x4*)(_Vg + (size_t)d * SEQ + key0); } } while (0)
#define ATT_LOAD_Q(IT, QF) do { const bf16_t* _Qp = qq + ((size_t)((IT) >> 3) * SEQ + ((IT) & 7) * 256 + 32 * wid + r) * 64 + hh * 8; \
        _Pragma("unroll") for (int ks = 0; ks < 4; ++ks) QF[ks] = *(const s16x8*)(_Qp + ks * 16); } while (0)
    u32x4 kv[NF], vv[NF];
    if ((int)blockIdx.x < 1024) { ATT_LOAD_FILL((int)blockIdx.x, kv, vv); }
    for (int item = blockIdx.x; item < 1024; item += gridDim.x) {
        const int qc = item & 7, bh = item >> 3, t0 = qc * 256, wlo = t0 - HIST, tq = t0 + 32 * wid;
        const bf16_t* Kg = kk + (size_t)bh * SEQ * 64; const bf16_t* Vg = vt + (size_t)bh * 64 * SEQ;
        const int b = bh >> 4, h = bh & 15; const size_t rowo = ((size_t)b * SEQ + tq + r) * DM + h * 64 + 4 * hh;
        asm volatile("s_waitcnt lgkmcnt(0)" ::: "memory"); __builtin_amdgcn_s_barrier(); asm volatile("" ::: "memory");
#pragma unroll
        for (int i = 0; i < NF; ++i) { const int c = tid + 512 * i, row = c >> 3, part = c & 7, key = wlo + row;
            if (key >= 0) *(PG8_LAS u32x4*)(Kl + row * KP + part * 16) = kv[i]; }
#pragma unroll
        for (int i = 0; i < NF; ++i) { const int c = tid + 512 * i, d = c / VCH, part = c - d * VCH, key0 = wlo + part * 8;
            if (key0 >= 0) { PG8_LAS u32x2_t* w = (PG8_LAS u32x2_t*)(Vl + d * VP + part * 16); u32x2_t a = {vv[i].x, vv[i].y}, bb = {vv[i].z, vv[i].w}; w[0] = a; w[1] = bb; } }
        s16x8 qf[4]; ATT_LOAD_Q(item, qf);
        asm volatile("s_waitcnt lgkmcnt(0)" ::: "memory"); __builtin_amdgcn_s_barrier(); asm volatile("" ::: "memory");
        const size_t rowc = ((size_t)b * SEQ + tq + (lane >> 3)) * DM + h * 64 + (lane & 7) * 8;
        u32x4 zc[4];
#pragma unroll
        for (int i = 0; i < 4; ++i) zc[i] = *(const u32x4*)(sz2 + rowc + (size_t)(8 * i) * DM);
        const int nitem = item + gridDim.x;
        u32x4 kvn[NF], vvn[NF];
        if (nitem < 1024) { ATT_LOAD_FILL(nitem, kvn, vvn); }
        f32x16 o0, o1;
#pragma unroll
        for (int i = 0; i < 16; ++i) { o0[i] = 0.f; o1[i] = 0.f; }
        float carry = 1.f;
        for (int s0 = tq; s0 >= 0; s0 -= 32) {
            s16x8 kf[4]; s16x4 vf[2][2][2];
            if (s0 >= wlo) {
                PG8_LAS const unsigned char* kp = Kl + (s0 - wlo + r) * KP + hh * 16; PG8_LAS const unsigned char* vp = Vl + r * VP + (s0 - wlo + 4 * hh) * 2;
#pragma unroll
                for (int ks = 0; ks < 4; ++ks) kf[ks] = *(PG8_LAS const s16x8*)(kp + ks * 32);
#pragma unroll
                for (int dt = 0; dt < 2; ++dt)
#pragma unroll
                    for (int s = 0; s < 2; ++s)
#pragma unroll
                        for (int pt = 0; pt < 2; ++pt) vf[dt][s][pt] = *(PG8_LAS const s16x4*)(vp + dt * 32 * VP + (16 * s + 8 * pt) * 2);
            } else {
                const bf16_t* kp = Kg + (size_t)(s0 + r) * 64 + hh * 8; const bf16_t* vp = Vg + (size_t)r * SEQ + s0 + 4 * hh;
#pragma unroll
                for (int ks = 0; ks < 4; ++ks) kf[ks] = *(const s16x8*)(kp + ks * 16);
#pragma unroll
                for (int dt = 0; dt < 2; ++dt)
#pragma unroll
                    for (int s = 0; s < 2; ++s)
#pragma unroll
                        for (int pt = 0; pt < 2; ++pt) vf[dt][s][pt] = *(const s16x4*)(vp + (size_t)dt * 32 * SEQ + 16 * s + 8 * pt);
            }
            f32x16 x;
#pragma unroll
            for (int i = 0; i < 16; ++i) x[i] = 0.f;
#pragma unroll
            for (int ks = 0; ks < 4; ++ks) x = MFMA32(kf[ks], qf[ks], x);
            float beta[16], keep[16];
            const bool diag = (s0 == tq);
#pragma unroll
            for (int i = 0; i < 16; ++i) {
                const float l = fmaxf(x[i], -120.f);
                const float e = __builtin_amdgcn_exp2f(-l);
                float bt = __builtin_amdgcn_rcpf(1.f + e), kp = e * bt;
                beta[i] = bt; keep[i] = kp;
            }
            if (diag) {
#pragma unroll
                for (int i = 0; i < 16; ++i) { const bool valid = ((i & 3) + 8 * (i >> 2) + 4 * hh) < r; beta[i] = valid ? beta[i] : 0.f; keep[i] = valid ? keep[i] : 1.f; }
            }
            float Gp[4], PG[4];
#pragma unroll
            for (int g = 0; g < 4; ++g) { Gp[g] = (keep[4 * g] * keep[4 * g + 1]) * (keep[4 * g + 2] * keep[4 * g + 3]); PG[g] = __shfl_xor(Gp[g], 32); }
            float base[4];
            { float so = 1.f, sp = 1.f;
#pragma unroll
              for (int g = 3; g >= 0; --g) { base[g] = carry * so * sp * (hh == 0 ? PG[g] : 1.f); so *= Gp[g]; sp *= PG[g]; }
              carry = carry * so * sp; }
            float a[16];
#pragma unroll
            for (int g = 0; g < 4; ++g) { float run = base[g];
                a[4 * g + 3] = beta[4 * g + 3] * run; run *= keep[4 * g + 3];
                a[4 * g + 2] = beta[4 * g + 2] * run; run *= keep[4 * g + 2];
                a[4 * g + 1] = beta[4 * g + 1] * run; run *= keep[4 * g + 1];
                a[4 * g] = beta[4 * g] * run; }
#pragma unroll
            for (int s = 0; s < 2; ++s) {
                u32x4 pw; pw.x = pk2(a[8 * s], a[8 * s + 1]); pw.y = pk2(a[8 * s + 2], a[8 * s + 3]); pw.z = pk2(a[8 * s + 4], a[8 * s + 5]); pw.w = pk2(a[8 * s + 6], a[8 * s + 7]);
                const s16x8 pf = __builtin_bit_cast(s16x8, pw);
                const s16x8 va = __builtin_shufflevector(vf[0][s][0], vf[0][s][1], 0, 1, 2, 3, 4, 5, 6, 7);
                const s16x8 vb = __builtin_shufflevector(vf[1][s][0], vf[1][s][1], 0, 1, 2, 3, 4, 5, 6, 7);
                o0 = MFMA32(va, pf, o0); o1 = MFMA32(vb, pf, o1);
            }
            if (__all(carry < 1e-12f)) break;
        }
        { PG8_LAS unsigned char* S = lds + WIN * KP + 64 * VP + wid * 4608;
#pragma unroll
          for (int i = 0; i < 4; ++i) *(PG8_LAS u32x4*)(S + ((lane >> 3) + 8 * i) * 144 + (lane & 7) * 16) = zc[i];
          asm volatile("s_waitcnt lgkmcnt(0)" ::: "memory");
          PG8_LAS unsigned char* Sr = S + r * 144 + 8 * hh;
#pragma unroll
          for (int g = 0; g < 4; ++g) {
              const u32x2_t z0 = *(PG8_LAS const u32x2_t*)(Sr + 16 * g), z1 = *(PG8_LAS const u32x2_t*)(Sr + 64 + 16 * g);
              u32x2_t w0, w1;
              w0.x = pk2(o0[4 * g] * bflo(z0.x), o0[4 * g + 1] * bfhi(z0.x)); w0.y = pk2(o0[4 * g + 2] * bflo(z0.y), o0[4 * g + 3] * bfhi(z0.y));
              w1.x = pk2(o1[4 * g] * bflo(z1.x), o1[4 * g + 1] * bfhi(z1.x)); w1.y = pk2(o1[4 * g + 2] * bflo(z1.y), o1[4 * g + 3] * bfhi(z1.y));
              *(PG8_LAS u32x2_t*)(Sr + 16 * g) = w0; *(PG8_LAS u32x2_t*)(Sr + 64 + 16 * g) = w1; }
          asm volatile("s_waitcnt lgkmcnt(0)" ::: "memory");
#pragma unroll
          for (int i = 0; i < 4; ++i) { const u32x4 v = *(PG8_LAS const u32x4*)(S + ((lane >> 3) + 8 * i) * 144 + (lane & 7) * 16); *(u32x4*)(g2 + rowc + (size_t)(8 * i) * DM) = v; }
          asm volatile("s_waitcnt lgkmcnt(0)" ::: "memory"); }
#pragma unroll
        for (int i = 0; i < NF; ++i) { kv[i] = kvn[i]; vv[i] = vvn[i]; }
    }
#undef ATT_LOAD_FILL
#undef ATT_LOAD_Q
}

__global__ __launch_bounds__(512, 2) void yoco_fwd(Params P) {
    extern __shared__ __attribute__((aligned(16))) unsigned char shm[];
    PG8_LAS unsigned char* lds = (PG8_LAS unsigned char*)shm;
    unsigned char* ws = P.ws;
    bf16_t* R1 = (bf16_t*)(ws + OFF_R1); bf16_t* R2 = (bf16_t*)(ws + OFF_R2); bf16_t* R3 = (bf16_t*)(ws + OFF_R3); bf16_t* R4 = (bf16_t*)(ws + OFF_R4);
    float* rstd0 = (float*)(ws + OFF_RSTD0); float* rstd1 = (float*)(ws + OFF_RSTD1); float* ssp = (float*)(ws + OFF_SSP);
    const bf16_t* pb = (const bf16_t*)(ws + OFF_PB); bf16_t* E1b = (bf16_t*)(ws + OFF_E1);
#define PH(k) if (P.ph_lo <= (k) && (k) < P.ph_hi)
#define SYNC(k) if (fused) { if ((k) < 5) xcd_barrier(xb, [&]() { deferred_items(P, (float*)shm, (k)); }); else xcd_barrier(xb, []() {}); }
    const bool fused = (P.ph_hi - P.ph_lo) > 1;
    volatile LAS unsigned* st = (volatile LAS unsigned*)(lds + LDS_ST);
    unsigned* bar = (unsigned*)(ws + OFF_BAR);
    if (fused) { if (threadIdx.x == 0) { st[0] = 0u; st[1] = 0u; } __syncthreads(); }
    XcdBarrier xb; xb.bar = bar; xb.x = 0u; xb.st = st;
    if (fused) xb = xcd_barrier_post(bar, st);
    PH(0) phase0(P, (float*)shm);
    SYNC(0)
    PH(1) { Epi1 E{R2, R3, rstd0}; run_gemm(lds, R1, (const bf16_t*)(ws + OFF_WIN1), M_TOK, 2048, 1024, E); }
    SYNC(1)
    PH(2) pool_phase(P);
    SYNC(2)
    PH(3) { EpiResB<true> E{P.x, nullptr, R2}; run_gemm(lds, R1, (const bf16_t*)(ws + OFF_WAOUT), M_TOK, 1024, 1024, E); }
    SYNC(3)
    PH(4) { SchedPG S{ws, 0, (int)gridDim.x, (int)blockIdx.x}; EpiPG<true> E{EpiE{E1b}, EpiGate<true>{R2, E1b, R3, rstd1, nullptr}}; pg8::gemm_stream(lds, S, E); }
    SYNC(4)
    PH(6) { SchedP6 S{ws, (int)gridDim.x, (int)blockIdx.x};
            EpiP6 E{EpiKQZ{R1, R2, R4 + (size_t)M_TOK * DM, rstd1, P.k_norm, P.b_q_norm}, EpiVT{R4, rstd1}}; pg8::gemm_stream(lds, S, E); }
    SYNC(6)
    PH(7) attn_phase(P, lds);
    SYNC(7)
    PH(8) { EpiResB<false> E{nullptr, R3, R2}; run_gemm(lds, (const bf16_t*)P.out, (const bf16_t*)(ws + OFF_WBOUT), M_TOK, 1024, 1024, E); }
    SYNC(8)
    PH(9) { SchedPG S{ws, 1, (int)gridDim.x, (int)blockIdx.x}; EpiPG<false> E{EpiE{E1b}, EpiGate<false>{R2, E1b, nullptr, nullptr, P.out}}; pg8::gemm_stream(lds, S, E); }
}

extern "C" void kernel_launch(void* const* d_in, const int* in_sizes, int n_in, void* d_out, int out_size, void* d_ws, size_t ws_size, hipStream_t stream) {
    static int grid = 0;
    if (grid == 0) {
        int dev = 0, cus = 0, per_cu = 0;
        if (n_in != 16 || out_size != M_TOK * DM || ws_size < WS_END) { fprintf(stderr, "kernel_launch: unexpected shapes (n_in %d out %d ws %zu)\n", n_in, out_size, ws_size); grid = -1; return; }
        (void)hipGetDevice(&dev); (void)hipDeviceGetAttribute(&cus, hipDeviceAttributeMultiprocessorCount, dev);
        if (hipFuncSetAttribute((const void*)yoco_fwd, hipFuncAttributeMaxDynamicSharedMemorySize, LDS_BYTES) != hipSuccess) { fprintf(stderr, "kernel_launch: hipFuncSetAttribute failed\n"); grid = -1; return; }
        (void)hipOccupancyMaxActiveBlocksPerMultiprocessor(&per_cu, (const void*)yoco_fwd, 512, LDS_BYTES);
        if (per_cu < 1) { fprintf(stderr, "kernel_launch: occupancy query says %d blocks per CU\n", per_cu); (void)hipGetLastError(); per_cu = 1; }
        grid = cus;
    }
    if (grid < 0) return;
    Params p{};
    const float** pp = (const float**)&p;
    for (int i = 0; i < 16; ++i) pp[i] = (const float*)d_in[i];
    p.out = (float*)d_out; p.ws = (unsigned char*)d_ws;
    p.ph_lo = 0; p.ph_hi = NPHASE;
    if (hipMemsetAsync((unsigned char*)d_ws + OFF_BAR, 0, XCD_BAR_WORDS * 4, stream) != hipSuccess) { fprintf(stderr, "kernel_launch: memset of the barrier words failed\n"); return; }
    void* args[] = {&p};
    hipError_t e = hipLaunchCooperativeKernel((const void*)yoco_fwd, dim3(grid), dim3(512), args, LDS_BYTES, stream);
    if (e != hipSuccess) fprintf(stderr, "kernel_launch: cooperative launch failed: %s (grid %d)\n", hipGetErrorString(e), grid);
}
```

```cpp
#include <hip/hip_runtime.h>
#include <cstdio>
namespace pg8 {
#define PG8_LAS __attribute__((address_space(3)))
typedef unsigned short bf16_t;
typedef short bf16x8 __attribute__((ext_vector_type(8)));
typedef float f32x4 __attribute__((ext_vector_type(4)));
typedef unsigned u32x4 __attribute__((ext_vector_type(4)));
constexpr int BM = 256, BK = 64, HALF = 128, HTB = HALF * BK * 2  , STAGE_BYTES = 8 * HTB, NXCD = 8, WGM = 8;

__host__ __device__ __forceinline__ int lds_byte(int r, int c) { const int st = (r >> 4) * 2 + (c >> 5), rr = r & 15, cc = c & 31, ob = rr * 64 + cc * 2; return st * 1024 + (ob ^ (((ob >> 9) & 1) << 5)); }
__host__ __device__ __forceinline__ void stage_rc(int b, int& R, int& C) { const int st = b / 1024, sb = b % 1024, swz = sb ^ (((sb >> 9) & 1) << 5); R = (st >> 1) * 16 + swz / 64; C = (st & 1) * 32 + (swz % 64) / 2; }
__host__ __device__ __forceinline__ int perm32(int rho) { const int n = rho >> 4, i = rho & 15; return 8 * (i >> 2) + 4 * n + (i & 3); }

struct Unit { int pm, pn; };
struct Gemm { const bf16_t* A; const bf16_t* Bt; int M, N, K; };
struct StaticOrder {
    int nM, nN, nwg, G, c;
    __host__ __device__ void init(int M, int N, int G_, int c_) { nM = M / BM; nN = N / BM; nwg = nM * nN; G = G_; c = c_; }
    __host__ __device__ bool next(int i, Unit& u) const {
        const long L = (long)i * G + c; if (L >= nwg) return false;
        int wgid = (int)L; { const int q = nwg / NXCD, r = nwg % NXCD, xcd = wgid % NXCD, off = wgid / NXCD; wgid = (xcd < r ? xcd * (q + 1) : r * (q + 1) + (xcd - r) * q) + off; }
        const int nig = WGM * nN, gid = wgid / nig, fm = gid * WGM, gsz = (nM - fm) < WGM ? (nM - fm) : WGM;
        u.pm = fm + ((wgid % nig) % gsz); u.pn = (wgid % nig) / gsz; return true;
    }
    __device__ __forceinline__ void a_ready(const Unit&) const {}
    __device__ __forceinline__ void done(const Unit&) const {}
};
template <class Epi, class Sched, bool STAMP = false>
__device__ __forceinline__ void gemm_phase(PG8_LAS unsigned char* lds, const Gemm g, const Sched& S, const Epi& E, unsigned long long* stamps) {
    const int tid = threadIdx.x, wid = __builtin_amdgcn_readfirstlane(tid >> 6), lane = tid & 63, wr = wid >> 2, wc = wid & 3, fr = lane & 15, fq = lane >> 4;
    const int K = g.K, nt = K / BK;
    int ts_lo = 0, ts_hi = 0, nts = 0; const unsigned long long rt_entry = STAMP ? (unsigned long long)wall_clock64() : 0ull;
#define PG8_STAMP() do { if (STAMP && wid == 0 && nts < 64) { const unsigned long long _c = (unsigned long long)clock64(); \
        ts_lo = (lane == nts) ? (int)(unsigned)_c : ts_lo; ts_hi = (lane == nts) ? (int)(unsigned)(_c >> 32) : ts_hi; ++nts; } } while (0)
    PG8_STAMP();
    unsigned voffA[2], voffB[2];
#pragma unroll
    for (int i = 0; i < 2; ++i) { int R, C; stage_rc(tid * 16 + i * 8192, R, C); const int Rb = Epi::PERM ? ((R & ~31) + perm32(R & 31)) : R;
        voffA[i] = (unsigned)(R * K + C) * 2u; voffB[i] = (unsigned)(Rb * K + C) * 2u; }
    const size_t kstep = (size_t)(BK * 2);
    const size_t hstep = (size_t)HALF * K * 2;
    const size_t tstep = 2 * hstep;
    const unsigned ldsw = (unsigned)wid * 1024u;
    const int aoff = lds_byte(wr * 64 + fr, fq * 8), boff = lds_byte(wc * 32 + fr, fq * 8);
#define PG8_SA(b, h) (((b) * 2 + (h)) * HTB)
#define PG8_SB(b, h) ((4 + (b) * 2 + (h)) * HTB)
#define PG8_STAGE(bufoff, gbase, voff) do { _Pragma("unroll") for (int _i = 0; _i < 2; ++_i) \
        __builtin_amdgcn_global_load_lds((const unsigned*)((const char*)(gbase) + (voff)[_i]), (PG8_LAS unsigned*)(lds + (bufoff) + ldsw + _i * 8192), 16, 0, 0); } while (0)
#define PG8_LDA(dst, b, h) do { _Pragma("unroll") for (int m = 0; m < 4; ++m) _Pragma("unroll") for (int k = 0; k < 2; ++k) dst[m][k] = *(const PG8_LAS bf16x8*)(lds + PG8_SA(b, h) + aoff + m * 2048 + k * 1024); } while (0)
#define PG8_LDB(dst, b, h) do { _Pragma("unroll") for (int n = 0; n < 2; ++n) _Pragma("unroll") for (int k = 0; k < 2; ++k) dst[n][k] = *(const PG8_LAS bf16x8*)(lds + PG8_SB(b, h) + boff + n * 2048 + k * 1024); } while (0)
#define PG8_MMA(ai, bj, At, Bt) do { __builtin_amdgcn_s_setprio(1); _Pragma("unroll") for (int m = 0; m < 4; ++m) _Pragma("unroll") for (int n = 0; n < 2; ++n) _Pragma("unroll") for (int k = 0; k < 2; ++k) \
        acc[ai][bj][m][n] = __builtin_amdgcn_mfma_f32_16x16x32_bf16(Bt[n][k], At[m][k], acc[ai][bj][m][n], 0, 0, 0); __builtin_amdgcn_s_setprio(0); } while (0)
#define PG8_WAIT_V(n) asm volatile("s_waitcnt vmcnt(" #n ")" ::: "memory")
#define PG8_WAIT_L(n) asm volatile("s_waitcnt lgkmcnt(" #n ")" ::: "memory")
#define PG8_BAR __builtin_amdgcn_s_barrier()
#define PG8_SCHED __builtin_amdgcn_sched_barrier(0)
    Unit cur, nxt; int ui = 0;
    if (!S.next(0, cur)) return;
    f32x4 acc[2][2][4][2];
#pragma unroll
    for (int a = 0; a < 2; ++a)
#pragma unroll
        for (int b = 0; b < 2; ++b)
#pragma unroll
            for (int m = 0; m < 4; ++m)
#pragma unroll
                for (int n = 0; n < 2; ++n) acc[a][b][m][n] = (f32x4){0.f, 0.f, 0.f, 0.f};
    bf16x8 At[4][2], B0[2][2], B1[2][2];
    const char* cA = (const char*)g.A + (size_t)cur.pm * tstep; const char* cB = (const char*)g.Bt + (size_t)cur.pn * tstep;
    S.a_ready(cur);
    PG8_STAGE(PG8_SB(0, 0), cB, voffB); PG8_STAGE(PG8_SA(0, 0), cA, voffA); PG8_STAGE(PG8_SB(0, 1), cB + hstep, voffB); PG8_STAGE(PG8_SA(0, 1), cA + hstep, voffA);
    if (wr == 1) PG8_BAR;
    PG8_WAIT_V(4); PG8_BAR;
    PG8_STAGE(PG8_SB(1, 0), cB + kstep, voffB); PG8_STAGE(PG8_SA(1, 0), cA + kstep, voffA); PG8_STAGE(PG8_SB(1, 1), cB + hstep + kstep, voffB);
    PG8_WAIT_V(6); PG8_BAR;
    PG8_STAMP();
    for (;;) {
        const bool has_next = S.next(ui + 1, nxt);
        const char* nA = has_next ? (const char*)g.A + (size_t)nxt.pm * tstep : cA; const char* nB = has_next ? (const char*)g.Bt + (size_t)nxt.pn * tstep : cB;
        for (int t = 0; t < nt; t += 2) {
            const bool last = (t == nt - 2);
            const char* a1 = cA + (size_t)(t + 1) * kstep;
            const char* a2 = last ? nA : cA + (size_t)(t + 2) * kstep; const char* b2 = last ? nB : cB + (size_t)(t + 2) * kstep;
            const char* a3 = a2 + kstep; const char* b3 = b2 + kstep;
            if (last && has_next) S.a_ready(nxt);
            PG8_LDB(B0, 0, 0); PG8_SCHED; PG8_LDA(At, 0, 0); PG8_STAGE(PG8_SA(1, 1), a1 + hstep, voffA);
            PG8_WAIT_L(8); PG8_BAR; PG8_WAIT_L(0); PG8_MMA(0, 0, At, B0); PG8_BAR; PG8_SCHED;
            PG8_LDB(B1, 0, 1); PG8_STAGE(PG8_SB(0, 0), b2, voffB);
            PG8_BAR; PG8_WAIT_L(0); PG8_MMA(0, 1, At, B1); PG8_BAR;
            PG8_LDA(At, 0, 1); PG8_STAGE(PG8_SA(0, 0), a2, voffA);
            PG8_BAR; PG8_WAIT_L(0); PG8_MMA(1, 0, At, B0); PG8_BAR; PG8_SCHED;
            PG8_STAGE(PG8_SB(0, 1), b2 + hstep, voffB);
            PG8_WAIT_V(6); PG8_BAR; PG8_MMA(1, 1, At, B1); PG8_BAR;
            PG8_LDB(B0, 1, 0); PG8_SCHED; PG8_LDA(At, 1, 0); PG8_STAGE(PG8_SA(0, 1), a2 + hstep, voffA);
            PG8_WAIT_L(8); PG8_BAR; PG8_WAIT_L(0); PG8_MMA(0, 0, At, B0); PG8_BAR; PG8_SCHED;
            PG8_LDB(B1, 1, 1); PG8_STAGE(PG8_SB(1, 0), b3, voffB);
            PG8_BAR; PG8_WAIT_L(0); PG8_MMA(0, 1, At, B1); PG8_BAR;
            PG8_LDA(At, 1, 1); PG8_STAGE(PG8_SA(1, 0), a3, voffA);
            PG8_BAR; PG8_WAIT_L(0); PG8_MMA(1, 0, At, B0); PG8_BAR; PG8_SCHED;
            PG8_STAGE(PG8_SB(1, 1), b3 + hstep, voffB);
            PG8_WAIT_V(6); PG8_BAR; PG8_MMA(1, 1, At, B1); PG8_BAR;
        }
        PG8_STAMP();
        if constexpr (!Epi::AFTER_DRAIN) { E(acc, cur, wr, wc, fr, fq); S.done(cur); }
        PG8_STAMP();
        if (!has_next) break;
#pragma unroll
        for (int a = 0; a < 2; ++a)
#pragma unroll
            for (int b = 0; b < 2; ++b)
#pragma unroll
                for (int m = 0; m < 4; ++m)
#pragma unroll
                    for (int n = 0; n < 2; ++n) acc[a][b][m][n] = (f32x4){0.f, 0.f, 0.f, 0.f};
        cur = nxt; cA = nA; cB = nB; ++ui;
    }
    PG8_WAIT_V(0);
    if (wr == 0) PG8_BAR;
    PG8_BAR;
    if constexpr (Epi::AFTER_DRAIN) { E.fused(acc, cur, wr, wc, fr, fq, lds, wid, lane); S.done(cur); }
    PG8_STAMP();
    if (STAMP && wid == 0) { stamps[lane] = lane < nts ? (((unsigned long long)(unsigned)ts_hi << 32) | (unsigned)ts_lo) : 0ull;
        if (lane == 62) stamps[62] = rt_entry; if (lane == 63) stamps[63] = (unsigned long long)wall_clock64(); }
#undef PG8_STAMP
#undef PG8_SA
#undef PG8_SB
#undef PG8_STAGE
#undef PG8_LDA
#undef PG8_LDB
#undef PG8_MMA
#undef PG8_WAIT_V
#undef PG8_WAIT_L
#undef PG8_BAR
#undef PG8_SCHED
}
}
namespace pg8 {
struct UnitX { int pm, pn, kind; };
struct GDesc { const bf16_t* A; const bf16_t* Bt; int ks; };
__device__ __forceinline__ void map_unit(int L, int nM, int nN, int& pm, int& pn) {
    const int nwg = nM * nN; int wgid = L; { const int q = nwg / NXCD, r = nwg % NXCD, xcd = wgid % NXCD, off = wgid / NXCD; wgid = (xcd < r ? xcd * (q + 1) : r * (q + 1) + (xcd - r) * q) + off; }
    const int nig = WGM * nN, gid = wgid / nig, fm = gid * WGM, gsz = (nM - fm) < WGM ? (nM - fm) : WGM;
    pm = fm + ((wgid % nig) % gsz); pn = (wgid % nig) / gsz;
}
template <class Epi, class Sched>
__device__ __forceinline__ void gemm_stream(PG8_LAS unsigned char* lds, const Sched& S, const Epi& E) {
    const int tid = threadIdx.x, wid = __builtin_amdgcn_readfirstlane(tid >> 6), lane = tid & 63, wr = wid >> 2, wc = wid & 3, fr = lane & 15, fq = lane >> 4;
    const size_t kstep = (size_t)(BK * 2);
    const unsigned ldsw = (unsigned)wid * 1024u;
    const int aoff = lds_byte(wr * 64 + fr, fq * 8), boff = lds_byte(wc * 32 + fr, fq * 8);
#define PG8_SA(b, h) (((b) * 2 + (h)) * HTB)
#define PG8_SB(b, h) ((4 + (b) * 2 + (h)) * HTB)
#define PG8_STAGE(bufoff, gbase, voff) do { _Pragma("unroll") for (int _i = 0; _i < 2; ++_i) \
        __builtin_amdgcn_global_load_lds((const unsigned*)((const char*)(gbase) + (voff)[_i]), (PG8_LAS unsigned*)(lds + (bufoff) + ldsw + _i * 8192), 16, 0, 0); } while (0)
#define PG8_LDA(dst, b, h) do { _Pragma("unroll") for (int m = 0; m < 4; ++m) _Pragma("unroll") for (int k = 0; k < 2; ++k) dst[m][k] = *(const PG8_LAS bf16x8*)(lds + PG8_SA(b, h) + aoff + m * 2048 + k * 1024); } while (0)
#define PG8_LDB(dst, b, h) do { _Pragma("unroll") for (int n = 0; n < 2; ++n) _Pragma("unroll") for (int k = 0; k < 2; ++k) dst[n][k] = *(const PG8_LAS bf16x8*)(lds + PG8_SB(b, h) + boff + n * 2048 + k * 1024); } while (0)
#define PG8_MMA(ai, bj, At, Bt) do { __builtin_amdgcn_s_setprio(1); _Pragma("unroll") for (int m = 0; m < 4; ++m) _Pragma("unroll") for (int n = 0; n < 2; ++n) _Pragma("unroll") for (int k = 0; k < 2; ++k) \
        acc[ai][bj][m][n] = __builtin_amdgcn_mfma_f32_16x16x32_bf16(Bt[n][k], At[m][k], acc[ai][bj][m][n], 0, 0, 0); __builtin_amdgcn_s_setprio(0); } while (0)
#define PG8_WAIT_V(n) asm volatile("s_waitcnt vmcnt(" #n ")" ::: "memory")
#define PG8_WAIT_L(n) asm volatile("s_waitcnt lgkmcnt(" #n ")" ::: "memory")
#define PG8_BAR __builtin_amdgcn_s_barrier()
#define PG8_SCHED __builtin_amdgcn_sched_barrier(0)
    UnitX cur, nxt; int ui = 0;
    if (!S.next(0, cur)) return;
    f32x4 acc[2][2][4][2];
#pragma unroll
    for (int a = 0; a < 2; ++a)
#pragma unroll
        for (int b = 0; b < 2; ++b)
#pragma unroll
            for (int m = 0; m < 4; ++m)
#pragma unroll
                for (int n = 0; n < 2; ++n) acc[a][b][m][n] = (f32x4){0.f, 0.f, 0.f, 0.f};
    bf16x8 At[4][2], B0[2][2], B1[2][2];
    GDesc dc = S.desc(cur.kind);
    int ksC = dc.ks; size_t hsC = (size_t)HALF * ksC * 2;
    unsigned vAc[2], vBc[2];
#pragma unroll
    for (int i = 0; i < 2; ++i) { int R, C; stage_rc(tid * 16 + i * 8192, R, C); const int Rb = (R & ~31) + perm32(R & 31);
        vAc[i] = (unsigned)(R * ksC + C) * 2u; vBc[i] = (unsigned)(Rb * ksC + C) * 2u; }
    int shC = 31 - __builtin_clz((unsigned)ksC * 2u);
    const char* cA = (const char*)dc.A + (size_t)cur.pm * 2 * hsC; const char* cB = (const char*)dc.Bt + (size_t)cur.pn * 2 * hsC;
    PG8_STAGE(PG8_SB(0, 0), cB, vBc); PG8_STAGE(PG8_SA(0, 0), cA, vAc); PG8_STAGE(PG8_SB(0, 1), cB + hsC, vBc); PG8_STAGE(PG8_SA(0, 1), cA + hsC, vAc);
    if (wr == 1) PG8_BAR;
    PG8_WAIT_V(4); PG8_BAR;
    PG8_STAGE(PG8_SB(1, 0), cB + kstep, vBc); PG8_STAGE(PG8_SA(1, 0), cA + kstep, vAc); PG8_STAGE(PG8_SB(1, 1), cB + hsC + kstep, vBc);
    PG8_WAIT_V(6); PG8_BAR;
    for (;;) {
        const bool has_next = S.next(ui + 1, nxt);
        const char* nA = cA; const char* nB = cB; int ksN = ksC; size_t hsN = hsC;
        if (has_next) { const GDesc dn = S.desc(nxt.kind); ksN = dn.ks; hsN = (size_t)HALF * ksN * 2;
            nA = (const char*)dn.A + (size_t)nxt.pm * 2 * hsN; nB = (const char*)dn.Bt + (size_t)nxt.pn * 2 * hsN; }
        const int shN = 31 - __builtin_clz((unsigned)ksN * 2u); const unsigned cmask = (unsigned)ksC * 2u - 1u;
        const int nt = ksC / BK;
        for (int t = 0; t < nt; t += 2) {
            const bool last = (t == nt - 2);
            const char* a1 = cA + (size_t)(t + 1) * kstep;
            const char* a2 = last ? nA : cA + (size_t)(t + 2) * kstep; const char* b2 = last ? nB : cB + (size_t)(t + 2) * kstep;
            const char* a3 = a2 + kstep; const char* b3 = b2 + kstep;
            const size_t hs2 = last ? hsN : hsC;
            unsigned vA2[2], vB2[2];
#pragma unroll
            for (int i = 0; i < 2; ++i) { vA2[i] = last ? (((vAc[i] >> shC) << shN) | (vAc[i] & cmask)) : vAc[i]; vB2[i] = last ? (((vBc[i] >> shC) << shN) | (vBc[i] & cmask)) : vBc[i]; }
            PG8_LDB(B0, 0, 0); PG8_SCHED; PG8_LDA(At, 0, 0); PG8_STAGE(PG8_SA(1, 1), a1 + hsC, vAc);
            PG8_WAIT_L(8); PG8_BAR; PG8_WAIT_L(0); PG8_MMA(0, 0, At, B0); PG8_BAR; PG8_SCHED;
            PG8_LDB(B1, 0, 1); PG8_STAGE(PG8_SB(0, 0), b2, vB2);
            PG8_BAR; PG8_WAIT_L(0); PG8_MMA(0, 1, At, B1); PG8_BAR;
            PG8_LDA(At, 0, 1); PG8_STAGE(PG8_SA(0, 0), a2, vA2);
            PG8_BAR; PG8_WAIT_L(0); PG8_MMA(1, 0, At, B0); PG8_BAR; PG8_SCHED;
            PG8_STAGE(PG8_SB(0, 1), b2 + hs2, vB2);
            PG8_WAIT_V(6); PG8_BAR; PG8_MMA(1, 1, At, B1); PG8_BAR;
            PG8_LDB(B0, 1, 0); PG8_SCHED; PG8_LDA(At, 1, 0); PG8_STAGE(PG8_SA(0, 1), a2 + hs2, vA2);
            PG8_WAIT_L(8); PG8_BAR; PG8_WAIT_L(0); PG8_MMA(0, 0, At, B0); PG8_BAR; PG8_SCHED;
            PG8_LDB(B1, 1, 1); PG8_STAGE(PG8_SB(1, 0), b3, vB2);
            PG8_BAR; PG8_WAIT_L(0); PG8_MMA(0, 1, At, B1); PG8_BAR;
            PG8_LDA(At, 1, 1); PG8_STAGE(PG8_SA(1, 0), a3, vA2);
            PG8_BAR; PG8_WAIT_L(0); PG8_MMA(1, 0, At, B0); PG8_BAR; PG8_SCHED;
            PG8_STAGE(PG8_SB(1, 1), b3 + hs2, vB2);
            PG8_WAIT_V(6); PG8_BAR; PG8_MMA(1, 1, At, B1); PG8_BAR;
        }
        E(acc, cur, wr, wc, fr, fq);
        if (!has_next) break;
#pragma unroll
        for (int a = 0; a < 2; ++a)
#pragma unroll
            for (int b = 0; b < 2; ++b)
#pragma unroll
                for (int m = 0; m < 4; ++m)
#pragma unroll
                    for (int n = 0; n < 2; ++n) acc[a][b][m][n] = (f32x4){0.f, 0.f, 0.f, 0.f};
#pragma unroll
        for (int i = 0; i < 2; ++i) { vAc[i] = ((vAc[i] >> shC) << shN) | (vAc[i] & cmask); vBc[i] = ((vBc[i] >> shC) << shN) | (vBc[i] & cmask); }
        cur = nxt; cA = nA; cB = nB; ksC = ksN; hsC = hsN; shC = shN; ++ui;
    }
    PG8_WAIT_V(0);
    if (wr == 0) PG8_BAR;
    PG8_BAR;
#undef PG8_SA
#undef PG8_SB
#undef PG8_STAGE
#undef PG8_LDA
#undef PG8_LDB
#undef PG8_MMA
#undef PG8_WAIT_V
#undef PG8_WAIT_L
#undef PG8_BAR
#undef PG8_SCHED
}
}
#define XB_TMO      128
#define XB_XCNT(j)  (256  + 64 * (j))
#define XB_XSUB(j)  (1280 + 64 * (j))
#define XB_XGEN(j)  (2304 + 64 * (j))
#define XB_TOP      3328
#define XB_TOPGEN   3392
#define XCD_BAR_WORDS 3456
#define XB_SPIN_CAP (1u << 18)
#define LAS __attribute__((address_space(3)))
__device__ __forceinline__ unsigned xb_ld(unsigned* p)              { return __hip_atomic_load(p, __ATOMIC_RELAXED, __HIP_MEMORY_SCOPE_AGENT); }
__device__ __forceinline__ unsigned xb_add(unsigned* p, unsigned v) { return __hip_atomic_fetch_add(p, v, __ATOMIC_RELAXED, __HIP_MEMORY_SCOPE_AGENT); }
__device__ __forceinline__ unsigned xb_xcc_id() { return (unsigned)__builtin_amdgcn_s_getreg((3 << 11) | 20) & 0xFu; }
#define XB_SPIN(cond, bar) do { unsigned _sp = 0; while (cond) { __builtin_amdgcn_s_sleep(1); \
    if ((++_sp & 255u) == 0u) { if (xb_ld(&(bar)[XB_TMO])) break; if (_sp > XB_SPIN_CAP) { atomicAdd(&(bar)[XB_TMO], 1u); break; } } } } while (0)

struct XcdBarrier {
    unsigned* bar; unsigned x;
    volatile LAS unsigned* st;
};

__device__ __forceinline__ XcdBarrier xcd_barrier_post(unsigned* bar, volatile LAS unsigned* st) {
    XcdBarrier b; b.bar = bar; b.x = xb_xcc_id(); b.st = st;
    if (threadIdx.x == 0) (void)xb_add(&bar[XB_XCNT(b.x)], 1u);
    return b;
}
__device__ __forceinline__ void xcd_barrier_complete(unsigned* bar, unsigned x, unsigned& nloc, unsigned& nx) {
    const unsigned G = gridDim.x * gridDim.y * gridDim.z;
    unsigned sum, cnt, mine, sp = 0u;
    for (;;) {
        sum = 0u; cnt = 0u; mine = 0u;
#pragma unroll
        for (unsigned j = 0; j < 16; ++j) { const unsigned c = xb_ld(&bar[XB_XCNT(j)]); sum += c; cnt += (c > 0u) ? 1u : 0u; mine = (j == x) ? c : mine; }
        if (sum == G) break;
        __builtin_amdgcn_s_sleep(1);
        if ((++sp & 255u) == 0u) { if (xb_ld(&bar[XB_TMO])) break; if (sp > XB_SPIN_CAP) { atomicAdd(&bar[XB_TMO], 1u); break; } }
    }
    nloc = mine > 0u ? mine : 1u; nx = cnt > 0u ? cnt : 1u;
}

template <class F> __device__ __forceinline__ void xcd_barrier(const XcdBarrier& b, F&& shadow) {
    asm volatile("s_waitcnt vmcnt(0)" ::: "memory");
    __syncthreads();
    if (threadIdx.x == 0) {
        unsigned* bar = b.bar;
        __builtin_amdgcn_s_waitcnt(0);
        unsigned nloc = b.st[0], nx = b.st[1];
        if (nloc == 0u) { xcd_barrier_complete(bar, b.x, nloc, nx); b.st[0] = nloc; b.st[1] = nx; }
        const unsigned old = xb_add(&bar[XB_XSUB(b.x)], 1u);
        const unsigned gen = old / nloc;
        if (old + 1u == (gen + 1u) * nloc) {
            __builtin_amdgcn_fence(__ATOMIC_RELEASE, "agent");
            asm volatile("s_waitcnt vmcnt(0)" ::: "memory");
            const unsigned og = xb_add(&bar[XB_TOP], 1u);
            const unsigned tg = og / nx;
            if (og + 1u == (tg + 1u) * nx) xb_add(&bar[XB_TOPGEN], 1u);
            else XB_SPIN(xb_ld(&bar[XB_TOPGEN]) == tg, bar);
            __builtin_amdgcn_fence(__ATOMIC_ACQUIRE, "agent");
            xb_add(&bar[XB_XGEN(b.x)], 1u);
            asm volatile("s_waitcnt vmcnt(0)" ::: "memory");
        } else {
            XB_SPIN(xb_ld(&bar[XB_XGEN(b.x)]) == gen, bar);
            __builtin_amdgcn_fence(__ATOMIC_ACQUIRE, "agent");
            asm volatile("s_waitcnt vmcnt(0)" ::: "memory");
        }
    } else if (threadIdx.x >= 64) shadow();
    __syncthreads();
}
using pg8::f32x4; using pg8::u32x4; using pg8::bf16_t; using pg8::Unit;
#define DI __device__ __forceinline__
constexpr int M_TOK = 16384, DM = 1024, SEQ = 2048, NPHASE = 10;
constexpr float EPS = 1e-6f;
constexpr int LDS_ST = 147456, LDS_BYTES = LDS_ST + 16;
constexpr size_t MiB = 1024 * 1024;
constexpr size_t OFF_WIN1 = 0, OFF_WAOUT = 4 * MiB, OFF_WPLE0 = 6 * MiB, OFF_WPLE1 = 6 * MiB + 512 * 1024, OFF_WG0 = 7 * MiB, OFF_WG1 = 9 * MiB,
                 OFF_WKQZ = 11 * MiB, OFF_WV = 17 * MiB, OFF_WBOUT = 19 * MiB, OFF_PB = 21 * MiB, OFF_R1 = 37 * MiB, OFF_R2 = 69 * MiB, OFF_R3 = 101 * MiB,
                 OFF_R4 = 133 * MiB, OFF_RSTD0 = 197 * MiB, OFF_RSTD1 = 197 * MiB + 65536, OFF_SSP = 197 * MiB + 131072, OFF_BAR = 199 * MiB, OFF_E1 = 200 * MiB, WS_END = 232 * MiB;

struct Params {
    const float *x, *p, *a_norm, *a_w_in, *a_w_group, *a_scale, *a_w_out, *kv_norm, *w_kv, *k_norm, *b_norm, *b_w_in, *b_q_norm, *b_w_out, *ple_w, *ple_gate_w;
    float* out; unsigned char* ws; int ph_lo, ph_hi;
};

typedef __bf16 bf16x2_t __attribute__((ext_vector_type(2)));
typedef float f32x2_t __attribute__((ext_vector_type(2)));
typedef unsigned u32x2_t __attribute__((ext_vector_type(2)));
typedef short s16x8 __attribute__((ext_vector_type(8)));
typedef short s16x4 __attribute__((ext_vector_type(4)));
typedef float f32x16 __attribute__((ext_vector_type(16)));
DI unsigned pk2(float lo, float hi) { f32x2_t v = {lo, hi}; bf16x2_t r = __builtin_convertvector(v, bf16x2_t); return __builtin_bit_cast(unsigned, r); }
DI float bflo(unsigned u) { return __uint_as_float(u << 16); }
DI float bfhi(unsigned u) { return __uint_as_float(u & 0xffff0000u); }
DI u32x4 pk8(f32x4 a, f32x4 b) { u32x4 w; w.x = pk2(a[0], a[1]); w.y = pk2(a[2], a[3]); w.z = pk2(b[0], b[1]); w.w = pk2(b[2], b[3]); return w; }
DI int xcd_affine_id() { const int G = (int)gridDim.x, w = (int)blockIdx.x; return (G & 7) ? w : (w & 7) * (G >> 3) + (w >> 3); }
DI float wave_sum(float v) {
#pragma unroll
    for (int o = 1; o < 64; o <<= 1) v += __shfl_xor(v, o);
    return v;
}
DI float sigm(float v) { return __builtin_amdgcn_rcpf(1.f + __expf(-v)); }
DI f32x4 silu4(f32x4 v) { f32x4 r; r[0] = v[0] * sigm(v[0]); r[1] = v[1] * sigm(v[1]); r[2] = v[2] * sigm(v[2]); r[3] = v[3] * sigm(v[3]); return r; }
DI f32x4 sigm4(f32x4 v) { f32x4 r; r[0] = sigm(v[0]); r[1] = sigm(v[1]); r[2] = sigm(v[2]); r[3] = sigm(v[3]); return r; }

typedef const f32x4 (&AccRef)[2][2][4][2];

struct Epi1 {
    static constexpr bool PERM = true, AFTER_DRAIN = false;
    bf16_t* ug; bf16_t* sz; const float* rstd0;
    DI void operator()(AccRef acc, const Unit& u, int wr, int wc, int fr, int fq) const {
        const int row0 = u.pm * 256 + wr * 64 + fr; const bool isz = u.pn >= 4;
        bf16_t* base = (isz ? sz : ug) + (u.pn & 3) * 256 + wc * 32 + 8 * fq;
        float rsv[2][4];
#pragma unroll
        for (int ai = 0; ai < 2; ++ai)
#pragma unroll
            for (int m = 0; m < 4; ++m) rsv[ai][m] = rstd0[row0 + ai * 128 + m * 16];
#pragma unroll
        for (int ai = 0; ai < 2; ++ai)
#pragma unroll
            for (int m = 0; m < 4; ++m) { const int row = row0 + ai * 128 + m * 16; const float rs = rsv[ai][m]; bf16_t* rowp = base + (size_t)row * DM;
#pragma unroll
                for (int bj = 0; bj < 2; ++bj) { f32x4 v0 = acc[ai][bj][m][0] * rs, v1 = acc[ai][bj][m][1] * rs;
                    if (isz) { v0 = silu4(v0); v1 = silu4(v1); }
                    *(u32x4*)(rowp + bj * 128) = pk8(v0, v1); } }
    }
};
struct EpiE {
    static constexpr bool PERM = true, AFTER_DRAIN = false;
    bf16_t* e;
    DI void operator()(AccRef acc, const Unit& u, int wr, int wc, int fr, int fq) const {
        const int row0 = u.pm * 256 + wr * 64 + fr; bf16_t* base = e + u.pn * 256 + wc * 32 + 8 * fq;
#pragma unroll
        for (int ai = 0; ai < 2; ++ai)
#pragma unroll
            for (int m = 0; m < 4; ++m) { bf16_t* rowp = base + (size_t)(row0 + ai * 128 + m * 16) * DM;
#pragma unroll
                for (int bj = 0; bj < 2; ++bj) *(u32x4*)(rowp + bj * 128) = pk8(acc[ai][bj][m][0], acc[ai][bj][m][1]); }
    }
};
DI void unpk8(const u32x4 q, f32x4& lo, f32x4& hi) { lo = (f32x4){bflo(q.x), bfhi(q.x), bflo(q.y), bfhi(q.y)}; hi = (f32x4){bflo(q.z), bfhi(q.z), bflo(q.w), bfhi(q.w)}; }
template <bool SRCF32> struct EpiResB {
    static constexpr bool PERM = true, AFTER_DRAIN = false;
    const float* srcf; const bf16_t* srcb; bf16_t* xb;
    DI void operator()(AccRef acc, const Unit& u, int wr, int wc, int fr, int fq) const {
        const int row0 = u.pm * 256 + wr * 64 + fr, col0 = u.pn * 256 + wc * 32 + 8 * fq;
#pragma unroll
        for (int ai = 0; ai < 2; ++ai) {
            f32x4 a[4][2][2];
#pragma unroll
            for (int m = 0; m < 4; ++m) { const size_t o = (size_t)(row0 + ai * 128 + m * 16) * DM + col0;
#pragma unroll
                for (int bj = 0; bj < 2; ++bj) {
                    if (SRCF32) { a[m][bj][0] = __builtin_nontemporal_load((const f32x4*)(srcf + o + bj * 128)); a[m][bj][1] = __builtin_nontemporal_load((const f32x4*)(srcf + o + bj * 128 + 4)); }
                    else { const u32x4 q = *(const u32x4*)(srcb + o + bj * 128); unpk8(q, a[m][bj][0], a[m][bj][1]); } } }
#pragma unroll
            for (int m = 0; m < 4; ++m) { const size_t o = (size_t)(row0 + ai * 128 + m * 16) * DM + col0;
#pragma unroll
                for (int bj = 0; bj < 2; ++bj) *(u32x4*)(xb + o + bj * 128) = pk8(a[m][bj][0] + acc[ai][bj][m][0], a[m][bj][1] + acc[ai][bj][m][1]); }
        }
    }
};
template <bool NEXT> struct EpiGate {
    static constexpr bool PERM = true, AFTER_DRAIN = false;
    const bf16_t* xin; const bf16_t* e; bf16_t* xb; float* ssp; float* outf;
    DI void operator()(AccRef acc, const Unit& u, int wr, int wc, int fr, int fq) const {
        const int row0 = u.pm * 256 + wr * 64 + fr, col0 = u.pn * 256 + wc * 32 + 8 * fq;
#pragma unroll
        for (int ai = 0; ai < 2; ++ai) {
            u32x4 xv[4][2], ev[4][2];
#pragma unroll
            for (int m = 0; m < 4; ++m) { const size_t o = (size_t)(row0 + ai * 128 + m * 16) * DM + col0;
#pragma unroll
                for (int bj = 0; bj < 2; ++bj) { xv[m][bj] = *(const u32x4*)(xin + o + bj * 128); ev[m][bj] = *(const u32x4*)(e + o + bj * 128); } }
#pragma unroll
            for (int m = 0; m < 4; ++m) { const int row = row0 + ai * 128 + m * 16; const size_t o = (size_t)row * DM + col0; float ss = 0.f;
#pragma unroll
                for (int bj = 0; bj < 2; ++bj) { f32x4 a0, a1, e0, e1; unpk8(xv[m][bj], a0, a1); unpk8(ev[m][bj], e0, e1);
                    const f32x4 v0 = a0 + e0 * sigm4(acc[ai][bj][m][0]), v1 = a1 + e1 * sigm4(acc[ai][bj][m][1]);
                    if (NEXT) { *(u32x4*)(xb + o + bj * 128) = pk8(v0, v1);
                        ss += (v0[0] * v0[0] + v0[1] * v0[1]) + (v0[2] * v0[2] + v0[3] * v0[3]) + (v1[0] * v1[0] + v1[1] * v1[1]) + (v1[2] * v1[2] + v1[3] * v1[3]); }
                    else { __builtin_nontemporal_store(v0, (f32x4*)(outf + o + bj * 128)); __builtin_nontemporal_store(v1, (f32x4*)(outf + o + bj * 128 + 4)); } }
                if (NEXT) { ss += __shfl_xor(ss, 16); ss += __shfl_xor(ss, 32); if (fq == 0) atomicAdd(ssp + row, ss); } }
        }
    }
};
struct EpiKQZ {
    static constexpr bool PERM = true, AFTER_DRAIN = false;
    bf16_t *kk, *qq, *sz2; const float *rstd1, *k_norm, *q_norm;
    DI void operator()(AccRef acc, const Unit& u, int wr, int wc, int fr, int fq) const {
        const int row0 = u.pm * 256 + wr * 64 + fr, kind = u.pn >> 2, pq = u.pn & 3;
        float rsv[2][4];
#pragma unroll
        for (int ai = 0; ai < 2; ++ai)
#pragma unroll
            for (int m = 0; m < 4; ++m) rsv[ai][m] = rstd1[row0 + ai * 128 + m * 16];
        if (kind == 2) {
            bf16_t* base = sz2 + pq * 256 + 64 * wc + 8 * fq;
#pragma unroll
            for (int ai = 0; ai < 2; ++ai)
#pragma unroll
                for (int m = 0; m < 4; ++m) { const int row = row0 + ai * 128 + m * 16; const float rs = rsqrtf(rsv[ai][m] * (1.f / DM) + EPS); bf16_t* rowp = base + (size_t)row * DM;
#pragma unroll
                    for (int bj = 0; bj < 2; ++bj) *(u32x4*)(rowp + bj * 32) = pk8(silu4(acc[ai][bj][m][0] * rs), silu4(acc[ai][bj][m][1] * rs)); }
        } else {
            const float* gn = kind ? q_norm : k_norm; const float mul = kind ? 0.125f * 1.4426950408889634f : 1.f;
            bf16_t* dst = kind ? qq : kk; const int head = pq * 4 + wc;
            f32x4 g[2][2];
#pragma unroll
            for (int bj = 0; bj < 2; ++bj)
#pragma unroll
                for (int n = 0; n < 2; ++n) g[bj][n] = *(const f32x4*)(gn + 32 * bj + 8 * fq + 4 * n) * mul;
#pragma unroll
            for (int ai = 0; ai < 2; ++ai)
#pragma unroll
                for (int m = 0; m < 4; ++m) { const int row = row0 + ai * 128 + m * 16; const float rs = rsqrtf(rsv[ai][m] * (1.f / DM) + EPS); const int b = row >> 11, s = row & 2047;
                    f32x4 v[2][2]; float ss = 0.f;
#pragma unroll
                    for (int bj = 0; bj < 2; ++bj)
#pragma unroll
                        for (int n = 0; n < 2; ++n) { v[bj][n] = acc[ai][bj][m][n] * rs; ss += (v[bj][n][0] * v[bj][n][0] + v[bj][n][1] * v[bj][n][1]) + (v[bj][n][2] * v[bj][n][2] + v[bj][n][3] * v[bj][n][3]); }
                    ss += __shfl_xor(ss, 16); ss += __shfl_xor(ss, 32);
                    const float hr = rsqrtf(ss * (1.f / 64.f) + EPS);
                    bf16_t* rowp = dst + ((size_t)(b * 16 + head) * SEQ + s) * 64 + 8 * fq;
#pragma unroll
                    for (int bj = 0; bj < 2; ++bj) *(u32x4*)(rowp + 32 * bj) = pk8(v[bj][0] * hr * g[bj][0], v[bj][1] * hr * g[bj][1]); }
        }
    }
};
struct EpiVT {
    static constexpr bool PERM = true, AFTER_DRAIN = false;
    bf16_t* vt; const float* rstd1;
    DI void operator()(AccRef acc, const Unit& u, int wr, int wc, int fr, int fq) const {
        const int c0 = u.pm * 256 + wr * 64 + fr, tok0 = u.pn * 256 + wc * 32 + 8 * fq;
        f32x4 rs[2][2];
#pragma unroll
        for (int bj = 0; bj < 2; ++bj)
#pragma unroll
            for (int n = 0; n < 2; ++n) { const f32x4 q = *(const f32x4*)(rstd1 + tok0 + 128 * bj + 4 * n);
#pragma unroll
                for (int j = 0; j < 4; ++j) rs[bj][n][j] = rsqrtf(q[j] * (1.f / DM) + EPS); }
#pragma unroll
        for (int ai = 0; ai < 2; ++ai)
#pragma unroll
            for (int m = 0; m < 4; ++m) { const int c = c0 + ai * 128 + m * 16;
#pragma unroll
                for (int bj = 0; bj < 2; ++bj) { const int tok = tok0 + 128 * bj, b = tok >> 11, s = tok & 2047;
                    *(u32x4*)(vt + ((size_t)b * DM + c) * SEQ + s) = pk8(acc[ai][bj][m][0] * rs[bj][0], acc[ai][bj][m][1] * rs[bj][1]); } }
    }
};
template <class Epi> DI void run_gemm(PG8_LAS unsigned char* lds, const bf16_t* A, const bf16_t* Bt, int M, int N, int K, const Epi& E) {
    pg8::Gemm g{A, Bt, M, N, K}; pg8::StaticOrder S; S.init(M, N, (int)gridDim.x, (int)blockIdx.x);
    pg8::gemm_phase<Epi, pg8::StaticOrder, false>(lds, g, S, E, nullptr);
}

struct SchedPG {
    const unsigned char* ws; int layer, G, c;
    DI bool next(int i, pg8::UnitX& u) const { const int L = i * G + c; if (L >= 512) return false;
        pg8::map_unit(L & 255, 64, 4, u.pm, u.pn); u.kind = L >> 8; return true; }
    DI pg8::GDesc desc(int k) const { pg8::GDesc d;
        const size_t oa = k == 0 ? OFF_PB + (size_t)layer * M_TOK * 256 * 2 : OFF_R2, ob = k == 0 ? (layer ? OFF_WPLE1 : OFF_WPLE0) : (layer ? OFF_WG1 : OFF_WG0);
        d.A = (const bf16_t*)(ws + oa); d.Bt = (const bf16_t*)(ws + ob); d.ks = k == 0 ? 256 : 1024; return d; }
    DI void a_ready(const pg8::UnitX&) const {}
    DI void done(const pg8::UnitX&) const {}
};
template <bool NEXT> struct EpiPG {
    static constexpr bool PERM = true;
    EpiE e; EpiGate<NEXT> g;
    DI void operator()(AccRef acc, const pg8::UnitX& u, int wr, int wc, int fr, int fq) const { const Unit uu{u.pm, u.pn};
        if (u.kind == 0) e(acc, uu, wr, wc, fr, fq); else g(acc, uu, wr, wc, fr, fq); }
};
struct SchedP6 {
    const unsigned char* ws; int G, c;
    DI bool next(int i, pg8::UnitX& u) const { const int L = i * G + c; if (L >= 1024) return false;
        if (L < 768) { pg8::map_unit(L, 64, 12, u.pm, u.pn); u.kind = 0; } else { pg8::map_unit(L - 768, 4, 64, u.pm, u.pn); u.kind = 1; }
        return true; }
    DI pg8::GDesc desc(int k) const { pg8::GDesc d; d.A = (const bf16_t*)(ws + (k == 0 ? OFF_R3 : OFF_WV)); d.Bt = (const bf16_t*)(ws + (k == 0 ? OFF_WKQZ : OFF_R3)); d.ks = 1024; return d; }
};
struct EpiP6 {
    static constexpr bool PERM = true;
    EpiKQZ a; EpiVT b;
    DI void operator()(AccRef acc, const pg8::UnitX& u, int wr, int wc, int fr, int fq) const { const Unit uu{u.pm, u.pn};
        if (u.kind == 0) a(acc, uu, wr, wc, fr, fq); else b(acc, uu, wr, wc, fr, fq); }
};

DI int headperm(int cl) { const int o = cl & 255, wc = o >> 6, bj = (o >> 5) & 1, r = o & 31; return (cl & ~255) + 128 * bj + 32 * wc + r; }
DI void transpose_item(float* scr, const float* src, int ld, int K, int nT, const float* gain, bf16_t* dst, int rowoff, bool perm, int item, int lane) {
    const int kt = item / nT, nt = item - kt * nT, k0 = kt * 64, n0 = nt * 32, lr = lane >> 3, lc = lane & 7;
    float4 v[8];
#pragma unroll
    for (int i = 0; i < 8; ++i) v[i] = *(const float4*)(src + (size_t)(k0 + i * 8 + lr) * ld + n0 + lc * 4);
    float gk[8];
#pragma unroll
    for (int i = 0; i < 8; ++i) gk[i] = gain ? gain[k0 + 8 * lc + i] : 1.f;
#pragma unroll
    for (int i = 0; i < 8; ++i) { float* t = scr + (i * 8 + lr) * 33 + lc * 4; t[0] = v[i].x; t[1] = v[i].y; t[2] = v[i].z; t[3] = v[i].w; }
    asm volatile("s_waitcnt lgkmcnt(0)" ::: "memory");
#pragma unroll
    for (int j = 0; j < 4; ++j) { const int n = lr + 8 * j; const float* t = scr + (8 * lc) * 33 + n;
        int row = rowoff + n0 + n; if (perm) row = headperm(row);
        u32x4 w; w.x = pk2(t[0] * gk[0], t[33] * gk[1]); w.y = pk2(t[66] * gk[2], t[99] * gk[3]); w.z = pk2(t[132] * gk[4], t[165] * gk[5]); w.w = pk2(t[198] * gk[6], t[231] * gk[7]);
        *(u32x4*)(dst + (size_t)row * K + k0 + 8 * lc) = w; }
    asm volatile("s_waitcnt lgkmcnt(0)" ::: "memory");
}
DI void weff_job(float* L, const Params& P, bf16_t* dst, int job) {
    float* As = L; float* Bs = L + 64 * 129;
    const int tid = threadIdx.x, k0 = (job >> 4) * 64, n0 = (job & 15) * 64, g = n0 >> 8, d0 = n0 & 255, kk = tid >> 3, dg = tid & 7;
    float acc[8];
#pragma unroll
    for (int j = 0; j < 8; ++j) acc[j] = 0.f;
    for (int c0 = 0; c0 < 256; c0 += 128) {
        __syncthreads();
#pragma unroll
        for (int i = 0; i < 4; ++i) { const int idx = tid + 512 * i;
            { const int r = idx >> 5, c4 = idx & 31; const float4 v = *(const float4*)(P.a_w_in + (size_t)(k0 + r) * 2048 + g * 256 + c0 + c4 * 4);
              float* t = As + r * 129 + c4 * 4; t[0] = v.x; t[1] = v.y; t[2] = v.z; t[3] = v.w; }
            { const int cc = idx >> 4, d4 = idx & 15; *(float4*)(Bs + cc * 64 + d4 * 4) = *(const float4*)(P.a_w_group + (size_t)(g * 256 + c0 + cc) * 256 + d0 + d4 * 4); } }
        __syncthreads();
#pragma unroll 4
        for (int c = 0; c < 128; ++c) { const float a = As[kk * 129 + c]; const float4 b0 = *(const float4*)(Bs + c * 64 + dg * 8), b1 = *(const float4*)(Bs + c * 64 + dg * 8 + 4);
            acc[0] += a * b0.x; acc[1] += a * b0.y; acc[2] += a * b0.z; acc[3] += a * b0.w; acc[4] += a * b1.x; acc[5] += a * b1.y; acc[6] += a * b1.z; acc[7] += a * b1.w; }
    }
    const float an = P.a_norm[k0 + kk];
#pragma unroll
    for (int j = 0; j < 8; ++j) { const int n = n0 + dg * 8 + j; const float v = acc[j] * an * P.a_scale[n];
        dst[(size_t)n * DM + k0 + kk] = (bf16_t)(pk2(v, v) & 0xffffu); }
}
DI void shadow_p_convert(const Params& P, int half) {
    const float4* pp = (const float4*)P.p; u32x4* pb = (u32x4*)(P.ws + OFF_PB);
    const int HALFCH = M_TOK * 256 / 8, step = gridDim.x * 448, base = half * HALFCH;
    for (int i = blockIdx.x * 448 + ((int)threadIdx.x - 64); i < HALFCH; i += 5 * step) { float4 a[5], b[5];
#pragma unroll
        for (int q = 0; q < 5; ++q) if (i + q * step < HALFCH) { a[q] = pp[2 * (base + i + q * step)]; b[q] = pp[2 * (base + i + q * step) + 1]; }
#pragma unroll
        for (int q = 0; q < 5; ++q) if (i + q * step < HALFCH) { u32x4 u; u.x = pk2(a[q].x, a[q].y); u.y = pk2(a[q].z, a[q].w); u.z = pk2(b[q].x, b[q].y); u.w = pk2(b[q].z, b[q].w); pb[base + i + q * step] = u; } }
}
DI void deferred_items(const Params& P, float* L, int seam) {
    const int wid = threadIdx.x >> 6, lane = threadIdx.x & 63; unsigned char* ws = P.ws; float* scr = L + wid * (64 * 33);
    const int nitems = (seam == 0) ? 768 : (seam == 1 ? 512 : 1024);
    for (int t = blockIdx.x * 7 + (wid - 1); t < nitems; t += gridDim.x * 7) {
        const int r = t & 511, hi = t >> 9;
        if (seam == 0) { if (hi == 0) transpose_item(scr, P.a_w_out, 1024, 1024, 32, nullptr, (bf16_t*)(ws + OFF_WAOUT), 0, false, r, lane);
                         else if (r < 128) transpose_item(scr, P.ple_w, 1024, 256, 32, nullptr, (bf16_t*)(ws + OFF_WPLE0), 0, false, r, lane);
                         else transpose_item(scr, P.ple_w + 256 * 1024, 1024, 256, 32, nullptr, (bf16_t*)(ws + OFF_WPLE1), 0, false, r - 128, lane); }
        else if (seam == 1) transpose_item(scr, P.ple_gate_w, 1024, 1024, 32, nullptr, (bf16_t*)(ws + OFF_WG0), 0, false, r, lane);
        else if (seam == 2) { if (hi == 0) transpose_item(scr, P.w_kv, 2048, 1024, 32, P.kv_norm, (bf16_t*)(ws + OFF_WKQZ), 0, true, r, lane);
                              else transpose_item(scr, P.w_kv + 1024, 2048, 1024, 32, P.kv_norm, (bf16_t*)(ws + OFF_WV), 0, false, r, lane); }
        else if (seam == 3) transpose_item(scr, P.b_w_in, 2048, 1024, 64, P.b_norm, (bf16_t*)(ws + OFF_WKQZ), 1024, true, t, lane);
        else { if (hi == 0) transpose_item(scr, P.b_w_out, 1024, 1024, 32, nullptr, (bf16_t*)(ws + OFF_WBOUT), 0, false, r, lane);
               else transpose_item(scr, P.ple_gate_w + 1024 * 1024, 1024, 1024, 32, nullptr, (bf16_t*)(ws + OFF_WG1), 0, false, r, lane); }
    }
    if (seam < 2) shadow_p_convert(P, seam);
}
DI void phase0(const Params& P, float* L) {
    const int tid = threadIdx.x, wid = tid >> 6, lane = tid & 63, w = blockIdx.x, G = gridDim.x;
    unsigned char* ws = P.ws;
    { float* ss1 = (float*)(ws + OFF_RSTD1); for (int i = w * 512 + tid; i < M_TOK; i += G * 512) ss1[i] = 0.f; }
    if ((w & 1) == 0) { for (int job = w; job < 256; job += G) weff_job(L, P, (bf16_t*)(ws + OFF_WIN1), job); __syncthreads(); }
    { float* scr = L + wid * (64 * 33);
      for (int t = w * 8 + wid; t < 512; t += G * 8) transpose_item(scr, P.a_w_in + 1024, 2048, 1024, 32, P.a_norm, (bf16_t*)(ws + OFF_WIN1) + (size_t)1024 * 1024, 0, false, t, lane); }
    { bf16_t* xb = (bf16_t*)(ws + OFF_R1); float* rstd0 = (float*)(ws + OFF_RSTD0);
      for (int row = (xcd_affine_id() * 8 + wid) * 8; row < M_TOK; row += G * 64) {
          float4 v[8][4];
#pragma unroll
          for (int q = 0; q < 8; ++q)
#pragma unroll
              for (int j = 0; j < 4; ++j) v[q][j] = ((const float4*)(P.x + (size_t)(row + q) * DM) + lane)[64 * j];
#pragma unroll
          for (int q = 0; q < 8; ++q) { float s = 0.f;
#pragma unroll
              for (int j = 0; j < 4; ++j) s += (v[q][j].x * v[q][j].x + v[q][j].y * v[q][j].y) + (v[q][j].z * v[q][j].z + v[q][j].w * v[q][j].w);
              s = wave_sum(s);
              uint2* o = (uint2*)(xb + (size_t)(row + q) * DM) + lane;
#pragma unroll
              for (int j = 0; j < 4; ++j) { uint2 u; u.x = pk2(v[q][j].x, v[q][j].y); u.y = pk2(v[q][j].z, v[q][j].w); o[64 * j] = u; }
              if (lane == 0) rstd0[row + q] = rsqrtf(s * (1.f / DM) + EPS); } } }
    if ((w & 1) != 0) { __syncthreads(); for (int job = w; job < 256; job += G) weff_job(L, P, (bf16_t*)(ws + OFF_WIN1), job); }
}
DI void unpack8(const u32x4 q, float (&f)[8]) { f[0] = bflo(q.x); f[1] = bfhi(q.x); f[2] = bflo(q.y); f[3] = bfhi(q.y); f[4] = bflo(q.z); f[5] = bfhi(q.z); f[6] = bflo(q.w); f[7] = bfhi(q.w); }
DI void pool_phase(const Params& P) {
    const bf16_t* ug = (const bf16_t*)(P.ws + OFF_R2); const bf16_t* sz = (const bf16_t*)(P.ws + OFF_R3); bf16_t* Gd = (bf16_t*)(P.ws + OFF_R1);
    const int nth = gridDim.x * 512;
    for (int idx = xcd_affine_id() * 512 + threadIdx.x; idx < 131072; idx += nth) {
        const int chunk = idx & 127, run = idx >> 7, row0 = run * 16, t0 = row0 & (SEQ - 1), c0 = chunk * 8, wlen = 2 << (chunk >> 5);
        const u32x4* up = (const u32x4*)(ug + (size_t)row0 * DM + c0); const u32x4* zp = (const u32x4*)(sz + (size_t)row0 * DM + c0); u32x4* gp = (u32x4*)(Gd + (size_t)row0 * DM + c0);
        float s[8], c[8], z[8];
#pragma unroll
        for (int j = 0; j < 8; ++j) s[j] = 0.f;
        { const bool hist = t0 > 0;
#pragma unroll
          for (int j = 1; j <= 16; ++j) {
              const int jj = hist ? (j <= wlen ? j : wlen) : 0; const float mk = (hist && j <= wlen) ? 1.f : 0.f;
              unpack8(up[-(jj * 128)], c);
#pragma unroll
              for (int q = 0; q < 8; ++q) s[q] += mk * c[q]; } }
        const float inv_full = 1.f / (float)wlen;
#pragma unroll 4
        for (int rr = 0; rr < 16; ++rr) {
            const int t = t0 + rr;
            if (t >= wlen) { unpack8(up[(rr - wlen) * 128], c);
#pragma unroll
                for (int q = 0; q < 8; ++q) s[q] -= c[q]; }
            unpack8(up[rr * 128], c); unpack8(zp[rr * 128], z);
            const float inv = (t + 1 < wlen) ? 1.f / (float)(t + 1) : inv_full;
            float o[8];
#pragma unroll
            for (int q = 0; q < 8; ++q) { s[q] += c[q]; o[q] = (s[q] * inv - c[q]) * z[q]; }
            u32x4 w; w.x = pk2(o[0], o[1]); w.y = pk2(o[2], o[3]); w.z = pk2(o[4], o[5]); w.w = pk2(o[6], o[7]); gp[rr * 128] = w;
        }
    }
}
#define MFMA32(a, b, c) __builtin_amdgcn_mfma_f32_32x32x16_bf16((a), (b), (c), 0, 0, 0)
DI void attn_phase(const Params& P, PG8_LAS unsigned char* lds) {
    constexpr int HIST = 128, WIN = 384, KP = 144, VP = 776, NF = 6, VCH = 48;
    PG8_LAS unsigned char* Kl = lds; PG8_LAS unsigned char* Vl = lds + WIN * KP;
    const bf16_t* kk = (const bf16_t*)(P.ws + OFF_R1); const bf16_t* qq = (const bf16_t*)(P.ws + OFF_R2); const bf16_t* vt = (const bf16_t*)(P.ws + OFF_R4);
    const bf16_t* sz2 = (const bf16_t*)(P.ws + OFF_R4 + 32 * MiB); bf16_t* g2 = (bf16_t*)P.out;
    const int tid = threadIdx.x, wid = tid >> 6, lane = tid & 63, r = lane & 31, hh = lane >> 5;
#define ATT_LOAD_FILL(IT, KV, VV) do { const int _bh = (IT) >> 3, _wlo = ((IT) & 7) * 256 - HIST; const bf16_t* _Kg = kk + (size_t)_bh * SEQ * 64; const bf16_t* _Vg = vt + (size_t)_bh * 64 * SEQ; \
        _Pragma("unroll") for (int i = 0; i < NF; ++i) { const int c = tid + 512 * i, row = c >> 3, part = c & 7, key = _wlo + row; if (key >= 0) KV[i] = *(const u32x4*)(_Kg + (size_t)key * 64 + part * 8); } \
        _Pragma("unroll") for (int i = 0; i < NF; ++i) { const int c = tid + 512 * i, d = c / VCH, part = c - d * VCH, key0 = _wlo + part * 8; if (key0 >= 0) VV[i] = *(const u32x4*)(_Vg + (size_t)d * SEQ + key0); } } while (0)
#define ATT_LOAD_Q(IT, QF) do { const bf16_t* _Qp = qq + ((size_t)((IT) >> 3) * SEQ + ((IT) & 7) * 256 + 32 * wid + r) * 64 + hh * 8; \
        _Pragma("unroll") for (int ks = 0; ks < 4; ++ks) QF[ks] = *(const s16x8*)(_Qp + ks * 16); } while (0)
    u32x4 kv[NF], vv[NF];
    const bool aff = (gridDim.x & 7) == 0; const int islot0 = aff ? (int)(blockIdx.x >> 3) : (int)blockIdx.x, istep = aff ? (int)(gridDim.x >> 3) : (int)gridDim.x, ibase = aff ? (int)(blockIdx.x & 7) * 128 : 0, ilim = aff ? 128 : 1024;
    if (islot0 < ilim) { ATT_LOAD_FILL(ibase + islot0, kv, vv); }
    for (int islot = islot0; islot < ilim; islot += istep) {
        const int item = ibase + islot;
        const int qc = item & 7, bh = item >> 3, t0 = qc * 256, wlo = t0 - HIST, tq = t0 + 32 * wid;
        const bf16_t* Kg = kk + (size_t)bh * SEQ * 64; const bf16_t* Vg = vt + (size_t)bh * 64 * SEQ;
        const int b = bh >> 4, h = bh & 15; const size_t rowo = ((size_t)b * SEQ + tq + r) * DM + h * 64 + 4 * hh;
        asm volatile("s_waitcnt lgkmcnt(0)" ::: "memory"); __builtin_amdgcn_s_barrier(); asm volatile("" ::: "memory");
#pragma unroll
        for (int i = 0; i < NF; ++i) { const int c = tid + 512 * i, row = c >> 3, part = c & 7, key = wlo + row;
            if (key >= 0) *(PG8_LAS u32x4*)(Kl + row * KP + part * 16) = kv[i]; }
#pragma unroll
        for (int i = 0; i < NF; ++i) { const int c = tid + 512 * i, d = c / VCH, part = c - d * VCH, key0 = wlo + part * 8;
            if (key0 >= 0) { PG8_LAS u32x2_t* w = (PG8_LAS u32x2_t*)(Vl + d * VP + part * 16); u32x2_t a = {vv[i].x, vv[i].y}, bb = {vv[i].z, vv[i].w}; w[0] = a; w[1] = bb; } }
        s16x8 qf[4]; ATT_LOAD_Q(item, qf);
        asm volatile("s_waitcnt lgkmcnt(0)" ::: "memory"); __builtin_amdgcn_s_barrier(); asm volatile("" ::: "memory");
        const size_t rowc = ((size_t)b * SEQ + tq + (lane >> 3)) * DM + h * 64 + (lane & 7) * 8;
        u32x4 zc[4];
#pragma unroll
        for (int i = 0; i < 4; ++i) zc[i] = *(const u32x4*)(sz2 + rowc + (size_t)(8 * i) * DM);
        const int nitem = (islot + istep < ilim) ? item + istep : 1024;
        u32x4 kvn[NF], vvn[NF];
        if (nitem < 1024) { ATT_LOAD_FILL(nitem, kvn, vvn); }
        f32x16 o0, o1;
#pragma unroll
        for (int i = 0; i < 16; ++i) { o0[i] = 0.f; o1[i] = 0.f; }
        float carry = 1.f;
        for (int s0 = tq; s0 >= 0; s0 -= 32) {
            s16x8 kf[4]; s16x4 vf[2][2][2];
            if (s0 >= wlo) {
                PG8_LAS const unsigned char* kp = Kl + (s0 - wlo + r) * KP + hh * 16; PG8_LAS const unsigned char* vp = Vl + r * VP + (s0 - wlo + 4 * hh) * 2;
#pragma unroll
                for (int ks = 0; ks < 4; ++ks) kf[ks] = *(PG8_LAS const s16x8*)(kp + ks * 32);
#pragma unroll
                for (int dt = 0; dt < 2; ++dt)
#pragma unroll
                    for (int s = 0; s < 2; ++s)
#pragma unroll
                        for (int pt = 0; pt < 2; ++pt) vf[dt][s][pt] = *(PG8_LAS const s16x4*)(vp + dt * 32 * VP + (16 * s + 8 * pt) * 2);
            } else {
                const bf16_t* kp = Kg + (size_t)(s0 + r) * 64 + hh * 8; const bf16_t* vp = Vg + (size_t)r * SEQ + s0 + 4 * hh;
#pragma unroll
                for (int ks = 0; ks < 4; ++ks) kf[ks] = *(const s16x8*)(kp + ks * 16);
#pragma unroll
                for (int dt = 0; dt < 2; ++dt)
#pragma unroll
                    for (int s = 0; s < 2; ++s)
#pragma unroll
                        for (int pt = 0; pt < 2; ++pt) vf[dt][s][pt] = *(const s16x4*)(vp + (size_t)dt * 32 * SEQ + 16 * s + 8 * pt);
            }
            f32x16 x;
#pragma unroll
            for (int i = 0; i < 16; ++i) x[i] = 0.f;
#pragma unroll
            for (int ks = 0; ks < 4; ++ks) x = MFMA32(kf[ks], qf[ks], x);
            float beta[16], keep[16];
            const bool diag = (s0 == tq);
#pragma unroll
            for (int i = 0; i < 16; ++i) {
                const float l = fmaxf(x[i], -120.f);
                const float e = __builtin_amdgcn_exp2f(-l);
                float bt = __builtin_amdgcn_rcpf(1.f + e), kp = e * bt;
                beta[i] = bt; keep[i] = kp;
            }
            if (diag) {
#pragma unroll
                for (int i = 0; i < 16; ++i) { const bool valid = ((i & 3) + 8 * (i >> 2) + 4 * hh) < r; beta[i] = valid ? beta[i] : 0.f; keep[i] = valid ? keep[i] : 1.f; }
            }
            float Gp[4], PG[4];
#pragma unroll
            for (int g = 0; g < 4; ++g) { Gp[g] = (keep[4 * g] * keep[4 * g + 1]) * (keep[4 * g + 2] * keep[4 * g + 3]); PG[g] = __shfl_xor(Gp[g], 32); }
            float base[4];
            { float so = 1.f, sp = 1.f;
#pragma unroll
              for (int g = 3; g >= 0; --g) { base[g] = carry * so * sp * (hh == 0 ? PG[g] : 1.f); so *= Gp[g]; sp *= PG[g]; }
              carry = carry * so * sp; }
            float a[16];
#pragma unroll
            for (int g = 0; g < 4; ++g) { float run = base[g];
                a[4 * g + 3] = beta[4 * g + 3] * run; run *= keep[4 * g + 3];
                a[4 * g + 2] = beta[4 * g + 2] * run; run *= keep[4 * g + 2];
                a[4 * g + 1] = beta[4 * g + 1] * run; run *= keep[4 * g + 1];
                a[4 * g] = beta[4 * g] * run; }
#pragma unroll
            for (int s = 0; s < 2; ++s) {
                u32x4 pw; pw.x = pk2(a[8 * s], a[8 * s + 1]); pw.y = pk2(a[8 * s + 2], a[8 * s + 3]); pw.z = pk2(a[8 * s + 4], a[8 * s + 5]); pw.w = pk2(a[8 * s + 6], a[8 * s + 7]);
                const s16x8 pf = __builtin_bit_cast(s16x8, pw);
                const s16x8 va = __builtin_shufflevector(vf[0][s][0], vf[0][s][1], 0, 1, 2, 3, 4, 5, 6, 7);
                const s16x8 vb = __builtin_shufflevector(vf[1][s][0], vf[1][s][1], 0, 1, 2, 3, 4, 5, 6, 7);
                o0 = MFMA32(va, pf, o0); o1 = MFMA32(vb, pf, o1);
            }
            if (__all(carry < 1e-12f)) break;
        }
        { PG8_LAS unsigned char* S = lds + WIN * KP + 64 * VP + wid * 4608;
#pragma unroll
          for (int i = 0; i < 4; ++i) *(PG8_LAS u32x4*)(S + ((lane >> 3) + 8 * i) * 144 + (lane & 7) * 16) = zc[i];
          asm volatile("s_waitcnt lgkmcnt(0)" ::: "memory");
          PG8_LAS unsigned char* Sr = S + r * 144 + 8 * hh;
#pragma unroll
          for (int g = 0; g < 4; ++g) {
              const u32x2_t z0 = *(PG8_LAS const u32x2_t*)(Sr + 16 * g), z1 = *(PG8_LAS const u32x2_t*)(Sr + 64 + 16 * g);
              u32x2_t w0, w1;
              w0.x = pk2(o0[4 * g] * bflo(z0.x), o0[4 * g + 1] * bfhi(z0.x)); w0.y = pk2(o0[4 * g + 2] * bflo(z0.y), o0[4 * g + 3] * bfhi(z0.y));
              w1.x = pk2(o1[4 * g] * bflo(z1.x), o1[4 * g + 1] * bfhi(z1.x)); w1.y = pk2(o1[4 * g + 2] * bflo(z1.y), o1[4 * g + 3] * bfhi(z1.y));
              *(PG8_LAS u32x2_t*)(Sr + 16 * g) = w0; *(PG8_LAS u32x2_t*)(Sr + 64 + 16 * g) = w1; }
          asm volatile("s_waitcnt lgkmcnt(0)" ::: "memory");
#pragma unroll
          for (int i = 0; i < 4; ++i) { const u32x4 v = *(PG8_LAS const u32x4*)(S + ((lane >> 3) + 8 * i) * 144 + (lane & 7) * 16); *(u32x4*)(g2 + rowc + (size_t)(8 * i) * DM) = v; }
          asm volatile("s_waitcnt lgkmcnt(0)" ::: "memory"); }
#pragma unroll
        for (int i = 0; i < NF; ++i) { kv[i] = kvn[i]; vv[i] = vvn[i]; }
    }
#undef ATT_LOAD_FILL
#undef ATT_LOAD_Q
}

__global__ __launch_bounds__(512, 2) void yoco_fwd(Params P) {
    extern __shared__ __attribute__((aligned(16))) unsigned char shm[];
    PG8_LAS unsigned char* lds = (PG8_LAS unsigned char*)shm;
    unsigned char* ws = P.ws;
    bf16_t* R1 = (bf16_t*)(ws + OFF_R1); bf16_t* R2 = (bf16_t*)(ws + OFF_R2); bf16_t* R3 = (bf16_t*)(ws + OFF_R3); bf16_t* R4 = (bf16_t*)(ws + OFF_R4);
    float* rstd0 = (float*)(ws + OFF_RSTD0); float* rstd1 = (float*)(ws + OFF_RSTD1); float* ssp = (float*)(ws + OFF_SSP);
    const bf16_t* pb = (const bf16_t*)(ws + OFF_PB); bf16_t* E1b = (bf16_t*)(ws + OFF_E1);
#define PH(k) if (P.ph_lo <= (k) && (k) < P.ph_hi)
#define SYNC(k) if (fused) { if ((k) < 5) xcd_barrier(xb, [&]() { deferred_items(P, (float*)shm, (k)); }); else xcd_barrier(xb, []() {}); }
    const bool fused = (P.ph_hi - P.ph_lo) > 1;
    volatile LAS unsigned* st = (volatile LAS unsigned*)(lds + LDS_ST);
    unsigned* bar = (unsigned*)(ws + OFF_BAR);
    if (fused) { if (threadIdx.x == 0) { st[0] = 0u; st[1] = 0u; } __syncthreads(); }
    XcdBarrier xb; xb.bar = bar; xb.x = 0u; xb.st = st;
    if (fused) xb = xcd_barrier_post(bar, st);
    PH(0) phase0(P, (float*)shm);
    SYNC(0)
    PH(1) { Epi1 E{R2, R3, rstd0}; run_gemm(lds, R1, (const bf16_t*)(ws + OFF_WIN1), M_TOK, 2048, 1024, E); }
    SYNC(1)
    PH(2) pool_phase(P);
    SYNC(2)
    PH(3) { EpiResB<true> E{P.x, nullptr, R2}; run_gemm(lds, R1, (const bf16_t*)(ws + OFF_WAOUT), M_TOK, 1024, 1024, E); }
    SYNC(3)
    PH(4) { SchedPG S{ws, 0, (int)gridDim.x, (int)blockIdx.x}; EpiPG<true> E{EpiE{E1b}, EpiGate<true>{R2, E1b, R3, rstd1, nullptr}}; pg8::gemm_stream(lds, S, E); }
    SYNC(4)
    PH(6) { SchedP6 S{ws, (int)gridDim.x, (int)blockIdx.x};
            EpiP6 E{EpiKQZ{R1, R2, R4 + (size_t)M_TOK * DM, rstd1, P.k_norm, P.b_q_norm}, EpiVT{R4, rstd1}}; pg8::gemm_stream(lds, S, E); }
    SYNC(6)
    PH(7) attn_phase(P, lds);
    SYNC(7)
    PH(8) { EpiResB<false> E{nullptr, R3, R2}; run_gemm(lds, (const bf16_t*)P.out, (const bf16_t*)(ws + OFF_WBOUT), M_TOK, 1024, 1024, E); }
    SYNC(8)
    PH(9) { SchedPG S{ws, 1, (int)gridDim.x, (int)blockIdx.x}; EpiPG<false> E{EpiE{E1b}, EpiGate<false>{R2, E1b, nullptr, nullptr, P.out}}; pg8::gemm_stream(lds, S, E); }
}

extern "C" void kernel_launch(void* const* d_in, const int* in_sizes, int n_in, void* d_out, int out_size, void* d_ws, size_t ws_size, hipStream_t stream) {
    static int grid = 0;
    if (grid == 0) {
        int dev = 0, cus = 0, per_cu = 0;
        if (n_in != 16 || out_size != M_TOK * DM || ws_size < WS_END) { fprintf(stderr, "kernel_launch: unexpected shapes (n_in %d out %d ws %zu)\n", n_in, out_size, ws_size); grid = -1; return; }
        (void)hipGetDevice(&dev); (void)hipDeviceGetAttribute(&cus, hipDeviceAttributeMultiprocessorCount, dev);
        if (hipFuncSetAttribute((const void*)yoco_fwd, hipFuncAttributeMaxDynamicSharedMemorySize, LDS_BYTES) != hipSuccess) { fprintf(stderr, "kernel_launch: hipFuncSetAttribute failed\n"); grid = -1; return; }
        (void)hipOccupancyMaxActiveBlocksPerMultiprocessor(&per_cu, (const void*)yoco_fwd, 512, LDS_BYTES);
        if (per_cu < 1) { fprintf(stderr, "kernel_launch: occupancy query says %d blocks per CU\n", per_cu); (void)hipGetLastError(); per_cu = 1; }
        grid = cus;
    }
    if (grid < 0) return;
    Params p{};
    const float** pp = (const float**)&p;
    for (int i = 0; i < 16; ++i) pp[i] = (const float*)d_in[i];
    p.out = (float*)d_out; p.ws = (unsigned char*)d_ws;
    p.ph_lo = 0; p.ph_hi = NPHASE;
    if (hipMemsetAsync((unsigned char*)d_ws + OFF_BAR, 0, XCD_BAR_WORDS * 4, stream) != hipSuccess) { fprintf(stderr, "kernel_launch: memset of the barrier words failed\n"); return; }
    void* args[] = {&p};
    hipError_t e = hipLaunchCooperativeKernel((const void*)yoco_fwd, dim3(grid), dim3(512), args, LDS_BYTES, stream);
    if (e != hipSuccess) fprintf(stderr, "kernel_launch: cooperative launch failed: %s (grid %d)\n", hipGetErrorString(e), grid);
}
```

```cpp
#include <hip/hip_runtime.h>
#include <cstdio>
namespace pg8 {
#define PG8_LAS __attribute__((address_space(3)))
typedef unsigned short bf16_t;
typedef short bf16x8 __attribute__((ext_vector_type(8)));
typedef float f32x4 __attribute__((ext_vector_type(4)));
typedef unsigned u32x4 __attribute__((ext_vector_type(4)));
constexpr int BM = 256, BK = 64, HALF = 128, HTB = HALF * BK * 2  , STAGE_BYTES = 8 * HTB, NXCD = 8, WGM = 8;

__host__ __device__ __forceinline__ int lds_byte(int r, int c) { const int st = (r >> 4) * 2 + (c >> 5), rr = r & 15, cc = c & 31, ob = rr * 64 + cc * 2; return st * 1024 + (ob ^ (((ob >> 9) & 1) << 5)); }
__host__ __device__ __forceinline__ void stage_rc(int b, int& R, int& C) { const int st = b / 1024, sb = b % 1024, swz = sb ^ (((sb >> 9) & 1) << 5); R = (st >> 1) * 16 + swz / 64; C = (st & 1) * 32 + (swz % 64) / 2; }
__host__ __device__ __forceinline__ int perm32(int rho) { const int n = rho >> 4, i = rho & 15; return 8 * (i >> 2) + 4 * n + (i & 3); }

struct Unit { int pm, pn; };
struct Gemm { const bf16_t* A; const bf16_t* Bt; int M, N, K; };
struct StaticOrder {
    int nM, nN, nwg, G, c;
    __host__ __device__ void init(int M, int N, int G_, int c_) { nM = M / BM; nN = N / BM; nwg = nM * nN; G = G_; c = c_; }
    __host__ __device__ bool next(int i, Unit& u) const {
        const long L = (long)i * G + c; if (L >= nwg) return false;
        int wgid = (int)L; { const int q = nwg / NXCD, r = nwg % NXCD, xcd = wgid % NXCD, off = wgid / NXCD; wgid = (xcd < r ? xcd * (q + 1) : r * (q + 1) + (xcd - r) * q) + off; }
        const int nig = WGM * nN, gid = wgid / nig, fm = gid * WGM, gsz = (nM - fm) < WGM ? (nM - fm) : WGM;
        u.pm = fm + ((wgid % nig) % gsz); u.pn = (wgid % nig) / gsz; return true;
    }
    __device__ __forceinline__ void a_ready(const Unit&) const {}
    __device__ __forceinline__ void done(const Unit&) const {}
};
template <class Epi, class Sched, bool STAMP = false>
__device__ __forceinline__ void gemm_phase(PG8_LAS unsigned char* lds, const Gemm g, const Sched& S, const Epi& E, unsigned long long* stamps) {
    const int tid = threadIdx.x, wid = __builtin_amdgcn_readfirstlane(tid >> 6), lane = tid & 63, wr = wid >> 2, wc = wid & 3, fr = lane & 15, fq = lane >> 4;
    const int K = g.K, nt = K / BK;
    int ts_lo = 0, ts_hi = 0, nts = 0; const unsigned long long rt_entry = STAMP ? (unsigned long long)wall_clock64() : 0ull;
#define PG8_STAMP() do { if (STAMP && wid == 0 && nts < 64) { const unsigned long long _c = (unsigned long long)clock64(); \
        ts_lo = (lane == nts) ? (int)(unsigned)_c : ts_lo; ts_hi = (lane == nts) ? (int)(unsigned)(_c >> 32) : ts_hi; ++nts; } } while (0)
    PG8_STAMP();
    unsigned voffA[2], voffB[2];
#pragma unroll
    for (int i = 0; i < 2; ++i) { int R, C; stage_rc(tid * 16 + i * 8192, R, C); const int Rb = Epi::PERM ? ((R & ~31) + perm32(R & 31)) : R;
        voffA[i] = (unsigned)(R * K + C) * 2u; voffB[i] = (unsigned)(Rb * K + C) * 2u; }
    const size_t kstep = (size_t)(BK * 2);
    const size_t hstep = (size_t)HALF * K * 2;
    const size_t tstep = 2 * hstep;
    const unsigned ldsw = (unsigned)wid * 1024u;
    const int aoff = lds_byte(wr * 64 + fr, fq * 8), boff = lds_byte(wc * 32 + fr, fq * 8);
#define PG8_SA(b, h) (((b) * 2 + (h)) * HTB)
#define PG8_SB(b, h) ((4 + (b) * 2 + (h)) * HTB)
#define PG8_STAGE(bufoff, gbase, voff) do { _Pragma("unroll") for (int _i = 0; _i < 2; ++_i) \
        __builtin_amdgcn_global_load_lds((const unsigned*)((const char*)(gbase) + (voff)[_i]), (PG8_LAS unsigned*)(lds + (bufoff) + ldsw + _i * 8192), 16, 0, 0); } while (0)
#define PG8_LDA(dst, b, h) do { _Pragma("unroll") for (int m = 0; m < 4; ++m) _Pragma("unroll") for (int k = 0; k < 2; ++k) dst[m][k] = *(const PG8_LAS bf16x8*)(lds + PG8_SA(b, h) + aoff + m * 2048 + k * 1024); } while (0)
#define PG8_LDB(dst, b, h) do { _Pragma("unroll") for (int n = 0; n < 2; ++n) _Pragma("unroll") for (int k = 0; k < 2; ++k) dst[n][k] = *(const PG8_LAS bf16x8*)(lds + PG8_SB(b, h) + boff + n * 2048 + k * 1024); } while (0)
#define PG8_MMA(ai, bj, At, Bt) do { __builtin_amdgcn_s_setprio(1); _Pragma("unroll") for (int m = 0; m < 4; ++m) _Pragma("unroll") for (int n = 0; n < 2; ++n) _Pragma("unroll") for (int k = 0; k < 2; ++k) \
        acc[ai][bj][m][n] = __builtin_amdgcn_mfma_f32_16x16x32_bf16(Bt[n][k], At[m][k], acc[ai][bj][m][n], 0, 0, 0); __builtin_amdgcn_s_setprio(0); } while (0)
#define PG8_WAIT_V(n) asm volatile("s_waitcnt vmcnt(" #n ")" ::: "memory")
#define PG8_WAIT_L(n) asm volatile("s_waitcnt lgkmcnt(" #n ")" ::: "memory")
#define PG8_BAR __builtin_amdgcn_s_barrier()
#define PG8_SCHED __builtin_amdgcn_sched_barrier(0)
    Unit cur, nxt; int ui = 0;
    if (!S.next(0, cur)) return;
    f32x4 acc[2][2][4][2];
#pragma unroll
    for (int a = 0; a < 2; ++a)
#pragma unroll
        for (int b = 0; b < 2; ++b)
#pragma unroll
            for (int m = 0; m < 4; ++m)
#pragma unroll
                for (int n = 0; n < 2; ++n) acc[a][b][m][n] = (f32x4){0.f, 0.f, 0.f, 0.f};
    bf16x8 At[4][2], B0[2][2], B1[2][2];
    const char* cA = (const char*)g.A + (size_t)cur.pm * tstep; const char* cB = (const char*)g.Bt + (size_t)cur.pn * tstep;
    S.a_ready(cur);
    PG8_STAGE(PG8_SB(0, 0), cB, voffB); PG8_STAGE(PG8_SA(0, 0), cA, voffA); PG8_STAGE(PG8_SB(0, 1), cB + hstep, voffB); PG8_STAGE(PG8_SA(0, 1), cA + hstep, voffA);
    if (wr == 1) PG8_BAR;
    PG8_WAIT_V(4); PG8_BAR;
    PG8_STAGE(PG8_SB(1, 0), cB + kstep, voffB); PG8_STAGE(PG8_SA(1, 0), cA + kstep, voffA); PG8_STAGE(PG8_SB(1, 1), cB + hstep + kstep, voffB);
    PG8_WAIT_V(6); PG8_BAR;
    PG8_STAMP();
    for (;;) {
        const bool has_next = S.next(ui + 1, nxt);
        const char* nA = has_next ? (const char*)g.A + (size_t)nxt.pm * tstep : cA; const char* nB = has_next ? (const char*)g.Bt + (size_t)nxt.pn * tstep : cB;
        for (int t = 0; t < nt; t += 2) {
            const bool last = (t == nt - 2);
            const char* a1 = cA + (size_t)(t + 1) * kstep;
            const char* a2 = last ? nA : cA + (size_t)(t + 2) * kstep; const char* b2 = last ? nB : cB + (size_t)(t + 2) * kstep;
            const char* a3 = a2 + kstep; const char* b3 = b2 + kstep;
            if (last && has_next) S.a_ready(nxt);
            PG8_LDB(B0, 0, 0); PG8_SCHED; PG8_LDA(At, 0, 0); PG8_STAGE(PG8_SA(1, 1), a1 + hstep, voffA);
            PG8_WAIT_L(8); PG8_BAR; PG8_WAIT_L(0); PG8_MMA(0, 0, At, B0); PG8_BAR; PG8_SCHED;
            PG8_LDB(B1, 0, 1); PG8_STAGE(PG8_SB(0, 0), b2, voffB);
            PG8_BAR; PG8_WAIT_L(0); PG8_MMA(0, 1, At, B1); PG8_BAR;
            PG8_LDA(At, 0, 1); PG8_STAGE(PG8_SA(0, 0), a2, voffA);
            PG8_BAR; PG8_WAIT_L(0); PG8_MMA(1, 0, At, B0); PG8_BAR; PG8_SCHED;
            PG8_STAGE(PG8_SB(0, 1), b2 + hstep, voffB);
            PG8_WAIT_V(6); PG8_BAR; PG8_MMA(1, 1, At, B1); PG8_BAR;
            PG8_LDB(B0, 1, 0); PG8_SCHED; PG8_LDA(At, 1, 0); PG8_STAGE(PG8_SA(0, 1), a2 + hstep, voffA);
            PG8_WAIT_L(8); PG8_BAR; PG8_WAIT_L(0); PG8_MMA(0, 0, At, B0); PG8_BAR; PG8_SCHED;
            PG8_LDB(B1, 1, 1); PG8_STAGE(PG8_SB(1, 0), b3, voffB);
            PG8_BAR; PG8_WAIT_L(0); PG8_MMA(0, 1, At, B1); PG8_BAR;
            PG8_LDA(At, 1, 1); PG8_STAGE(PG8_SA(1, 0), a3, voffA);
            PG8_BAR; PG8_WAIT_L(0); PG8_MMA(1, 0, At, B0); PG8_BAR; PG8_SCHED;
            PG8_STAGE(PG8_SB(1, 1), b3 + hstep, voffB);
            PG8_WAIT_V(6); PG8_BAR; PG8_MMA(1, 1, At, B1); PG8_BAR;
        }
        PG8_STAMP();
        if constexpr (!Epi::AFTER_DRAIN) { E(acc, cur, wr, wc, fr, fq); S.done(cur); }
        PG8_STAMP();
        if (!has_next) break;
#pragma unroll
        for (int a = 0; a < 2; ++a)
#pragma unroll
            for (int b = 0; b < 2; ++b)
#pragma unroll
                for (int m = 0; m < 4; ++m)
#pragma unroll
                    for (int n = 0; n < 2; ++n) acc[a][b][m][n] = (f32x4){0.f, 0.f, 0.f, 0.f};
        cur = nxt; cA = nA; cB = nB; ++ui;
    }
    PG8_WAIT_V(0);
    if (wr == 0) PG8_BAR;
    PG8_BAR;
    if constexpr (Epi::AFTER_DRAIN) { E.fused(acc, cur, wr, wc, fr, fq, lds, wid, lane); S.done(cur); }
    PG8_STAMP();
    if (STAMP && wid == 0) { stamps[lane] = lane < nts ? (((unsigned long long)(unsigned)ts_hi << 32) | (unsigned)ts_lo) : 0ull;
        if (lane == 62) stamps[62] = rt_entry; if (lane == 63) stamps[63] = (unsigned long long)wall_clock64(); }
#undef PG8_STAMP
#undef PG8_SA
#undef PG8_SB
#undef PG8_STAGE
#undef PG8_LDA
#undef PG8_LDB
#undef PG8_MMA
#undef PG8_WAIT_V
#undef PG8_WAIT_L
#undef PG8_BAR
#undef PG8_SCHED
}
}
namespace pg8 {
struct UnitX { int pm, pn, kind; };
struct GDesc { const bf16_t* A; const bf16_t* Bt; int ks; };
__device__ __forceinline__ void map_unit(int L, int nM, int nN, int& pm, int& pn) {
    const int nwg = nM * nN; int wgid = L; { const int q = nwg / NXCD, r = nwg % NXCD, xcd = wgid % NXCD, off = wgid / NXCD; wgid = (xcd < r ? xcd * (q + 1) : r * (q + 1) + (xcd - r) * q) + off; }
    const int nig = WGM * nN, gid = wgid / nig, fm = gid * WGM, gsz = (nM - fm) < WGM ? (nM - fm) : WGM;
    pm = fm + ((wgid % nig) % gsz); pn = (wgid % nig) / gsz;
}
template <class Epi, class Sched>
__device__ __forceinline__ void gemm_stream(PG8_LAS unsigned char* lds, const Sched& S, const Epi& E) {
    const int tid = threadIdx.x, wid = __builtin_amdgcn_readfirstlane(tid >> 6), lane = tid & 63, wr = wid >> 2, wc = wid & 3, fr = lane & 15, fq = lane >> 4;
    const size_t kstep = (size_t)(BK * 2);
    const unsigned ldsw = (unsigned)wid * 1024u;
    const int aoff = lds_byte(wr * 64 + fr, fq * 8), boff = lds_byte(wc * 32 + fr, fq * 8);
#define PG8_SA(b, h) (((b) * 2 + (h)) * HTB)
#define PG8_SB(b, h) ((4 + (b) * 2 + (h)) * HTB)
#define PG8_STAGE(bufoff, gbase, voff) do { _Pragma("unroll") for (int _i = 0; _i < 2; ++_i) \
        __builtin_amdgcn_global_load_lds((const unsigned*)((const char*)(gbase) + (voff)[_i]), (PG8_LAS unsigned*)(lds + (bufoff) + ldsw + _i * 8192), 16, 0, 0); } while (0)
#define PG8_LDA(dst, b, h) do { _Pragma("unroll") for (int m = 0; m < 4; ++m) _Pragma("unroll") for (int k = 0; k < 2; ++k) dst[m][k] = *(const PG8_LAS bf16x8*)(lds + PG8_SA(b, h) + aoff + m * 2048 + k * 1024); } while (0)
#define PG8_LDB(dst, b, h) do { _Pragma("unroll") for (int n = 0; n < 2; ++n) _Pragma("unroll") for (int k = 0; k < 2; ++k) dst[n][k] = *(const PG8_LAS bf16x8*)(lds + PG8_SB(b, h) + boff + n * 2048 + k * 1024); } while (0)
#define PG8_MMA(ai, bj, At, Bt) do { __builtin_amdgcn_s_setprio(1); _Pragma("unroll") for (int m = 0; m < 4; ++m) _Pragma("unroll") for (int n = 0; n < 2; ++n) _Pragma("unroll") for (int k = 0; k < 2; ++k) \
        acc[ai][bj][m][n] = __builtin_amdgcn_mfma_f32_16x16x32_bf16(Bt[n][k], At[m][k], acc[ai][bj][m][n], 0, 0, 0); __builtin_amdgcn_s_setprio(0); } while (0)
#define PG8_WAIT_V(n) asm volatile("s_waitcnt vmcnt(" #n ")" ::: "memory")
#define PG8_WAIT_L(n) asm volatile("s_waitcnt lgkmcnt(" #n ")" ::: "memory")
#define PG8_BAR __builtin_amdgcn_s_barrier()
#define PG8_SCHED __builtin_amdgcn_sched_barrier(0)
    UnitX cur, nxt; int ui = 0;
    if (!S.next(0, cur)) return;
    f32x4 acc[2][2][4][2];
#pragma unroll
    for (int a = 0; a < 2; ++a)
#pragma unroll
        for (int b = 0; b < 2; ++b)
#pragma unroll
            for (int m = 0; m < 4; ++m)
#pragma unroll
                for (int n = 0; n < 2; ++n) acc[a][b][m][n] = (f32x4){0.f, 0.f, 0.f, 0.f};
    bf16x8 At[4][2], B0[2][2], B1[2][2];
    GDesc dc = S.desc(cur.kind);
    int ksC = dc.ks; size_t hsC = (size_t)HALF * ksC * 2;
    unsigned vAc[2], vBc[2];
#pragma unroll
    for (int i = 0; i < 2; ++i) { int R, C; stage_rc(tid * 16 + i * 8192, R, C); const int Rb = (R & ~31) + perm32(R & 31);
        vAc[i] = (unsigned)(R * ksC + C) * 2u; vBc[i] = (unsigned)(Rb * ksC + C) * 2u; }
    int shC = 31 - __builtin_clz((unsigned)ksC * 2u);
    const char* cA = (const char*)dc.A + (size_t)cur.pm * 2 * hsC; const char* cB = (const char*)dc.Bt + (size_t)cur.pn * 2 * hsC;
    PG8_STAGE(PG8_SB(0, 0), cB, vBc); PG8_STAGE(PG8_SA(0, 0), cA, vAc); PG8_STAGE(PG8_SB(0, 1), cB + hsC, vBc); PG8_STAGE(PG8_SA(0, 1), cA + hsC, vAc);
    if (wr == 1) PG8_BAR;
    PG8_WAIT_V(4); PG8_BAR;
    PG8_STAGE(PG8_SB(1, 0), cB + kstep, vBc); PG8_STAGE(PG8_SA(1, 0), cA + kstep, vAc); PG8_STAGE(PG8_SB(1, 1), cB + hsC + kstep, vBc);
    PG8_WAIT_V(6); PG8_BAR;
    for (;;) {
        const bool has_next = S.next(ui + 1, nxt);
        const char* nA = cA; const char* nB = cB; int ksN = ksC; size_t hsN = hsC;
        if (has_next) { const GDesc dn = S.desc(nxt.kind); ksN = dn.ks; hsN = (size_t)HALF * ksN * 2;
            nA = (const char*)dn.A + (size_t)nxt.pm * 2 * hsN; nB = (const char*)dn.Bt + (size_t)nxt.pn * 2 * hsN; }
        const int shN = 31 - __builtin_clz((unsigned)ksN * 2u); const unsigned cmask = (unsigned)ksC * 2u - 1u;
        const int nt = ksC / BK;
        for (int t = 0; t < nt; t += 2) {
            const bool last = (t == nt - 2);
            const char* a1 = cA + (size_t)(t + 1) * kstep;
            const char* a2 = last ? nA : cA + (size_t)(t + 2) * kstep; const char* b2 = last ? nB : cB + (size_t)(t + 2) * kstep;
            const char* a3 = a2 + kstep; const char* b3 = b2 + kstep;
            const size_t hs2 = last ? hsN : hsC;
            unsigned vA2[2], vB2[2];
#pragma unroll
            for (int i = 0; i < 2; ++i) { vA2[i] = last ? (((vAc[i] >> shC) << shN) | (vAc[i] & cmask)) : vAc[i]; vB2[i] = last ? (((vBc[i] >> shC) << shN) | (vBc[i] & cmask)) : vBc[i]; }
            PG8_LDB(B0, 0, 0); PG8_SCHED; PG8_LDA(At, 0, 0); PG8_STAGE(PG8_SA(1, 1), a1 + hsC, vAc);
            PG8_WAIT_L(8); PG8_BAR; PG8_WAIT_L(0); PG8_MMA(0, 0, At, B0); PG8_BAR; PG8_SCHED;
            PG8_LDB(B1, 0, 1); PG8_STAGE(PG8_SB(0, 0), b2, vB2);
            PG8_BAR; PG8_WAIT_L(0); PG8_MMA(0, 1, At, B1); PG8_BAR;
            PG8_LDA(At, 0, 1); PG8_STAGE(PG8_SA(0, 0), a2, vA2);
            PG8_BAR; PG8_WAIT_L(0); PG8_MMA(1, 0, At, B0); PG8_BAR; PG8_SCHED;
            PG8_STAGE(PG8_SB(0, 1), b2 + hs2, vB2);
            PG8_WAIT_V(6); PG8_BAR; PG8_MMA(1, 1, At, B1); PG8_BAR;
            PG8_LDB(B0, 1, 0); PG8_SCHED; PG8_LDA(At, 1, 0); PG8_STAGE(PG8_SA(0, 1), a2 + hs2, vA2);
            PG8_WAIT_L(8); PG8_BAR; PG8_WAIT_L(0); PG8_MMA(0, 0, At, B0); PG8_BAR; PG8_SCHED;
            PG8_LDB(B1, 1, 1); PG8_STAGE(PG8_SB(1, 0), b3, vB2);
            PG8_BAR; PG8_WAIT_L(0); PG8_MMA(0, 1, At, B1); PG8_BAR;
            PG8_LDA(At, 1, 1); PG8_STAGE(PG8_SA(1, 0), a3, vA2);
            PG8_BAR; PG8_WAIT_L(0); PG8_MMA(1, 0, At, B0); PG8_BAR; PG8_SCHED;
            PG8_STAGE(PG8_SB(1, 1), b3 + hs2, vB2);
            PG8_WAIT_V(6); PG8_BAR; PG8_MMA(1, 1, At, B1); PG8_BAR;
        }
        E(acc, cur, wr, wc, fr, fq);
        if (!has_next) break;
#pragma unroll
        for (int a = 0; a < 2; ++a)
#pragma unroll
            for (int b = 0; b < 2; ++b)
#pragma unroll
                for (int m = 0; m < 4; ++m)
#pragma unroll
                    for (int n = 0; n < 2; ++n) acc[a][b][m][n] = (f32x4){0.f, 0.f, 0.f, 0.f};
#pragma unroll
        for (int i = 0; i < 2; ++i) { vAc[i] = ((vAc[i] >> shC) << shN) | (vAc[i] & cmask); vBc[i] = ((vBc[i] >> shC) << shN) | (vBc[i] & cmask); }
        cur = nxt; cA = nA; cB = nB; ksC = ksN; hsC = hsN; shC = shN; ++ui;
    }
    PG8_WAIT_V(0);
    if (wr == 0) PG8_BAR;
    PG8_BAR;
#undef PG8_SA
#undef PG8_SB
#undef PG8_STAGE
#undef PG8_LDA
#undef PG8_LDB
#undef PG8_MMA
#undef PG8_WAIT_V
#undef PG8_WAIT_L
#undef PG8_BAR
#undef PG8_SCHED
}
}
#define XB_TMO      128
#define XB_XCNT(j)  (256  + 64 * (j))
#define XB_XSUB(j)  (1280 + 64 * (j))
#define XB_XGEN(j)  (2304 + 64 * (j))
#define XB_TOP      3328
#define XB_TOPGEN   3392
#define XCD_BAR_WORDS 3456
#define XB_SPIN_CAP (1u << 18)
#define LAS __attribute__((address_space(3)))
__device__ __forceinline__ unsigned xb_ld(unsigned* p)              { return __hip_atomic_load(p, __ATOMIC_RELAXED, __HIP_MEMORY_SCOPE_AGENT); }
__device__ __forceinline__ unsigned xb_add(unsigned* p, unsigned v) { return __hip_atomic_fetch_add(p, v, __ATOMIC_RELAXED, __HIP_MEMORY_SCOPE_AGENT); }
__device__ __forceinline__ unsigned xb_xcc_id() { return (unsigned)__builtin_amdgcn_s_getreg((3 << 11) | 20) & 0xFu; }
#define XB_SPIN(cond, bar) do { unsigned _sp = 0; while (cond) { __builtin_amdgcn_s_sleep(1); \
    if ((++_sp & 255u) == 0u) { if (xb_ld(&(bar)[XB_TMO])) break; if (_sp > XB_SPIN_CAP) { atomicAdd(&(bar)[XB_TMO], 1u); break; } } } } while (0)

struct XcdBarrier {
    unsigned* bar; unsigned x;
    volatile LAS unsigned* st;
};

__device__ __forceinline__ XcdBarrier xcd_barrier_post(unsigned* bar, volatile LAS unsigned* st) {
    XcdBarrier b; b.bar = bar; b.x = xb_xcc_id(); b.st = st;
    if (threadIdx.x == 0) (void)xb_add(&bar[XB_XCNT(b.x)], 1u);
    return b;
}
__device__ __forceinline__ void xcd_barrier_complete(unsigned* bar, unsigned x, unsigned& nloc, unsigned& nx) {
    const unsigned G = gridDim.x * gridDim.y * gridDim.z;
    unsigned sum, cnt, mine, sp = 0u;
    for (;;) {
        sum = 0u; cnt = 0u; mine = 0u;
#pragma unroll
        for (unsigned j = 0; j < 16; ++j) { const unsigned c = xb_ld(&bar[XB_XCNT(j)]); sum += c; cnt += (c > 0u) ? 1u : 0u; mine = (j == x) ? c : mine; }
        if (sum == G) break;
        __builtin_amdgcn_s_sleep(1);
        if ((++sp & 255u) == 0u) { if (xb_ld(&bar[XB_TMO])) break; if (sp > XB_SPIN_CAP) { atomicAdd(&bar[XB_TMO], 1u); break; } }
    }
    nloc = mine > 0u ? mine : 1u; nx = cnt > 0u ? cnt : 1u;
}

template <class F> __device__ __forceinline__ void xcd_barrier(const XcdBarrier& b, F&& shadow) {
    asm volatile("s_waitcnt vmcnt(0)" ::: "memory");
    __syncthreads();
    if (threadIdx.x == 0) {
        unsigned* bar = b.bar;
        __builtin_amdgcn_s_waitcnt(0);
        unsigned nloc = b.st[0], nx = b.st[1];
        if (nloc == 0u) { xcd_barrier_complete(bar, b.x, nloc, nx); b.st[0] = nloc; b.st[1] = nx; }
        const unsigned old = xb_add(&bar[XB_XSUB(b.x)], 1u);
        const unsigned gen = old / nloc;
        if (old + 1u == (gen + 1u) * nloc) {
            __builtin_amdgcn_fence(__ATOMIC_RELEASE, "agent");
            asm volatile("s_waitcnt vmcnt(0)" ::: "memory");
            const unsigned og = xb_add(&bar[XB_TOP], 1u);
            const unsigned tg = og / nx;
            if (og + 1u == (tg + 1u) * nx) xb_add(&bar[XB_TOPGEN], 1u);
            else XB_SPIN(xb_ld(&bar[XB_TOPGEN]) == tg, bar);
            __builtin_amdgcn_fence(__ATOMIC_ACQUIRE, "agent");
            xb_add(&bar[XB_XGEN(b.x)], 1u);
            asm volatile("s_waitcnt vmcnt(0)" ::: "memory");
        } else {
            XB_SPIN(xb_ld(&bar[XB_XGEN(b.x)]) == gen, bar);
            __builtin_amdgcn_fence(__ATOMIC_ACQUIRE, "agent");
            asm volatile("s_waitcnt vmcnt(0)" ::: "memory");
        }
    } else if (threadIdx.x >= 64) shadow();
    __syncthreads();
}
using pg8::f32x4; using pg8::u32x4; using pg8::bf16_t; using pg8::Unit;
#define DI __device__ __forceinline__
constexpr int M_TOK = 16384, DM = 1024, SEQ = 2048, NPHASE = 10;
constexpr float EPS = 1e-6f;
constexpr int LDS_ST = 147456, LDS_BYTES = LDS_ST + 16;
constexpr size_t MiB = 1024 * 1024;
constexpr size_t OFF_WIN1 = 0, OFF_WAOUT = 4 * MiB, OFF_WPLE0 = 6 * MiB, OFF_WPLE1 = 6 * MiB + 512 * 1024, OFF_WG0 = 7 * MiB, OFF_WG1 = 9 * MiB,
                 OFF_WKQZ = 11 * MiB, OFF_WV = 17 * MiB, OFF_WBOUT = 19 * MiB, OFF_PB = 21 * MiB, OFF_R1 = 37 * MiB, OFF_R2 = 69 * MiB, OFF_R3 = 101 * MiB,
                 OFF_R4 = 133 * MiB, OFF_RSTD0 = 197 * MiB, OFF_RSTD1 = 197 * MiB + 65536, OFF_SSP = 197 * MiB + 131072, OFF_BAR = 199 * MiB, OFF_E1 = 200 * MiB, WS_END = 232 * MiB;

struct Params {
    const float *x, *p, *a_norm, *a_w_in, *a_w_group, *a_scale, *a_w_out, *kv_norm, *w_kv, *k_norm, *b_norm, *b_w_in, *b_q_norm, *b_w_out, *ple_w, *ple_gate_w;
    float* out; unsigned char* ws; int ph_lo, ph_hi;
};

typedef __bf16 bf16x2_t __attribute__((ext_vector_type(2)));
typedef float f32x2_t __attribute__((ext_vector_type(2)));
typedef unsigned u32x2_t __attribute__((ext_vector_type(2)));
typedef short s16x8 __attribute__((ext_vector_type(8)));
typedef short s16x4 __attribute__((ext_vector_type(4)));
typedef float f32x16 __attribute__((ext_vector_type(16)));
DI unsigned pk2(float lo, float hi) { f32x2_t v = {lo, hi}; bf16x2_t r = __builtin_convertvector(v, bf16x2_t); return __builtin_bit_cast(unsigned, r); }
DI float bflo(unsigned u) { return __uint_as_float(u << 16); }
DI float bfhi(unsigned u) { return __uint_as_float(u & 0xffff0000u); }
DI u32x4 pk8(f32x4 a, f32x4 b) { u32x4 w; w.x = pk2(a[0], a[1]); w.y = pk2(a[2], a[3]); w.z = pk2(b[0], b[1]); w.w = pk2(b[2], b[3]); return w; }
DI int xcd_affine_id() { const int G = (int)gridDim.x, w = (int)blockIdx.x; return (G & 7) ? w : (w & 7) * (G >> 3) + (w >> 3); }
DI float wave_sum(float v) {
#pragma unroll
    for (int o = 1; o < 64; o <<= 1) v += __shfl_xor(v, o);
    return v;
}
DI float sigm(float v) { return __builtin_amdgcn_rcpf(1.f + __expf(-v)); }
DI f32x4 silu4(f32x4 v) { f32x4 r; r[0] = v[0] * sigm(v[0]); r[1] = v[1] * sigm(v[1]); r[2] = v[2] * sigm(v[2]); r[3] = v[3] * sigm(v[3]); return r; }
DI f32x4 sigm4(f32x4 v) { f32x4 r; r[0] = sigm(v[0]); r[1] = sigm(v[1]); r[2] = sigm(v[2]); r[3] = sigm(v[3]); return r; }

typedef const f32x4 (&AccRef)[2][2][4][2];

struct Epi1 {
    static constexpr bool PERM = true, AFTER_DRAIN = false;
    bf16_t* ug; bf16_t* sz; const float* rstd0;
    DI void operator()(AccRef acc, const Unit& u, int wr, int wc, int fr, int fq) const {
        const int row0 = u.pm * 256 + wr * 64 + fr; const bool isz = u.pn >= 4;
        bf16_t* base = (isz ? sz : ug) + (u.pn & 3) * 256 + wc * 32 + 8 * fq;
        float rsv[2][4];
#pragma unroll
        for (int ai = 0; ai < 2; ++ai)
#pragma unroll
            for (int m = 0; m < 4; ++m) rsv[ai][m] = rstd0[row0 + ai * 128 + m * 16];
#pragma unroll
        for (int ai = 0; ai < 2; ++ai)
#pragma unroll
            for (int m = 0; m < 4; ++m) { const int row = row0 + ai * 128 + m * 16; const float rs = rsv[ai][m]; bf16_t* rowp = base + (size_t)row * DM;
#pragma unroll
                for (int bj = 0; bj < 2; ++bj) { f32x4 v0 = acc[ai][bj][m][0] * rs, v1 = acc[ai][bj][m][1] * rs;
                    if (isz) { v0 = silu4(v0); v1 = silu4(v1); }
                    *(u32x4*)(rowp + bj * 128) = pk8(v0, v1); } }
    }
};
struct EpiE {
    static constexpr bool PERM = true, AFTER_DRAIN = false;
    bf16_t* e;
    DI void operator()(AccRef acc, const Unit& u, int wr, int wc, int fr, int fq) const {
        const int row0 = u.pm * 256 + wr * 64 + fr; bf16_t* base = e + u.pn * 256 + wc * 32 + 8 * fq;
#pragma unroll
        for (int ai = 0; ai < 2; ++ai)
#pragma unroll
            for (int m = 0; m < 4; ++m) { bf16_t* rowp = base + (size_t)(row0 + ai * 128 + m * 16) * DM;
#pragma unroll
                for (int bj = 0; bj < 2; ++bj) *(u32x4*)(rowp + bj * 128) = pk8(acc[ai][bj][m][0], acc[ai][bj][m][1]); }
    }
};
DI void unpk8(const u32x4 q, f32x4& lo, f32x4& hi) { lo = (f32x4){bflo(q.x), bfhi(q.x), bflo(q.y), bfhi(q.y)}; hi = (f32x4){bflo(q.z), bfhi(q.z), bflo(q.w), bfhi(q.w)}; }
template <bool SRCF32> struct EpiResB {
    static constexpr bool PERM = true, AFTER_DRAIN = false;
    const float* srcf; const bf16_t* srcb; bf16_t* xb;
    DI void operator()(AccRef acc, const Unit& u, int wr, int wc, int fr, int fq) const {
        const int row0 = u.pm * 256 + wr * 64 + fr, col0 = u.pn * 256 + wc * 32 + 8 * fq;
#pragma unroll
        for (int ai = 0; ai < 2; ++ai) {
            f32x4 a[4][2][2];
#pragma unroll
            for (int m = 0; m < 4; ++m) { const size_t o = (size_t)(row0 + ai * 128 + m * 16) * DM + col0;
#pragma unroll
                for (int bj = 0; bj < 2; ++bj) {
                    if (SRCF32) { a[m][bj][0] = __builtin_nontemporal_load((const f32x4*)(srcf + o + bj * 128)); a[m][bj][1] = __builtin_nontemporal_load((const f32x4*)(srcf + o + bj * 128 + 4)); }
                    else { const u32x4 q = *(const u32x4*)(srcb + o + bj * 128); unpk8(q, a[m][bj][0], a[m][bj][1]); } } }
#pragma unroll
            for (int m = 0; m < 4; ++m) { const size_t o = (size_t)(row0 + ai * 128 + m * 16) * DM + col0;
#pragma unroll
                for (int bj = 0; bj < 2; ++bj) *(u32x4*)(xb + o + bj * 128) = pk8(a[m][bj][0] + acc[ai][bj][m][0], a[m][bj][1] + acc[ai][bj][m][1]); }
        }
    }
};
template <bool NEXT> struct EpiGate {
    static constexpr bool PERM = true, AFTER_DRAIN = false;
    const bf16_t* xin; const bf16_t* e; bf16_t* xb; float* ssp; float* outf;
    DI void operator()(AccRef acc, const Unit& u, int wr, int wc, int fr, int fq) const {
        const int row0 = u.pm * 256 + wr * 64 + fr, col0 = u.pn * 256 + wc * 32 + 8 * fq;
#pragma unroll
        for (int ai = 0; ai < 2; ++ai) {
            u32x4 xv[4][2], ev[4][2];
#pragma unroll
            for (int m = 0; m < 4; ++m) { const size_t o = (size_t)(row0 + ai * 128 + m * 16) * DM + col0;
#pragma unroll
                for (int bj = 0; bj < 2; ++bj) { xv[m][bj] = *(const u32x4*)(xin + o + bj * 128); ev[m][bj] = *(const u32x4*)(e + o + bj * 128); } }
#pragma unroll
            for (int m = 0; m < 4; ++m) { const int row = row0 + ai * 128 + m * 16; const size_t o = (size_t)row * DM + col0; float ss = 0.f;
#pragma unroll
                for (int bj = 0; bj < 2; ++bj) { f32x4 a0, a1, e0, e1; unpk8(xv[m][bj], a0, a1); unpk8(ev[m][bj], e0, e1);
                    const f32x4 v0 = a0 + e0 * sigm4(acc[ai][bj][m][0]), v1 = a1 + e1 * sigm4(acc[ai][bj][m][1]);
                    if (NEXT) { *(u32x4*)(xb + o + bj * 128) = pk8(v0, v1);
                        ss += (v0[0] * v0[0] + v0[1] * v0[1]) + (v0[2] * v0[2] + v0[3] * v0[3]) + (v1[0] * v1[0] + v1[1] * v1[1]) + (v1[2] * v1[2] + v1[3] * v1[3]); }
                    else { __builtin_nontemporal_store(v0, (f32x4*)(outf + o + bj * 128)); __builtin_nontemporal_store(v1, (f32x4*)(outf + o + bj * 128 + 4)); } }
                if (NEXT) { ss += __shfl_xor(ss, 16); ss += __shfl_xor(ss, 32); if (fq == 0) atomicAdd(ssp + row, ss); } }
        }
    }
};
struct EpiKQZ {
    static constexpr bool PERM = true, AFTER_DRAIN = false;
    bf16_t *kk, *qq, *sz2; const float *rstd1, *k_norm, *q_norm;
    DI void operator()(AccRef acc, const Unit& u, int wr, int wc, int fr, int fq) const {
        const int row0 = u.pm * 256 + wr * 64 + fr, kind = u.pn >> 2, pq = u.pn & 3;
        float rsv[2][4];
#pragma unroll
        for (int ai = 0; ai < 2; ++ai)
#pragma unroll
            for (int m = 0; m < 4; ++m) rsv[ai][m] = rstd1[row0 + ai * 128 + m * 16];
        if (kind == 2) {
            bf16_t* base = sz2 + pq * 256 + 64 * wc + 8 * fq;
#pragma unroll
            for (int ai = 0; ai < 2; ++ai)
#pragma unroll
                for (int m = 0; m < 4; ++m) { const int row = row0 + ai * 128 + m * 16; const float rs = rsqrtf(rsv[ai][m] * (1.f / DM) + EPS); bf16_t* rowp = base + (size_t)row * DM;
#pragma unroll
                    for (int bj = 0; bj < 2; ++bj) *(u32x4*)(rowp + bj * 32) = pk8(silu4(acc[ai][bj][m][0] * rs), silu4(acc[ai][bj][m][1] * rs)); }
        } else {
            const float* gn = kind ? q_norm : k_norm; const float mul = kind ? 0.125f * 1.4426950408889634f : 1.f;
            bf16_t* dst = kind ? qq : kk; const int head = pq * 4 + wc;
            f32x4 g[2][2];
#pragma unroll
            for (int bj = 0; bj < 2; ++bj)
#pragma unroll
                for (int n = 0; n < 2; ++n) g[bj][n] = *(const f32x4*)(gn + 32 * bj + 8 * fq + 4 * n) * mul;
#pragma unroll
            for (int ai = 0; ai < 2; ++ai)
#pragma unroll
                for (int m = 0; m < 4; ++m) { const int row = row0 + ai * 128 + m * 16; const float rs = rsqrtf(rsv[ai][m] * (1.f / DM) + EPS); const int b = row >> 11, s = row & 2047;
                    f32x4 v[2][2]; float ss = 0.f;
#pragma unroll
                    for (int bj = 0; bj < 2; ++bj)
#pragma unroll
                        for (int n = 0; n < 2; ++n) { v[bj][n] = acc[ai][bj][m][n] * rs; ss += (v[bj][n][0] * v[bj][n][0] + v[bj][n][1] * v[bj][n][1]) + (v[bj][n][2] * v[bj][n][2] + v[bj][n][3] * v[bj][n][3]); }
                    ss += __shfl_xor(ss, 16); ss += __shfl_xor(ss, 32);
                    const float hr = rsqrtf(ss * (1.f / 64.f) + EPS);
                    bf16_t* rowp = dst + ((size_t)(b * 16 + head) * SEQ + s) * 64 + 8 * fq;
#pragma unroll
                    for (int bj = 0; bj < 2; ++bj) *(u32x4*)(rowp + 32 * bj) = pk8(v[bj][0] * hr * g[bj][0], v[bj][1] * hr * g[bj][1]); }
        }
    }
};
struct EpiVT {
    static constexpr bool PERM = true, AFTER_DRAIN = false;
    bf16_t* vt; const float* rstd1;
    DI void operator()(AccRef acc, const Unit& u, int wr, int wc, int fr, int fq) const {
        const int c0 = u.pm * 256 + wr * 64 + fr, tok0 = u.pn * 256 + wc * 32 + 8 * fq;
        f32x4 rs[2][2];
#pragma unroll
        for (int bj = 0; bj < 2; ++bj)
#pragma unroll
            for (int n = 0; n < 2; ++n) { const f32x4 q = *(const f32x4*)(rstd1 + tok0 + 128 * bj + 4 * n);
#pragma unroll
                for (int j = 0; j < 4; ++j) rs[bj][n][j] = rsqrtf(q[j] * (1.f / DM) + EPS); }
#pragma unroll
        for (int ai = 0; ai < 2; ++ai)
#pragma unroll
            for (int m = 0; m < 4; ++m) { const int c = c0 + ai * 128 + m * 16;
#pragma unroll
                for (int bj = 0; bj < 2; ++bj) { const int tok = tok0 + 128 * bj, b = tok >> 11, s = tok & 2047;
                    *(u32x4*)(vt + ((size_t)b * DM + c) * SEQ + s) = pk8(acc[ai][bj][m][0] * rs[bj][0], acc[ai][bj][m][1] * rs[bj][1]); } }
    }
};
template <class Epi> DI void run_gemm(PG8_LAS unsigned char* lds, const bf16_t* A, const bf16_t* Bt, int M, int N, int K, const Epi& E) {
    pg8::Gemm g{A, Bt, M, N, K}; pg8::StaticOrder S; S.init(M, N, (int)gridDim.x, (int)blockIdx.x);
    pg8::gemm_phase<Epi, pg8::StaticOrder, false>(lds, g, S, E, nullptr);
}

struct SchedPG {
    const unsigned char* ws; int layer, G, c;
    DI bool next(int i, pg8::UnitX& u) const { const int L = i * G + c; if (L >= 512) return false;
        pg8::map_unit(L & 255, 64, 4, u.pm, u.pn); u.kind = L >> 8; return true; }
    DI pg8::GDesc desc(int k) const { pg8::GDesc d;
        const size_t oa = k == 0 ? OFF_PB + (size_t)layer * M_TOK * 256 * 2 : OFF_R2, ob = k == 0 ? (layer ? OFF_WPLE1 : OFF_WPLE0) : (layer ? OFF_WG1 : OFF_WG0);
        d.A = (const bf16_t*)(ws + oa); d.Bt = (const bf16_t*)(ws + ob); d.ks = k == 0 ? 256 : 1024; return d; }
    DI void a_ready(const pg8::UnitX&) const {}
    DI void done(const pg8::UnitX&) const {}
};
template <bool NEXT> struct EpiPG {
    static constexpr bool PERM = true;
    EpiE e; EpiGate<NEXT> g;
    DI void operator()(AccRef acc, const pg8::UnitX& u, int wr, int wc, int fr, int fq) const { const Unit uu{u.pm, u.pn};
        if (u.kind == 0) e(acc, uu, wr, wc, fr, fq); else g(acc, uu, wr, wc, fr, fq); }
};
struct SchedP6 {
    const unsigned char* ws; int G, c;
    DI bool next(int i, pg8::UnitX& u) const { const int L = i * G + c; if (L >= 1024) return false;
        if (L < 768) { pg8::map_unit(L, 64, 12, u.pm, u.pn); u.kind = 0; } else { pg8::map_unit(L - 768, 4, 64, u.pm, u.pn); u.kind = 1; }
        return true; }
    DI pg8::GDesc desc(int k) const { pg8::GDesc d; d.A = (const bf16_t*)(ws + (k == 0 ? OFF_R3 : OFF_WV)); d.Bt = (const bf16_t*)(ws + (k == 0 ? OFF_WKQZ : OFF_R3)); d.ks = 1024; return d; }
};
struct EpiP6 {
    static constexpr bool PERM = true;
    EpiKQZ a; EpiVT b;
    DI void operator()(AccRef acc, const pg8::UnitX& u, int wr, int wc, int fr, int fq) const { const Unit uu{u.pm, u.pn};
        if (u.kind == 0) a(acc, uu, wr, wc, fr, fq); else b(acc, uu, wr, wc, fr, fq); }
};

DI int headperm(int cl) { const int o = cl & 255, wc = o >> 6, bj = (o >> 5) & 1, r = o & 31; return (cl & ~255) + 128 * bj + 32 * wc + r; }
DI void transpose_item(float* scr, const float* src, int ld, int K, int nT, const float* gain, bf16_t* dst, int rowoff, bool perm, int item, int lane) {
    const int kt = item / nT, nt = item - kt * nT, k0 = kt * 64, n0 = nt * 32, lr = lane >> 3, lc = lane & 7;
    float4 v[8];
#pragma unroll
    for (int i = 0; i < 8; ++i) v[i] = *(const float4*)(src + (size_t)(k0 + i * 8 + lr) * ld + n0 + lc * 4);
    float gk[8];
#pragma unroll
    for (int i = 0; i < 8; ++i) gk[i] = gain ? gain[k0 + 8 * lc + i] : 1.f;
#pragma unroll
    for (int i = 0; i < 8; ++i) { float* t = scr + (i * 8 + lr) * 33 + lc * 4; t[0] = v[i].x; t[1] = v[i].y; t[2] = v[i].z; t[3] = v[i].w; }
    asm volatile("s_waitcnt lgkmcnt(0)" ::: "memory");
#pragma unroll
    for (int j = 0; j < 4; ++j) { const int n = lr + 8 * j; const float* t = scr + (8 * lc) * 33 + n;
        int row = rowoff + n0 + n; if (perm) row = headperm(row);
        u32x4 w; w.x = pk2(t[0] * gk[0], t[33] * gk[1]); w.y = pk2(t[66] * gk[2], t[99] * gk[3]); w.z = pk2(t[132] * gk[4], t[165] * gk[5]); w.w = pk2(t[198] * gk[6], t[231] * gk[7]);
        *(u32x4*)(dst + (size_t)row * K + k0 + 8 * lc) = w; }
    asm volatile("s_waitcnt lgkmcnt(0)" ::: "memory");
}
DI void weff_job(float* L, const Params& P, bf16_t* dst, int job) {
    float* As = L; float* Bs = L + 64 * 129;
    const int tid = threadIdx.x, k0 = (job >> 4) * 64, n0 = (job & 15) * 64, g = n0 >> 8, d0 = n0 & 255, kk = tid >> 3, dg = tid & 7;
    float acc[8];
#pragma unroll
    for (int j = 0; j < 8; ++j) acc[j] = 0.f;
    for (int c0 = 0; c0 < 256; c0 += 128) {
        __syncthreads();
#pragma unroll
        for (int i = 0; i < 4; ++i) { const int idx = tid + 512 * i;
            { const int r = idx >> 5, c4 = idx & 31; const float4 v = *(const float4*)(P.a_w_in + (size_t)(k0 + r) * 2048 + g * 256 + c0 + c4 * 4);
              float* t = As + r * 129 + c4 * 4; t[0] = v.x; t[1] = v.y; t[2] = v.z; t[3] = v.w; }
            { const int cc = idx >> 4, d4 = idx & 15; *(float4*)(Bs + cc * 64 + d4 * 4) = *(const float4*)(P.a_w_group + (size_t)(g * 256 + c0 + cc) * 256 + d0 + d4 * 4); } }
        __syncthreads();
#pragma unroll 4
        for (int c = 0; c < 128; ++c) { const float a = As[kk * 129 + c]; const float4 b0 = *(const float4*)(Bs + c * 64 + dg * 8), b1 = *(const float4*)(Bs + c * 64 + dg * 8 + 4);
            acc[0] += a * b0.x; acc[1] += a * b0.y; acc[2] += a * b0.z; acc[3] += a * b0.w; acc[4] += a * b1.x; acc[5] += a * b1.y; acc[6] += a * b1.z; acc[7] += a * b1.w; }
    }
    const float an = P.a_norm[k0 + kk];
#pragma unroll
    for (int j = 0; j < 8; ++j) { const int n = n0 + dg * 8 + j; const float v = acc[j] * an * P.a_scale[n];
        dst[(size_t)n * DM + k0 + kk] = (bf16_t)(pk2(v, v) & 0xffffu); }
}
DI void shadow_p_convert(const Params& P, int half) {
    const float4* pp = (const float4*)P.p; u32x4* pb = (u32x4*)(P.ws + OFF_PB);
    const int HALFCH = M_TOK * 256 / 8, step = gridDim.x * 448, base = half * HALFCH;
    for (int i = blockIdx.x * 448 + ((int)threadIdx.x - 64); i < HALFCH; i += 5 * step) { float4 a[5], b[5];
#pragma unroll
        for (int q = 0; q < 5; ++q) if (i + q * step < HALFCH) { a[q] = pp[2 * (base + i + q * step)]; b[q] = pp[2 * (base + i + q * step) + 1]; }
#pragma unroll
        for (int q = 0; q < 5; ++q) if (i + q * step < HALFCH) { u32x4 u; u.x = pk2(a[q].x, a[q].y); u.y = pk2(a[q].z, a[q].w); u.z = pk2(b[q].x, b[q].y); u.w = pk2(b[q].z, b[q].w); pb[base + i + q * step] = u; } }
}
DI void deferred_items(const Params& P, float* L, int seam) {
    const int wid = threadIdx.x >> 6, lane = threadIdx.x & 63; unsigned char* ws = P.ws; float* scr = L + wid * (64 * 33);
    const int nitems = (seam == 0) ? 1792 : 2560;
    for (int t = blockIdx.x * 7 + (wid - 1); t < nitems; t += gridDim.x * 7) {
        if (seam == 0) {
            if (t < 512) transpose_item(scr, P.a_w_out, 1024, 1024, 32, nullptr, (bf16_t*)(ws + OFF_WAOUT), 0, false, t, lane);
            else if (t < 640) transpose_item(scr, P.ple_w, 1024, 256, 32, nullptr, (bf16_t*)(ws + OFF_WPLE0), 0, false, t - 512, lane);
            else if (t < 768) transpose_item(scr, P.ple_w + 256 * 1024, 1024, 256, 32, nullptr, (bf16_t*)(ws + OFF_WPLE1), 0, false, t - 640, lane);
            else if (t < 1280) transpose_item(scr, P.w_kv, 2048, 1024, 32, P.kv_norm, (bf16_t*)(ws + OFF_WKQZ), 0, true, t - 768, lane);
            else transpose_item(scr, P.w_kv + 1024, 2048, 1024, 32, P.kv_norm, (bf16_t*)(ws + OFF_WV), 0, false, t - 1280, lane);
        } else {
            if (t < 512) transpose_item(scr, P.ple_gate_w, 1024, 1024, 32, nullptr, (bf16_t*)(ws + OFF_WG0), 0, false, t, lane);
            else if (t < 1536) transpose_item(scr, P.b_w_in, 2048, 1024, 64, P.b_norm, (bf16_t*)(ws + OFF_WKQZ), 1024, true, t - 512, lane);
            else if (t < 2048) transpose_item(scr, P.b_w_out, 1024, 1024, 32, nullptr, (bf16_t*)(ws + OFF_WBOUT), 0, false, t - 1536, lane);
            else transpose_item(scr, P.ple_gate_w + 1024 * 1024, 1024, 1024, 32, nullptr, (bf16_t*)(ws + OFF_WG1), 0, false, t - 2048, lane);
        }
    }
    shadow_p_convert(P, seam);
}
struct GrpBarrier { unsigned* cnt; unsigned* gen; unsigned* tmo; unsigned nmem; };
DI void grp_barrier(const GrpBarrier& gb) {
    asm volatile("s_waitcnt vmcnt(0)" ::: "memory");
    __syncthreads();
    if (threadIdx.x == 0) {
        const unsigned old = xb_add(gb.cnt, 1u), g = old / gb.nmem;
        if (old + 1u == (g + 1u) * gb.nmem) xb_add(gb.gen, 1u);
        else XB_SPIN(xb_ld(gb.gen) == g, gb.tmo - XB_TMO);
        __builtin_amdgcn_fence(__ATOMIC_ACQUIRE, "agent");
        asm volatile("s_waitcnt vmcnt(0)" ::: "memory");
    }
    __syncthreads();
}
DI void phase0(const Params& P, float* L) {
    const int tid = threadIdx.x, wid = tid >> 6, lane = tid & 63, w = blockIdx.x, G = gridDim.x;
    unsigned char* ws = P.ws;
    { float* ss1 = (float*)(ws + OFF_RSTD1); for (int i = w * 512 + tid; i < M_TOK; i += G * 512) ss1[i] = 0.f; }
    if ((w & 1) == 0) { for (int job = w; job < 256; job += G) weff_job(L, P, (bf16_t*)(ws + OFF_WIN1), job); __syncthreads(); }
    { float* scr = L + wid * (64 * 33);
      for (int t = w * 8 + wid; t < 512; t += G * 8) transpose_item(scr, P.a_w_in + 1024, 2048, 1024, 32, P.a_norm, (bf16_t*)(ws + OFF_WIN1) + (size_t)1024 * 1024, 0, false, t, lane); }
    { bf16_t* xb = (bf16_t*)(ws + OFF_R1); float* rstd0 = (float*)(ws + OFF_RSTD0);
      for (int row = (xcd_affine_id() * 8 + wid) * 8; row < M_TOK; row += G * 64) {
          float4 v[8][4];
#pragma unroll
          for (int q = 0; q < 8; ++q)
#pragma unroll
              for (int j = 0; j < 4; ++j) v[q][j] = ((const float4*)(P.x + (size_t)(row + q) * DM) + lane)[64 * j];
#pragma unroll
          for (int q = 0; q < 8; ++q) { float s = 0.f;
#pragma unroll
              for (int j = 0; j < 4; ++j) s += (v[q][j].x * v[q][j].x + v[q][j].y * v[q][j].y) + (v[q][j].z * v[q][j].z + v[q][j].w * v[q][j].w);
              s = wave_sum(s);
              uint2* o = (uint2*)(xb + (size_t)(row + q) * DM) + lane;
#pragma unroll
              for (int j = 0; j < 4; ++j) { uint2 u; u.x = pk2(v[q][j].x, v[q][j].y); u.y = pk2(v[q][j].z, v[q][j].w); o[64 * j] = u; }
              if (lane == 0) rstd0[row + q] = rsqrtf(s * (1.f / DM) + EPS); } } }
    if ((w & 1) != 0) { __syncthreads(); for (int job = w; job < 256; job += G) weff_job(L, P, (bf16_t*)(ws + OFF_WIN1), job); }
}
DI void unpack8(const u32x4 q, float (&f)[8]) { f[0] = bflo(q.x); f[1] = bfhi(q.x); f[2] = bflo(q.y); f[3] = bfhi(q.y); f[4] = bflo(q.z); f[5] = bfhi(q.z); f[6] = bflo(q.w); f[7] = bfhi(q.w); }
DI void pool_phase(const Params& P) {
    const bf16_t* ug = (const bf16_t*)(P.ws + OFF_R2); const bf16_t* sz = (const bf16_t*)(P.ws + OFF_R3); bf16_t* Gd = (bf16_t*)(P.ws + OFF_R1);
    const int nth = gridDim.x * 512;
    for (int idx = xcd_affine_id() * 512 + threadIdx.x; idx < 131072; idx += nth) {
        const int chunk = idx & 127, run = idx >> 7, row0 = run * 16, t0 = row0 & (SEQ - 1), c0 = chunk * 8, wlen = 2 << (chunk >> 5);
        const u32x4* up = (const u32x4*)(ug + (size_t)row0 * DM + c0); const u32x4* zp = (const u32x4*)(sz + (size_t)row0 * DM + c0); u32x4* gp = (u32x4*)(Gd + (size_t)row0 * DM + c0);
        float s[8], c[8], z[8];
#pragma unroll
        for (int j = 0; j < 8; ++j) s[j] = 0.f;
        { const bool hist = t0 > 0;
#pragma unroll
          for (int j = 1; j <= 16; ++j) {
              const int jj = hist ? (j <= wlen ? j : wlen) : 0; const float mk = (hist && j <= wlen) ? 1.f : 0.f;
              unpack8(up[-(jj * 128)], c);
#pragma unroll
              for (int q = 0; q < 8; ++q) s[q] += mk * c[q]; } }
        const float inv_full = 1.f / (float)wlen;
#pragma unroll 4
        for (int rr = 0; rr < 16; ++rr) {
            const int t = t0 + rr;
            if (t >= wlen) { unpack8(up[(rr - wlen) * 128], c);
#pragma unroll
                for (int q = 0; q < 8; ++q) s[q] -= c[q]; }
            unpack8(up[rr * 128], c); unpack8(zp[rr * 128], z);
            const float inv = (t + 1 < wlen) ? 1.f / (float)(t + 1) : inv_full;
            float o[8];
#pragma unroll
            for (int q = 0; q < 8; ++q) { s[q] += c[q]; o[q] = (s[q] * inv - c[q]) * z[q]; }
            u32x4 w; w.x = pk2(o[0], o[1]); w.y = pk2(o[2], o[3]); w.z = pk2(o[4], o[5]); w.w = pk2(o[6], o[7]); gp[rr * 128] = w;
        }
    }
}
#define MFMA32(a, b, c) __builtin_amdgcn_mfma_f32_32x32x16_bf16((a), (b), (c), 0, 0, 0)
DI void attn_phase(const Params& P, PG8_LAS unsigned char* lds) {
    constexpr int HIST = 128, WIN = 384, KP = 144, VP = 776, NF = 6, VCH = 48;
    PG8_LAS unsigned char* Kl = lds; PG8_LAS unsigned char* Vl = lds + WIN * KP;
    const bf16_t* kk = (const bf16_t*)(P.ws + OFF_R1); const bf16_t* qq = (const bf16_t*)(P.ws + OFF_R2); const bf16_t* vt = (const bf16_t*)(P.ws + OFF_R4);
    const bf16_t* sz2 = (const bf16_t*)(P.ws + OFF_R4 + 32 * MiB); bf16_t* g2 = (bf16_t*)P.out;
    const int tid = threadIdx.x, wid = tid >> 6, lane = tid & 63, r = lane & 31, hh = lane >> 5;
#define ATT_LOAD_FILL(IT, KV, VV) do { const int _bh = (IT) >> 3, _wlo = ((IT) & 7) * 256 - HIST; const bf16_t* _Kg = kk + (size_t)_bh * SEQ * 64; const bf16_t* _Vg = vt + (size_t)_bh * 64 * SEQ; \
        _Pragma("unroll") for (int i = 0; i < NF; ++i) { const int c = tid + 512 * i, row = c >> 3, part = c & 7, key = _wlo + row; if (key >= 0) KV[i] = *(const u32x4*)(_Kg + (size_t)key * 64 + part * 8); } \
        _Pragma("unroll") for (int i = 0; i < NF; ++i) { const int c = tid + 512 * i, d = c / VCH, part = c - d * VCH, key0 = _wlo + part * 8; if (key0 >= 0) VV[i] = *(const u32x4*)(_Vg + (size_t)d * SEQ + key0); } } while (0)
#define ATT_LOAD_Q(IT, QF) do { const bf16_t* _Qp = qq + ((size_t)((IT) >> 3) * SEQ + ((IT) & 7) * 256 + 32 * wid + r) * 64 + hh * 8; \
        _Pragma("unroll") for (int ks = 0; ks < 4; ++ks) QF[ks] = *(const s16x8*)(_Qp + ks * 16); } while (0)
    u32x4 kv[NF], vv[NF];
    const bool aff = (gridDim.x & 7) == 0; const int islot0 = aff ? (int)(blockIdx.x >> 3) : (int)blockIdx.x, istep = aff ? (int)(gridDim.x >> 3) : (int)gridDim.x, ibase = aff ? (int)(blockIdx.x & 7) * 128 : 0, ilim = aff ? 128 : 1024;
    if (islot0 < ilim) { ATT_LOAD_FILL(ibase + islot0, kv, vv); }
    for (int islot = islot0; islot < ilim; islot += istep) {
        const int item = ibase + islot;
        const int qc = item & 7, bh = item >> 3, t0 = qc * 256, wlo = t0 - HIST, tq = t0 + 32 * wid;
        const bf16_t* Kg = kk + (size_t)bh * SEQ * 64; const bf16_t* Vg = vt + (size_t)bh * 64 * SEQ;
        const int b = bh >> 4, h = bh & 15; const size_t rowo = ((size_t)b * SEQ + tq + r) * DM + h * 64 + 4 * hh;
        asm volatile("s_waitcnt lgkmcnt(0)" ::: "memory"); __builtin_amdgcn_s_barrier(); asm volatile("" ::: "memory");
#pragma unroll
        for (int i = 0; i < NF; ++i) { const int c = tid + 512 * i, row = c >> 3, part = c & 7, key = wlo + row;
            if (key >= 0) *(PG8_LAS u32x4*)(Kl + row * KP + part * 16) = kv[i]; }
#pragma unroll
        for (int i = 0; i < NF; ++i) { const int c = tid + 512 * i, d = c / VCH, part = c - d * VCH, key0 = wlo + part * 8;
            if (key0 >= 0) { PG8_LAS u32x2_t* w = (PG8_LAS u32x2_t*)(Vl + d * VP + part * 16); u32x2_t a = {vv[i].x, vv[i].y}, bb = {vv[i].z, vv[i].w}; w[0] = a; w[1] = bb; } }
        s16x8 qf[4]; ATT_LOAD_Q(item, qf);
        asm volatile("s_waitcnt lgkmcnt(0)" ::: "memory"); __builtin_amdgcn_s_barrier(); asm volatile("" ::: "memory");
        const size_t rowc = ((size_t)b * SEQ + tq + (lane >> 3)) * DM + h * 64 + (lane & 7) * 8;
        u32x4 zc[4];
#pragma unroll
        for (int i = 0; i < 4; ++i) zc[i] = *(const u32x4*)(sz2 + rowc + (size_t)(8 * i) * DM);
        const int nitem = (islot + istep < ilim) ? item + istep : 1024;
        u32x4 kvn[NF], vvn[NF];
        if (nitem < 1024) { ATT_LOAD_FILL(nitem, kvn, vvn); }
        f32x16 o0, o1;
#pragma unroll
        for (int i = 0; i < 16; ++i) { o0[i] = 0.f; o1[i] = 0.f; }
        float carry = 1.f;
        for (int s0 = tq; s0 >= 0; s0 -= 32) {
            s16x8 kf[4]; s16x4 vf[2][2][2];
            if (s0 >= wlo) {
                PG8_LAS const unsigned char* kp = Kl + (s0 - wlo + r) * KP + hh * 16; PG8_LAS const unsigned char* vp = Vl + r * VP + (s0 - wlo + 4 * hh) * 2;
#pragma unroll
                for (int ks = 0; ks < 4; ++ks) kf[ks] = *(PG8_LAS const s16x8*)(kp + ks * 32);
#pragma unroll
                for (int dt = 0; dt < 2; ++dt)
#pragma unroll
                    for (int s = 0; s < 2; ++s)
#pragma unroll
                        for (int pt = 0; pt < 2; ++pt) vf[dt][s][pt] = *(PG8_LAS const s16x4*)(vp + dt * 32 * VP + (16 * s + 8 * pt) * 2);
            } else {
                const bf16_t* kp = Kg + (size_t)(s0 + r) * 64 + hh * 8; const bf16_t* vp = Vg + (size_t)r * SEQ + s0 + 4 * hh;
#pragma unroll
                for (int ks = 0; ks < 4; ++ks) kf[ks] = *(const s16x8*)(kp + ks * 16);
#pragma unroll
                for (int dt = 0; dt < 2; ++dt)
#pragma unroll
                    for (int s = 0; s < 2; ++s)
#pragma unroll
                        for (int pt = 0; pt < 2; ++pt) vf[dt][s][pt] = *(const s16x4*)(vp + (size_t)dt * 32 * SEQ + 16 * s + 8 * pt);
            }
            f32x16 x;
#pragma unroll
            for (int i = 0; i < 16; ++i) x[i] = 0.f;
#pragma unroll
            for (int ks = 0; ks < 4; ++ks) x = MFMA32(kf[ks], qf[ks], x);
            float beta[16], keep[16];
            const bool diag = (s0 == tq);
#pragma unroll
            for (int i = 0; i < 16; ++i) {
                const float l = fmaxf(x[i], -120.f);
                const float e = __builtin_amdgcn_exp2f(-l);
                float bt = __builtin_amdgcn_rcpf(1.f + e), kp = e * bt;
                beta[i] = bt; keep[i] = kp;
            }
            if (diag) {
#pragma unroll
                for (int i = 0; i < 16; ++i) { const bool valid = ((i & 3) + 8 * (i >> 2) + 4 * hh) < r; beta[i] = valid ? beta[i] : 0.f; keep[i] = valid ? keep[i] : 1.f; }
            }
            float Gp[4], PG[4];
#pragma unroll
            for (int g = 0; g < 4; ++g) { Gp[g] = (keep[4 * g] * keep[4 * g + 1]) * (keep[4 * g + 2] * keep[4 * g + 3]); PG[g] = __shfl_xor(Gp[g], 32); }
            float base[4];
            { float so = 1.f, sp = 1.f;
#pragma unroll
              for (int g = 3; g >= 0; --g) { base[g] = carry * so * sp * (hh == 0 ? PG[g] : 1.f); so *= Gp[g]; sp *= PG[g]; }
              carry = carry * so * sp; }
            float a[16];
#pragma unroll
            for (int g = 0; g < 4; ++g) { float run = base[g];
                a[4 * g + 3] = beta[4 * g + 3] * run; run *= keep[4 * g + 3];
                a[4 * g + 2] = beta[4 * g + 2] * run; run *= keep[4 * g + 2];
                a[4 * g + 1] = beta[4 * g + 1] * run; run *= keep[4 * g + 1];
                a[4 * g] = beta[4 * g] * run; }
#pragma unroll
            for (int s = 0; s < 2; ++s) {
                u32x4 pw; pw.x = pk2(a[8 * s], a[8 * s + 1]); pw.y = pk2(a[8 * s + 2], a[8 * s + 3]); pw.z = pk2(a[8 * s + 4], a[8 * s + 5]); pw.w = pk2(a[8 * s + 6], a[8 * s + 7]);
                const s16x8 pf = __builtin_bit_cast(s16x8, pw);
                const s16x8 va = __builtin_shufflevector(vf[0][s][0], vf[0][s][1], 0, 1, 2, 3, 4, 5, 6, 7);
                const s16x8 vb = __builtin_shufflevector(vf[1][s][0], vf[1][s][1], 0, 1, 2, 3, 4, 5, 6, 7);
                o0 = MFMA32(va, pf, o0); o1 = MFMA32(vb, pf, o1);
            }
            if (__all(carry < 1e-12f)) break;
        }
        { PG8_LAS unsigned char* S = lds + WIN * KP + 64 * VP + wid * 4608;
#pragma unroll
          for (int i = 0; i < 4; ++i) *(PG8_LAS u32x4*)(S + ((lane >> 3) + 8 * i) * 144 + (lane & 7) * 16) = zc[i];
          asm volatile("s_waitcnt lgkmcnt(0)" ::: "memory");
          PG8_LAS unsigned char* Sr = S + r * 144 + 8 * hh;
#pragma unroll
          for (int g = 0; g < 4; ++g) {
              const u32x2_t z0 = *(PG8_LAS const u32x2_t*)(Sr + 16 * g), z1 = *(PG8_LAS const u32x2_t*)(Sr + 64 + 16 * g);
              u32x2_t w0, w1;
              w0.x = pk2(o0[4 * g] * bflo(z0.x), o0[4 * g + 1] * bfhi(z0.x)); w0.y = pk2(o0[4 * g + 2] * bflo(z0.y), o0[4 * g + 3] * bfhi(z0.y));
              w1.x = pk2(o1[4 * g] * bflo(z1.x), o1[4 * g + 1] * bfhi(z1.x)); w1.y = pk2(o1[4 * g + 2] * bflo(z1.y), o1[4 * g + 3] * bfhi(z1.y));
              *(PG8_LAS u32x2_t*)(Sr + 16 * g) = w0; *(PG8_LAS u32x2_t*)(Sr + 64 + 16 * g) = w1; }
          asm volatile("s_waitcnt lgkmcnt(0)" ::: "memory");
#pragma unroll
          for (int i = 0; i < 4; ++i) { const u32x4 v = *(PG8_LAS const u32x4*)(S + ((lane >> 3) + 8 * i) * 144 + (lane & 7) * 16); *(u32x4*)(g2 + rowc + (size_t)(8 * i) * DM) = v; }
          asm volatile("s_waitcnt lgkmcnt(0)" ::: "memory"); }
#pragma unroll
        for (int i = 0; i < NF; ++i) { kv[i] = kvn[i]; vv[i] = vvn[i]; }
    }
#undef ATT_LOAD_FILL
#undef ATT_LOAD_Q
}

__global__ __launch_bounds__(512, 2) void yoco_fwd(Params P) {
    extern __shared__ __attribute__((aligned(16))) unsigned char shm[];
    PG8_LAS unsigned char* lds = (PG8_LAS unsigned char*)shm;
    unsigned char* ws = P.ws;
    bf16_t* R1 = (bf16_t*)(ws + OFF_R1); bf16_t* R2 = (bf16_t*)(ws + OFF_R2); bf16_t* R3 = (bf16_t*)(ws + OFF_R3); bf16_t* R4 = (bf16_t*)(ws + OFF_R4);
    float* rstd0 = (float*)(ws + OFF_RSTD0); float* rstd1 = (float*)(ws + OFF_RSTD1); float* ssp = (float*)(ws + OFF_SSP);
    const bf16_t* pb = (const bf16_t*)(ws + OFF_PB); bf16_t* E1b = (bf16_t*)(ws + OFF_E1);
#define PH(k) if (P.ph_lo <= (k) && (k) < P.ph_hi)
#define SYNC(k) if (fused) { if ((k) < 2) xcd_barrier(xb, [&]() { deferred_items(P, (float*)shm, (k)); }); else if ((k) >= 3 && grp_ok) grp_barrier(gb); else xcd_barrier(xb, []() {}); }
    const bool fused = (P.ph_hi - P.ph_lo) > 1;
    volatile LAS unsigned* st = (volatile LAS unsigned*)(lds + LDS_ST);
    unsigned* bar = (unsigned*)(ws + OFF_BAR);
    if (fused) { if (threadIdx.x == 0) { st[0] = 0u; st[1] = 0u; } __syncthreads(); }
    XcdBarrier xb; xb.bar = bar; xb.x = 0u; xb.st = st;
    if (fused) xb = xcd_barrier_post(bar, st);
    unsigned* gtab = (unsigned*)(ws + OFF_BAR + 16384 + 8192);
    if (fused && threadIdx.x == 0) gtab[blockIdx.x] = xb.x;
    bool grp_ok = false;
    GrpBarrier gb;
    PH(0) phase0(P, (float*)shm);
    SYNC(0)
    gb.cnt = (unsigned*)(ws + OFF_BAR + 16384) + 64 * (blockIdx.x & 7); gb.gen = (unsigned*)(ws + OFF_BAR + 16384 + 4096) + 64 * (blockIdx.x & 7); gb.tmo = bar + XB_TMO; gb.nmem = gridDim.x >> 3;
    if (fused) { const int t = threadIdx.x; int pred = 1;
        if (gridDim.x == 256 && t < 256) pred = (gtab[t] == gtab[t & 7]);
        grp_ok = (gridDim.x == 256) && (__syncthreads_and(pred) != 0); }
    PH(1) { Epi1 E{R2, R3, rstd0}; run_gemm(lds, R1, (const bf16_t*)(ws + OFF_WIN1), M_TOK, 2048, 1024, E); }
    SYNC(1)
    PH(2) pool_phase(P);
    SYNC(2)
    PH(3) { EpiResB<true> E{P.x, nullptr, R2}; run_gemm(lds, R1, (const bf16_t*)(ws + OFF_WAOUT), M_TOK, 1024, 1024, E); }
    SYNC(3)
    PH(4) { SchedPG S{ws, 0, (int)gridDim.x, (int)blockIdx.x}; EpiPG<true> E{EpiE{E1b}, EpiGate<true>{R2, E1b, R3, rstd1, nullptr}}; pg8::gemm_stream(lds, S, E); }
    SYNC(4)
    PH(6) { SchedP6 S{ws, (int)gridDim.x, (int)blockIdx.x};
            EpiP6 E{EpiKQZ{R1, R2, R4 + (size_t)M_TOK * DM, rstd1, P.k_norm, P.b_q_norm}, EpiVT{R4, rstd1}}; pg8::gemm_stream(lds, S, E); }
    SYNC(6)
    PH(7) attn_phase(P, lds);
    SYNC(7)
    PH(8) { EpiResB<false> E{nullptr, R3, R2}; run_gemm(lds, (const bf16_t*)P.out, (const bf16_t*)(ws + OFF_WBOUT), M_TOK, 1024, 1024, E); }
    SYNC(8)
    PH(9) { SchedPG S{ws, 1, (int)gridDim.x, (int)blockIdx.x}; EpiPG<false> E{EpiE{E1b}, EpiGate<false>{R2, E1b, nullptr, nullptr, P.out}}; pg8::gemm_stream(lds, S, E); }
}

extern "C" void kernel_launch(void* const* d_in, const int* in_sizes, int n_in, void* d_out, int out_size, void* d_ws, size_t ws_size, hipStream_t stream) {
    static int grid = 0;
    if (grid == 0) {
        int dev = 0, cus = 0, per_cu = 0;
        if (n_in != 16 || out_size != M_TOK * DM || ws_size < WS_END) { fprintf(stderr, "kernel_launch: unexpected shapes (n_in %d out %d ws %zu)\n", n_in, out_size, ws_size); grid = -1; return; }
        (void)hipGetDevice(&dev); (void)hipDeviceGetAttribute(&cus, hipDeviceAttributeMultiprocessorCount, dev);
        if (hipFuncSetAttribute((const void*)yoco_fwd, hipFuncAttributeMaxDynamicSharedMemorySize, LDS_BYTES) != hipSuccess) { fprintf(stderr, "kernel_launch: hipFuncSetAttribute failed\n"); grid = -1; return; }
        (void)hipOccupancyMaxActiveBlocksPerMultiprocessor(&per_cu, (const void*)yoco_fwd, 512, LDS_BYTES);
        if (per_cu < 1) { fprintf(stderr, "kernel_launch: occupancy query says %d blocks per CU\n", per_cu); (void)hipGetLastError(); per_cu = 1; }
        grid = cus;
    }
    if (grid < 0) return;
    Params p{};
    const float** pp = (const float**)&p;
    for (int i = 0; i < 16; ++i) pp[i] = (const float*)d_in[i];
    p.out = (float*)d_out; p.ws = (unsigned char*)d_ws;
    p.ph_lo = 0; p.ph_hi = NPHASE;
    if (hipMemsetAsync((unsigned char*)d_ws + OFF_BAR, 0, 32768, stream) != hipSuccess) { fprintf(stderr, "kernel_launch: memset of the barrier words failed\n"); return; }
    void* args[] = {&p};
    hipError_t e = hipLaunchCooperativeKernel((const void*)yoco_fwd, dim3(grid), dim3(512), args, LDS_BYTES, stream);
    if (e != hipSuccess) fprintf(stderr, "kernel_launch: cooperative launch failed: %s (grid %d)\n", hipGetErrorString(e), grid);
}
```

```cpp
#include <hip/hip_runtime.h>
#include <cstdio>
namespace pg8 {
#define PG8_LAS __attribute__((address_space(3)))
typedef unsigned short bf16_t;
typedef short bf16x8 __attribute__((ext_vector_type(8)));
typedef float f32x4 __attribute__((ext_vector_type(4)));
typedef unsigned u32x4 __attribute__((ext_vector_type(4)));
constexpr int BM = 256, BK = 64, HALF = 128, HTB = HALF * BK * 2  , STAGE_BYTES = 8 * HTB, NXCD = 8, WGM = 8;

__host__ __device__ __forceinline__ int lds_byte(int r, int c) { const int st = (r >> 4) * 2 + (c >> 5), rr = r & 15, cc = c & 31, ob = rr * 64 + cc * 2; return st * 1024 + (ob ^ (((ob >> 9) & 1) << 5)); }
__host__ __device__ __forceinline__ void stage_rc(int b, int& R, int& C) { const int st = b / 1024, sb = b % 1024, swz = sb ^ (((sb >> 9) & 1) << 5); R = (st >> 1) * 16 + swz / 64; C = (st & 1) * 32 + (swz % 64) / 2; }
__host__ __device__ __forceinline__ int perm32(int rho) { const int n = rho >> 4, i = rho & 15; return 8 * (i >> 2) + 4 * n + (i & 3); }

struct Unit { int pm, pn; };
struct Gemm { const bf16_t* A; const bf16_t* Bt; int M, N, K; };
struct StaticOrder {
    int nM, nN, nwg, G, c;
    __host__ __device__ void init(int M, int N, int G_, int c_) { nM = M / BM; nN = N / BM; nwg = nM * nN; G = G_; c = c_; }
    __host__ __device__ bool next(int i, Unit& u) const {
        const long L = (long)i * G + c; if (L >= nwg) return false;
        int wgid = (int)L; { const int q = nwg / NXCD, r = nwg % NXCD, xcd = wgid % NXCD, off = wgid / NXCD; wgid = (xcd < r ? xcd * (q + 1) : r * (q + 1) + (xcd - r) * q) + off; }
        const int nig = WGM * nN, gid = wgid / nig, fm = gid * WGM, gsz = (nM - fm) < WGM ? (nM - fm) : WGM;
        u.pm = fm + ((wgid % nig) % gsz); u.pn = (wgid % nig) / gsz; return true;
    }
    __device__ __forceinline__ void a_ready(const Unit&) const {}
    __device__ __forceinline__ void done(const Unit&) const {}
};
template <class Epi, class Sched, bool STAMP = false>
__device__ __forceinline__ void gemm_phase(PG8_LAS unsigned char* lds, const Gemm g, const Sched& S, const Epi& E, unsigned long long* stamps) {
    const int tid = threadIdx.x, wid = __builtin_amdgcn_readfirstlane(tid >> 6), lane = tid & 63, wr = wid >> 2, wc = wid & 3, fr = lane & 15, fq = lane >> 4;
    const int K = g.K, nt = K / BK;
    int ts_lo = 0, ts_hi = 0, nts = 0; const unsigned long long rt_entry = STAMP ? (unsigned long long)wall_clock64() : 0ull;
#define PG8_STAMP() do { if (STAMP && wid == 0 && nts < 64) { const unsigned long long _c = (unsigned long long)clock64(); \
        ts_lo = (lane == nts) ? (int)(unsigned)_c : ts_lo; ts_hi = (lane == nts) ? (int)(unsigned)(_c >> 32) : ts_hi; ++nts; } } while (0)
    PG8_STAMP();
    unsigned voffA[2], voffB[2];
#pragma unroll
    for (int i = 0; i < 2; ++i) { int R, C; stage_rc(tid * 16 + i * 8192, R, C); const int Rb = Epi::PERM ? ((R & ~31) + perm32(R & 31)) : R;
        voffA[i] = (unsigned)(R * K + C) * 2u; voffB[i] = (unsigned)(Rb * K + C) * 2u; }
    const size_t kstep = (size_t)(BK * 2);
    const size_t hstep = (size_t)HALF * K * 2;
    const size_t tstep = 2 * hstep;
    const unsigned ldsw = (unsigned)wid * 1024u;
    const int aoff = lds_byte(wr * 64 + fr, fq * 8), boff = lds_byte(wc * 32 + fr, fq * 8);
#define PG8_SA(b, h) (((b) * 2 + (h)) * HTB)
#define PG8_SB(b, h) ((4 + (b) * 2 + (h)) * HTB)
#define PG8_STAGE(bufoff, gbase, voff) do { _Pragma("unroll") for (int _i = 0; _i < 2; ++_i) \
        __builtin_amdgcn_global_load_lds((const unsigned*)((const char*)(gbase) + (voff)[_i]), (PG8_LAS unsigned*)(lds + (bufoff) + ldsw + _i * 8192), 16, 0, 0); } while (0)
#define PG8_LDA(dst, b, h) do { _Pragma("unroll") for (int m = 0; m < 4; ++m) _Pragma("unroll") for (int k = 0; k < 2; ++k) dst[m][k] = *(const PG8_LAS bf16x8*)(lds + PG8_SA(b, h) + aoff + m * 2048 + k * 1024); } while (0)
#define PG8_LDB(dst, b, h) do { _Pragma("unroll") for (int n = 0; n < 2; ++n) _Pragma("unroll") for (int k = 0; k < 2; ++k) dst[n][k] = *(const PG8_LAS bf16x8*)(lds + PG8_SB(b, h) + boff + n * 2048 + k * 1024); } while (0)
#define PG8_MMA(ai, bj, At, Bt) do { __builtin_amdgcn_s_setprio(1); _Pragma("unroll") for (int m = 0; m < 4; ++m) _Pragma("unroll") for (int n = 0; n < 2; ++n) _Pragma("unroll") for (int k = 0; k < 2; ++k) \
        acc[ai][bj][m][n] = __builtin_amdgcn_mfma_f32_16x16x32_bf16(Bt[n][k], At[m][k], acc[ai][bj][m][n], 0, 0, 0); __builtin_amdgcn_s_setprio(0); } while (0)
#define PG8_WAIT_V(n) asm volatile("s_waitcnt vmcnt(" #n ")" ::: "memory")
#define PG8_WAIT_L(n) asm volatile("s_waitcnt lgkmcnt(" #n ")" ::: "memory")
#define PG8_BAR __builtin_amdgcn_s_barrier()
#define PG8_SCHED __builtin_amdgcn_sched_barrier(0)
    Unit cur, nxt; int ui = 0;
    if (!S.next(0, cur)) return;
    f32x4 acc[2][2][4][2];
#pragma unroll
    for (int a = 0; a < 2; ++a)
#pragma unroll
        for (int b = 0; b < 2; ++b)
#pragma unroll
            for (int m = 0; m < 4; ++m)
#pragma unroll
                for (int n = 0; n < 2; ++n) acc[a][b][m][n] = (f32x4){0.f, 0.f, 0.f, 0.f};
    bf16x8 At[4][2], B0[2][2], B1[2][2];
    const char* cA = (const char*)g.A + (size_t)cur.pm * tstep; const char* cB = (const char*)g.Bt + (size_t)cur.pn * tstep;
    S.a_ready(cur);
    PG8_STAGE(PG8_SB(0, 0), cB, voffB); PG8_STAGE(PG8_SA(0, 0), cA, voffA); PG8_STAGE(PG8_SB(0, 1), cB + hstep, voffB); PG8_STAGE(PG8_SA(0, 1), cA + hstep, voffA);
    if (wr == 1) PG8_BAR;
    PG8_WAIT_V(4); PG8_BAR;
    PG8_STAGE(PG8_SB(1, 0), cB + kstep, voffB); PG8_STAGE(PG8_SA(1, 0), cA + kstep, voffA); PG8_STAGE(PG8_SB(1, 1), cB + hstep + kstep, voffB);
    PG8_WAIT_V(6); PG8_BAR;
    PG8_STAMP();
    for (;;) {
        const bool has_next = S.next(ui + 1, nxt);
        const char* nA = has_next ? (const char*)g.A + (size_t)nxt.pm * tstep : cA; const char* nB = has_next ? (const char*)g.Bt + (size_t)nxt.pn * tstep : cB;
        for (int t = 0; t < nt; t += 2) {
            const bool last = (t == nt - 2);
            const char* a1 = cA + (size_t)(t + 1) * kstep;
            const char* a2 = last ? nA : cA + (size_t)(t + 2) * kstep; const char* b2 = last ? nB : cB + (size_t)(t + 2) * kstep;
            const char* a3 = a2 + kstep; const char* b3 = b2 + kstep;
            if (last && has_next) S.a_ready(nxt);
            PG8_LDB(B0, 0, 0); PG8_SCHED; PG8_LDA(At, 0, 0); PG8_STAGE(PG8_SA(1, 1), a1 + hstep, voffA);
            PG8_WAIT_L(8); PG8_BAR; PG8_WAIT_L(0); PG8_MMA(0, 0, At, B0); PG8_BAR; PG8_SCHED;
            PG8_LDB(B1, 0, 1); PG8_STAGE(PG8_SB(0, 0), b2, voffB);
            PG8_BAR; PG8_WAIT_L(0); PG8_MMA(0, 1, At, B1); PG8_BAR;
            PG8_LDA(At, 0, 1); PG8_STAGE(PG8_SA(0, 0), a2, voffA);
            PG8_BAR; PG8_WAIT_L(0); PG8_MMA(1, 0, At, B0); PG8_BAR; PG8_SCHED;
            PG8_STAGE(PG8_SB(0, 1), b2 + hstep, voffB);
            PG8_WAIT_V(6); PG8_BAR; PG8_MMA(1, 1, At, B1); PG8_BAR;
            PG8_LDB(B0, 1, 0); PG8_SCHED; PG8_LDA(At, 1, 0); PG8_STAGE(PG8_SA(0, 1), a2 + hstep, voffA);
            PG8_WAIT_L(8); PG8_BAR; PG8_WAIT_L(0); PG8_MMA(0, 0, At, B0); PG8_BAR; PG8_SCHED;
            PG8_LDB(B1, 1, 1); PG8_STAGE(PG8_SB(1, 0), b3, voffB);
            PG8_BAR; PG8_WAIT_L(0); PG8_MMA(0, 1, At, B1); PG8_BAR;
            PG8_LDA(At, 1, 1); PG8_STAGE(PG8_SA(1, 0), a3, voffA);
            PG8_BAR; PG8_WAIT_L(0); PG8_MMA(1, 0, At, B0); PG8_BAR; PG8_SCHED;
            PG8_STAGE(PG8_SB(1, 1), b3 + hstep, voffB);
            PG8_WAIT_V(6); PG8_BAR; PG8_MMA(1, 1, At, B1); PG8_BAR;
        }
        PG8_STAMP();
        if constexpr (!Epi::AFTER_DRAIN) { E(acc, cur, wr, wc, fr, fq); S.done(cur); }
        PG8_STAMP();
        if (!has_next) break;
#pragma unroll
        for (int a = 0; a < 2; ++a)
#pragma unroll
            for (int b = 0; b < 2; ++b)
#pragma unroll
                for (int m = 0; m < 4; ++m)
#pragma unroll
                    for (int n = 0; n < 2; ++n) acc[a][b][m][n] = (f32x4){0.f, 0.f, 0.f, 0.f};
        cur = nxt; cA = nA; cB = nB; ++ui;
    }
    PG8_WAIT_V(0);
    if (wr == 0) PG8_BAR;
    PG8_BAR;
    if constexpr (Epi::AFTER_DRAIN) { E.fused(acc, cur, wr, wc, fr, fq, lds, wid, lane); S.done(cur); }
    PG8_STAMP();
    if (STAMP && wid == 0) { stamps[lane] = lane < nts ? (((unsigned long long)(unsigned)ts_hi << 32) | (unsigned)ts_lo) : 0ull;
        if (lane == 62) stamps[62] = rt_entry; if (lane == 63) stamps[63] = (unsigned long long)wall_clock64(); }
#undef PG8_STAMP
#undef PG8_SA
#undef PG8_SB
#undef PG8_STAGE
#undef PG8_LDA
#undef PG8_LDB
#undef PG8_MMA
#undef PG8_WAIT_V
#undef PG8_WAIT_L
#undef PG8_BAR
#undef PG8_SCHED
}
}
namespace pg8 {
struct UnitX { int pm, pn, kind; };
struct GDesc { const bf16_t* A; const bf16_t* Bt; int ks; };
__device__ __forceinline__ void map_unit(int L, int nM, int nN, int& pm, int& pn) {
    const int nwg = nM * nN; int wgid = L; { const int q = nwg / NXCD, r = nwg % NXCD, xcd = wgid % NXCD, off = wgid / NXCD; wgid = (xcd < r ? xcd * (q + 1) : r * (q + 1) + (xcd - r) * q) + off; }
    const int nig = WGM * nN, gid = wgid / nig, fm = gid * WGM, gsz = (nM - fm) < WGM ? (nM - fm) : WGM;
    pm = fm + ((wgid % nig) % gsz); pn = (wgid % nig) / gsz;
}
template <class Epi, class Sched>
__device__ __forceinline__ void gemm_stream(PG8_LAS unsigned char* lds, const Sched& S, const Epi& E) {
    const int tid = threadIdx.x, wid = __builtin_amdgcn_readfirstlane(tid >> 6), lane = tid & 63, wr = wid >> 2, wc = wid & 3, fr = lane & 15, fq = lane >> 4;
    const size_t kstep = (size_t)(BK * 2);
    const unsigned ldsw = (unsigned)wid * 1024u;
    const int aoff = lds_byte(wr * 64 + fr, fq * 8), boff = lds_byte(wc * 32 + fr, fq * 8);
#define PG8_SA(b, h) (((b) * 2 + (h)) * HTB)
#define PG8_SB(b, h) ((4 + (b) * 2 + (h)) * HTB)
#define PG8_STAGE(bufoff, gbase, voff) do { _Pragma("unroll") for (int _i = 0; _i < 2; ++_i) \
        __builtin_amdgcn_global_load_lds((const unsigned*)((const char*)(gbase) + (voff)[_i]), (PG8_LAS unsigned*)(lds + (bufoff) + ldsw + _i * 8192), 16, 0, 0); } while (0)
#define PG8_LDA(dst, b, h) do { _Pragma("unroll") for (int m = 0; m < 4; ++m) _Pragma("unroll") for (int k = 0; k < 2; ++k) dst[m][k] = *(const PG8_LAS bf16x8*)(lds + PG8_SA(b, h) + aoff + m * 2048 + k * 1024); } while (0)
#define PG8_LDB(dst, b, h) do { _Pragma("unroll") for (int n = 0; n < 2; ++n) _Pragma("unroll") for (int k = 0; k < 2; ++k) dst[n][k] = *(const PG8_LAS bf16x8*)(lds + PG8_SB(b, h) + boff + n * 2048 + k * 1024); } while (0)
#define PG8_MMA(ai, bj, At, Bt) do { __builtin_amdgcn_s_setprio(1); _Pragma("unroll") for (int m = 0; m < 4; ++m) _Pragma("unroll") for (int n = 0; n < 2; ++n) _Pragma("unroll") for (int k = 0; k < 2; ++k) \
        acc[ai][bj][m][n] = __builtin_amdgcn_mfma_f32_16x16x32_bf16(Bt[n][k], At[m][k], acc[ai][bj][m][n], 0, 0, 0); __builtin_amdgcn_s_setprio(0); } while (0)
#define PG8_WAIT_V(n) asm volatile("s_waitcnt vmcnt(" #n ")" ::: "memory")
#define PG8_WAIT_L(n) asm volatile("s_waitcnt lgkmcnt(" #n ")" ::: "memory")
#define PG8_BAR __builtin_amdgcn_s_barrier()
#define PG8_SCHED __builtin_amdgcn_sched_barrier(0)
    UnitX cur, nxt; int ui = 0;
    if (!S.next(0, cur)) return;
    f32x4 acc[2][2][4][2];
#pragma unroll
    for (int a = 0; a < 2; ++a)
#pragma unroll
        for (int b = 0; b < 2; ++b)
#pragma unroll
            for (int m = 0; m < 4; ++m)
#pragma unroll
                for (int n = 0; n < 2; ++n) acc[a][b][m][n] = (f32x4){0.f, 0.f, 0.f, 0.f};
    bf16x8 At[4][2], B0[2][2], B1[2][2];
    GDesc dc = S.desc(cur.kind);
    int ksC = dc.ks; size_t hsC = (size_t)HALF * ksC * 2;
    unsigned vAc[2], vBc[2];
#pragma unroll
    for (int i = 0; i < 2; ++i) { int R, C; stage_rc(tid * 16 + i * 8192, R, C); const int Rb = (R & ~31) + perm32(R & 31);
        vAc[i] = (unsigned)(R * ksC + C) * 2u; vBc[i] = (unsigned)(Rb * ksC + C) * 2u; }
    int shC = 31 - __builtin_clz((unsigned)ksC * 2u);
    const char* cA = (const char*)dc.A + (size_t)cur.pm * 2 * hsC; const char* cB = (const char*)dc.Bt + (size_t)cur.pn * 2 * hsC;
    PG8_STAGE(PG8_SB(0, 0), cB, vBc); PG8_STAGE(PG8_SA(0, 0), cA, vAc); PG8_STAGE(PG8_SB(0, 1), cB + hsC, vBc); PG8_STAGE(PG8_SA(0, 1), cA + hsC, vAc);
    if (wr == 1) PG8_BAR;
    PG8_WAIT_V(4); PG8_BAR;
    PG8_STAGE(PG8_SB(1, 0), cB + kstep, vBc); PG8_STAGE(PG8_SA(1, 0), cA + kstep, vAc); PG8_STAGE(PG8_SB(1, 1), cB + hsC + kstep, vBc);
    PG8_WAIT_V(6); PG8_BAR;
    for (;;) {
        const bool has_next = S.next(ui + 1, nxt);
        const char* nA = cA; const char* nB = cB; int ksN = ksC; size_t hsN = hsC;
        if (has_next) { const GDesc dn = S.desc(nxt.kind); ksN = dn.ks; hsN = (size_t)HALF * ksN * 2;
            nA = (const char*)dn.A + (size_t)nxt.pm * 2 * hsN; nB = (const char*)dn.Bt + (size_t)nxt.pn * 2 * hsN; }
        const int shN = 31 - __builtin_clz((unsigned)ksN * 2u); const unsigned cmask = (unsigned)ksC * 2u - 1u;
        const int nt = ksC / BK;
        for (int t = 0; t < nt; t += 2) {
            const bool last = (t == nt - 2);
            const char* a1 = cA + (size_t)(t + 1) * kstep;
            const char* a2 = last ? nA : cA + (size_t)(t + 2) * kstep; const char* b2 = last ? nB : cB + (size_t)(t + 2) * kstep;
            const char* a3 = a2 + kstep; const char* b3 = b2 + kstep;
            const size_t hs2 = last ? hsN : hsC;
            unsigned vA2[2], vB2[2];
#pragma unroll
            for (int i = 0; i < 2; ++i) { vA2[i] = last ? (((vAc[i] >> shC) << shN) | (vAc[i] & cmask)) : vAc[i]; vB2[i] = last ? (((vBc[i] >> shC) << shN) | (vBc[i] & cmask)) : vBc[i]; }
            PG8_LDB(B0, 0, 0); PG8_SCHED; PG8_LDA(At, 0, 0); PG8_STAGE(PG8_SA(1, 1), a1 + hsC, vAc);
            PG8_WAIT_L(8); PG8_BAR; PG8_WAIT_L(0); PG8_MMA(0, 0, At, B0); PG8_BAR; PG8_SCHED;
            PG8_LDB(B1, 0, 1); PG8_STAGE(PG8_SB(0, 0), b2, vB2);
            PG8_BAR; PG8_WAIT_L(0); PG8_MMA(0, 1, At, B1); PG8_BAR;
            PG8_LDA(At, 0, 1); PG8_STAGE(PG8_SA(0, 0), a2, vA2);
            PG8_BAR; PG8_WAIT_L(0); PG8_MMA(1, 0, At, B0); PG8_BAR; PG8_SCHED;
            PG8_STAGE(PG8_SB(0, 1), b2 + hs2, vB2);
            PG8_WAIT_V(6); PG8_BAR; PG8_MMA(1, 1, At, B1); PG8_BAR;
            PG8_LDB(B0, 1, 0); PG8_SCHED; PG8_LDA(At, 1, 0); PG8_STAGE(PG8_SA(0, 1), a2 + hs2, vA2);
            PG8_WAIT_L(8); PG8_BAR; PG8_WAIT_L(0); PG8_MMA(0, 0, At, B0); PG8_BAR; PG8_SCHED;
            PG8_LDB(B1, 1, 1); PG8_STAGE(PG8_SB(1, 0), b3, vB2);
            PG8_BAR; PG8_WAIT_L(0); PG8_MMA(0, 1, At, B1); PG8_BAR;
            PG8_LDA(At, 1, 1); PG8_STAGE(PG8_SA(1, 0), a3, vA2);
            PG8_BAR; PG8_WAIT_L(0); PG8_MMA(1, 0, At, B0); PG8_BAR; PG8_SCHED;
            PG8_STAGE(PG8_SB(1, 1), b3 + hs2, vB2);
            PG8_WAIT_V(6); PG8_BAR; PG8_MMA(1, 1, At, B1); PG8_BAR;
        }
        E(acc, cur, wr, wc, fr, fq);
        if (!has_next) break;
#pragma unroll
        for (int a = 0; a < 2; ++a)
#pragma unroll
            for (int b = 0; b < 2; ++b)
#pragma unroll
                for (int m = 0; m < 4; ++m)
#pragma unroll
                    for (int n = 0; n < 2; ++n) acc[a][b][m][n] = (f32x4){0.f, 0.f, 0.f, 0.f};
#pragma unroll
        for (int i = 0; i < 2; ++i) { vAc[i] = ((vAc[i] >> shC) << shN) | (vAc[i] & cmask); vBc[i] = ((vBc[i] >> shC) << shN) | (vBc[i] & cmask); }
        cur = nxt; cA = nA; cB = nB; ksC = ksN; hsC = hsN; shC = shN; ++ui;
    }
    PG8_WAIT_V(0);
    if (wr == 0) PG8_BAR;
    PG8_BAR;
#undef PG8_SA
#undef PG8_SB
#undef PG8_STAGE
#undef PG8_LDA
#undef PG8_LDB
#undef PG8_MMA
#undef PG8_WAIT_V
#undef PG8_WAIT_L
#undef PG8_BAR
#undef PG8_SCHED
}
}
#define XB_TMO      128
#define XB_XCNT(j)  (256  + 64 * (j))
#define XB_XSUB(j)  (1280 + 64 * (j))
#define XB_XGEN(j)  (2304 + 64 * (j))
#define XB_TOP      3328
#define XB_TOPGEN   3392
#define XCD_BAR_WORDS 3456
#define XB_SPIN_CAP (1u << 18)
#define LAS __attribute__((address_space(3)))
__device__ __forceinline__ unsigned xb_ld(unsigned* p)              { return __hip_atomic_load(p, __ATOMIC_RELAXED, __HIP_MEMORY_SCOPE_AGENT); }
__device__ __forceinline__ unsigned xb_add(unsigned* p, unsigned v) { return __hip_atomic_fetch_add(p, v, __ATOMIC_RELAXED, __HIP_MEMORY_SCOPE_AGENT); }
__device__ __forceinline__ unsigned xb_xcc_id() { return (unsigned)__builtin_amdgcn_s_getreg((3 << 11) | 20) & 0xFu; }
#define XB_SPIN(cond, bar) do { unsigned _sp = 0; while (cond) { __builtin_amdgcn_s_sleep(1); \
    if ((++_sp & 255u) == 0u) { if (xb_ld(&(bar)[XB_TMO])) break; if (_sp > XB_SPIN_CAP) { atomicAdd(&(bar)[XB_TMO], 1u); break; } } } } while (0)

struct XcdBarrier {
    unsigned* bar; unsigned x;
    volatile LAS unsigned* st;
};

__device__ __forceinline__ XcdBarrier xcd_barrier_post(unsigned* bar, volatile LAS unsigned* st) {
    XcdBarrier b; b.bar = bar; b.x = xb_xcc_id(); b.st = st;
    if (threadIdx.x == 0) (void)xb_add(&bar[XB_XCNT(b.x)], 1u);
    return b;
}
__device__ __forceinline__ void xcd_barrier_complete(unsigned* bar, unsigned x, unsigned& nloc, unsigned& nx) {
    const unsigned G = gridDim.x * gridDim.y * gridDim.z;
    unsigned sum, cnt, mine, sp = 0u;
    for (;;) {
        sum = 0u; cnt = 0u; mine = 0u;
#pragma unroll
        for (unsigned j = 0; j < 16; ++j) { const unsigned c = xb_ld(&bar[XB_XCNT(j)]); sum += c; cnt += (c > 0u) ? 1u : 0u; mine = (j == x) ? c : mine; }
        if (sum == G) break;
        __builtin_amdgcn_s_sleep(1);
        if ((++sp & 255u) == 0u) { if (xb_ld(&bar[XB_TMO])) break; if (sp > XB_SPIN_CAP) { atomicAdd(&bar[XB_TMO], 1u); break; } }
    }
    nloc = mine > 0u ? mine : 1u; nx = cnt > 0u ? cnt : 1u;
}

template <class F> __device__ __forceinline__ void xcd_barrier(const XcdBarrier& b, F&& shadow) {
    asm volatile("s_waitcnt vmcnt(0)" ::: "memory");
    __syncthreads();
    if (threadIdx.x == 0) {
        unsigned* bar = b.bar;
        __builtin_amdgcn_s_waitcnt(0);
        unsigned nloc = b.st[0], nx = b.st[1];
        if (nloc == 0u) { xcd_barrier_complete(bar, b.x, nloc, nx); b.st[0] = nloc; b.st[1] = nx; }
        const unsigned old = xb_add(&bar[XB_XSUB(b.x)], 1u);
        const unsigned gen = old / nloc;
        if (old + 1u == (gen + 1u) * nloc) {
            __builtin_amdgcn_fence(__ATOMIC_RELEASE, "agent");
            asm volatile("s_waitcnt vmcnt(0)" ::: "memory");
            const unsigned og = xb_add(&bar[XB_TOP], 1u);
            const unsigned tg = og / nx;
            if (og + 1u == (tg + 1u) * nx) xb_add(&bar[XB_TOPGEN], 1u);
            else XB_SPIN(xb_ld(&bar[XB_TOPGEN]) == tg, bar);
            __builtin_amdgcn_fence(__ATOMIC_ACQUIRE, "agent");
            xb_add(&bar[XB_XGEN(b.x)], 1u);
            asm volatile("s_waitcnt vmcnt(0)" ::: "memory");
        } else {
            XB_SPIN(xb_ld(&bar[XB_XGEN(b.x)]) == gen, bar);
            __builtin_amdgcn_fence(__ATOMIC_ACQUIRE, "agent");
            asm volatile("s_waitcnt vmcnt(0)" ::: "memory");
        }
    } else if (threadIdx.x >= 64) shadow();
    __syncthreads();
}
using pg8::f32x4; using pg8::u32x4; using pg8::bf16_t; using pg8::Unit;
#define DI __device__ __forceinline__
constexpr int M_TOK = 16384, DM = 1024, SEQ = 2048, NPHASE = 10;
constexpr float EPS = 1e-6f;
constexpr int LDS_ST = 147456, LDS_BYTES = LDS_ST + 16;
constexpr size_t MiB = 1024 * 1024;
constexpr size_t OFF_WIN1 = 0, OFF_WAOUT = 4 * MiB, OFF_WPLE0 = 6 * MiB, OFF_WPLE1 = 6 * MiB + 512 * 1024, OFF_WG0 = 7 * MiB, OFF_WG1 = 9 * MiB,
                 OFF_WKQZ = 11 * MiB, OFF_WV = 17 * MiB, OFF_WBOUT = 19 * MiB, OFF_PB = 21 * MiB, OFF_R1 = 37 * MiB, OFF_R2 = 69 * MiB, OFF_R3 = 101 * MiB,
                 OFF_R4 = 133 * MiB, OFF_RSTD0 = 197 * MiB, OFF_RSTD1 = 197 * MiB + 65536, OFF_SSP = 197 * MiB + 131072, OFF_BAR = 199 * MiB, OFF_E1 = 200 * MiB, WS_END = 232 * MiB;

struct Params {
    const float *x, *p, *a_norm, *a_w_in, *a_w_group, *a_scale, *a_w_out, *kv_norm, *w_kv, *k_norm, *b_norm, *b_w_in, *b_q_norm, *b_w_out, *ple_w, *ple_gate_w;
    float* out; unsigned char* ws; int ph_lo, ph_hi;
};

typedef __bf16 bf16x2_t __attribute__((ext_vector_type(2)));
typedef float f32x2_t __attribute__((ext_vector_type(2)));
typedef unsigned u32x2_t __attribute__((ext_vector_type(2)));
typedef short s16x8 __attribute__((ext_vector_type(8)));
typedef short s16x4 __attribute__((ext_vector_type(4)));
typedef float f32x16 __attribute__((ext_vector_type(16)));
DI unsigned pk2(float lo, float hi) { f32x2_t v = {lo, hi}; bf16x2_t r = __builtin_convertvector(v, bf16x2_t); return __builtin_bit_cast(unsigned, r); }
DI float bflo(unsigned u) { return __uint_as_float(u << 16); }
DI float bfhi(unsigned u) { return __uint_as_float(u & 0xffff0000u); }
DI u32x4 pk8(f32x4 a, f32x4 b) { u32x4 w; w.x = pk2(a[0], a[1]); w.y = pk2(a[2], a[3]); w.z = pk2(b[0], b[1]); w.w = pk2(b[2], b[3]); return w; }
DI int xcd_affine_id() { const int G = (int)gridDim.x, w = (int)blockIdx.x; return (G & 7) ? w : (w & 7) * (G >> 3) + (w >> 3); }
DI float wave_sum(float v) {
#pragma unroll
    for (int o = 1; o < 64; o <<= 1) v += __shfl_xor(v, o);
    return v;
}
DI float sigm(float v) { return __builtin_amdgcn_rcpf(1.f + __expf(-v)); }
DI f32x4 silu4(f32x4 v) { f32x4 r; r[0] = v[0] * sigm(v[0]); r[1] = v[1] * sigm(v[1]); r[2] = v[2] * sigm(v[2]); r[3] = v[3] * sigm(v[3]); return r; }
DI f32x4 sigm4(f32x4 v) { f32x4 r; r[0] = sigm(v[0]); r[1] = sigm(v[1]); r[2] = sigm(v[2]); r[3] = sigm(v[3]); return r; }

typedef const f32x4 (&AccRef)[2][2][4][2];

struct Epi1 {
    static constexpr bool PERM = true, AFTER_DRAIN = false;
    bf16_t* ug; bf16_t* sz; const float* rstd0;
    DI void operator()(AccRef acc, const Unit& u, int wr, int wc, int fr, int fq) const {
        const int row0 = u.pm * 256 + wr * 64 + fr; const bool isz = u.pn >= 4;
        bf16_t* base = (isz ? sz : ug) + (u.pn & 3) * 256 + wc * 32 + 8 * fq;
        float rsv[2][4];
#pragma unroll
        for (int ai = 0; ai < 2; ++ai)
#pragma unroll
            for (int m = 0; m < 4; ++m) rsv[ai][m] = rstd0[row0 + ai * 128 + m * 16];
#pragma unroll
        for (int ai = 0; ai < 2; ++ai)
#pragma unroll
            for (int m = 0; m < 4; ++m) { const int row = row0 + ai * 128 + m * 16; const float rs = rsv[ai][m]; bf16_t* rowp = base + (size_t)row * DM;
#pragma unroll
                for (int bj = 0; bj < 2; ++bj) { f32x4 v0 = acc[ai][bj][m][0] * rs, v1 = acc[ai][bj][m][1] * rs;
                    if (isz) { v0 = silu4(v0); v1 = silu4(v1); }
                    *(u32x4*)(rowp + bj * 128) = pk8(v0, v1); } }
    }
};
struct EpiE {
    static constexpr bool PERM = true, AFTER_DRAIN = false;
    bf16_t* e;
    DI void operator()(AccRef acc, const Unit& u, int wr, int wc, int fr, int fq) const {
        const int row0 = u.pm * 256 + wr * 64 + fr; bf16_t* base = e + u.pn * 256 + wc * 32 + 8 * fq;
#pragma unroll
        for (int ai = 0; ai < 2; ++ai)
#pragma unroll
            for (int m = 0; m < 4; ++m) { bf16_t* rowp = base + (size_t)(row0 + ai * 128 + m * 16) * DM;
#pragma unroll
                for (int bj = 0; bj < 2; ++bj) *(u32x4*)(rowp + bj * 128) = pk8(acc[ai][bj][m][0], acc[ai][bj][m][1]); }
    }
};
DI void unpk8(const u32x4 q, f32x4& lo, f32x4& hi) { lo = (f32x4){bflo(q.x), bfhi(q.x), bflo(q.y), bfhi(q.y)}; hi = (f32x4){bflo(q.z), bfhi(q.z), bflo(q.w), bfhi(q.w)}; }
template <bool SRCF32> struct EpiResB {
    static constexpr bool PERM = true, AFTER_DRAIN = false;
    const float* srcf; const bf16_t* srcb; bf16_t* xb;
    DI void operator()(AccRef acc, const Unit& u, int wr, int wc, int fr, int fq) const {
        const int row0 = u.pm * 256 + wr * 64 + fr, col0 = u.pn * 256 + wc * 32 + 8 * fq;
#pragma unroll
        for (int ai = 0; ai < 2; ++ai) {
            f32x4 a[4][2][2];
#pragma unroll
            for (int m = 0; m < 4; ++m) { const size_t o = (size_t)(row0 + ai * 128 + m * 16) * DM + col0;
#pragma unroll
                for (int bj = 0; bj < 2; ++bj) {
                    if (SRCF32) { a[m][bj][0] = __builtin_nontemporal_load((const f32x4*)(srcf + o + bj * 128)); a[m][bj][1] = __builtin_nontemporal_load((const f32x4*)(srcf + o + bj * 128 + 4)); }
                    else { const u32x4 q = *(const u32x4*)(srcb + o + bj * 128); unpk8(q, a[m][bj][0], a[m][bj][1]); } } }
#pragma unroll
            for (int m = 0; m < 4; ++m) { const size_t o = (size_t)(row0 + ai * 128 + m * 16) * DM + col0;
#pragma unroll
                for (int bj = 0; bj < 2; ++bj) *(u32x4*)(xb + o + bj * 128) = pk8(a[m][bj][0] + acc[ai][bj][m][0], a[m][bj][1] + acc[ai][bj][m][1]); }
        }
    }
};
template <bool NEXT> struct EpiGate {
    static constexpr bool PERM = true, AFTER_DRAIN = false;
    const bf16_t* xin; const bf16_t* e; bf16_t* xb; float* ssp; float* outf;
    DI void operator()(AccRef acc, const Unit& u, int wr, int wc, int fr, int fq) const {
        const int row0 = u.pm * 256 + wr * 64 + fr, col0 = u.pn * 256 + wc * 32 + 8 * fq;
#pragma unroll
        for (int ai = 0; ai < 2; ++ai) {
            u32x4 xv[4][2], ev[4][2];
#pragma unroll
            for (int m = 0; m < 4; ++m) { const size_t o = (size_t)(row0 + ai * 128 + m * 16) * DM + col0;
#pragma unroll
                for (int bj = 0; bj < 2; ++bj) { xv[m][bj] = *(const u32x4*)(xin + o + bj * 128); ev[m][bj] = *(const u32x4*)(e + o + bj * 128); } }
#pragma unroll
            for (int m = 0; m < 4; ++m) { const int row = row0 + ai * 128 + m * 16; const size_t o = (size_t)row * DM + col0; float ss = 0.f;
#pragma unroll
                for (int bj = 0; bj < 2; ++bj) { f32x4 a0, a1, e0, e1; unpk8(xv[m][bj], a0, a1); unpk8(ev[m][bj], e0, e1);
                    const f32x4 v0 = a0 + e0 * sigm4(acc[ai][bj][m][0]), v1 = a1 + e1 * sigm4(acc[ai][bj][m][1]);
                    if (NEXT) { *(u32x4*)(xb + o + bj * 128) = pk8(v0, v1);
                        ss += (v0[0] * v0[0] + v0[1] * v0[1]) + (v0[2] * v0[2] + v0[3] * v0[3]) + (v1[0] * v1[0] + v1[1] * v1[1]) + (v1[2] * v1[2] + v1[3] * v1[3]); }
                    else { __builtin_nontemporal_store(v0, (f32x4*)(outf + o + bj * 128)); __builtin_nontemporal_store(v1, (f32x4*)(outf + o + bj * 128 + 4)); } }
                if (NEXT) { ss += __shfl_xor(ss, 16); ss += __shfl_xor(ss, 32); if (fq == 0) atomicAdd(ssp + row, ss); } }
        }
    }
};
struct EpiKQZ {
    static constexpr bool PERM = true, AFTER_DRAIN = false;
    bf16_t *kk, *qq, *sz2; const float *rstd1, *k_norm, *q_norm;
    DI void operator()(AccRef acc, const Unit& u, int wr, int wc, int fr, int fq) const {
        const int row0 = u.pm * 256 + wr * 64 + fr, kind = u.pn >> 2, pq = u.pn & 3;
        float rsv[2][4];
#pragma unroll
        for (int ai = 0; ai < 2; ++ai)
#pragma unroll
            for (int m = 0; m < 4; ++m) rsv[ai][m] = rstd1[row0 + ai * 128 + m * 16];
        if (kind == 2) {
            bf16_t* base = sz2 + pq * 256 + 64 * wc + 8 * fq;
#pragma unroll
            for (int ai = 0; ai < 2; ++ai)
#pragma unroll
                for (int m = 0; m < 4; ++m) { const int row = row0 + ai * 128 + m * 16; const float rs = rsqrtf(rsv[ai][m] * (1.f / DM) + EPS); bf16_t* rowp = base + (size_t)row * DM;
#pragma unroll
                    for (int bj = 0; bj < 2; ++bj) *(u32x4*)(rowp + bj * 32) = pk8(silu4(acc[ai][bj][m][0] * rs), silu4(acc[ai][bj][m][1] * rs)); }
        } else {
            const float* gn = kind ? q_norm : k_norm; const float mul = kind ? 0.125f * 1.4426950408889634f : 1.f;
            bf16_t* dst = kind ? qq : kk; const int head = pq * 4 + wc;
            f32x4 g[2][2];
#pragma unroll
            for (int bj = 0; bj < 2; ++bj)
#pragma unroll
                for (int n = 0; n < 2; ++n) g[bj][n] = *(const f32x4*)(gn + 32 * bj + 8 * fq + 4 * n) * mul;
#pragma unroll
            for (int ai = 0; ai < 2; ++ai)
#pragma unroll
                for (int m = 0; m < 4; ++m) { const int row = row0 + ai * 128 + m * 16; const float rs = rsqrtf(rsv[ai][m] * (1.f / DM) + EPS); const int b = row >> 11, s = row & 2047;
                    f32x4 v[2][2]; float ss = 0.f;
#pragma unroll
                    for (int bj = 0; bj < 2; ++bj)
#pragma unroll
                        for (int n = 0; n < 2; ++n) { v[bj][n] = acc[ai][bj][m][n] * rs; ss += (v[bj][n][0] * v[bj][n][0] + v[bj][n][1] * v[bj][n][1]) + (v[bj][n][2] * v[bj][n][2] + v[bj][n][3] * v[bj][n][3]); }
                    ss += __shfl_xor(ss, 16); ss += __shfl_xor(ss, 32);
                    const float hr = rsqrtf(ss * (1.f / 64.f) + EPS);
                    bf16_t* rowp = dst + ((size_t)(b * 16 + head) * SEQ + s) * 64 + 8 * fq;
#pragma unroll
                    for (int bj = 0; bj < 2; ++bj) *(u32x4*)(rowp + 32 * bj) = pk8(v[bj][0] * hr * g[bj][0], v[bj][1] * hr * g[bj][1]); }
        }
    }
};
struct EpiVT {
    static constexpr bool PERM = true, AFTER_DRAIN = false;
    bf16_t* vt; const float* rstd1;
    DI void operator()(AccRef acc, const Unit& u, int wr, int wc, int fr, int fq) const {
        const int c0 = u.pm * 256 + wr * 64 + fr, tok0 = u.pn * 256 + wc * 32 + 8 * fq;
        f32x4 rs[2][2];
#pragma unroll
        for (int bj = 0; bj < 2; ++bj)
#pragma unroll
            for (int n = 0; n < 2; ++n) { const f32x4 q = *(const f32x4*)(rstd1 + tok0 + 128 * bj + 4 * n);
#pragma unroll
                for (int j = 0; j < 4; ++j) rs[bj][n][j] = rsqrtf(q[j] * (1.f / DM) + EPS); }
#pragma unroll
        for (int ai = 0; ai < 2; ++ai)
#pragma unroll
            for (int m = 0; m < 4; ++m) { const int c = c0 + ai * 128 + m * 16;
#pragma unroll
                for (int bj = 0; bj < 2; ++bj) { const int tok = tok0 + 128 * bj, b = tok >> 11, s = tok & 2047;
                    *(u32x4*)(vt + ((size_t)b * DM + c) * SEQ + s) = pk8(acc[ai][bj][m][0] * rs[bj][0], acc[ai][bj][m][1] * rs[bj][1]); } }
    }
};
template <class Epi> DI void run_gemm(PG8_LAS unsigned char* lds, const bf16_t* A, const bf16_t* Bt, int M, int N, int K, const Epi& E) {
    pg8::Gemm g{A, Bt, M, N, K}; pg8::StaticOrder S; S.init(M, N, (int)gridDim.x, (int)blockIdx.x);
    pg8::gemm_phase<Epi, pg8::StaticOrder, false>(lds, g, S, E, nullptr);
}

struct SchedPG {
    const unsigned char* ws; int layer, G, c;
    DI bool next(int i, pg8::UnitX& u) const { const int L = i * G + c; if (L >= 512) return false;
        pg8::map_unit(L & 255, 64, 4, u.pm, u.pn); u.kind = L >> 8; return true; }
    DI pg8::GDesc desc(int k) const { pg8::GDesc d;
        const size_t oa = k == 0 ? OFF_PB + (size_t)layer * M_TOK * 256 * 2 : OFF_R2, ob = k == 0 ? (layer ? OFF_WPLE1 : OFF_WPLE0) : (layer ? OFF_WG1 : OFF_WG0);
        d.A = (const bf16_t*)(ws + oa); d.Bt = (const bf16_t*)(ws + ob); d.ks = k == 0 ? 256 : 1024; return d; }
    DI void a_ready(const pg8::UnitX&) const {}
    DI void done(const pg8::UnitX&) const {}
};
template <bool NEXT> struct EpiPG {
    static constexpr bool PERM = true;
    EpiE e; EpiGate<NEXT> g;
    DI void operator()(AccRef acc, const pg8::UnitX& u, int wr, int wc, int fr, int fq) const { const Unit uu{u.pm, u.pn};
        if (u.kind == 0) e(acc, uu, wr, wc, fr, fq); else g(acc, uu, wr, wc, fr, fq); }
};
struct SchedP6 {
    const unsigned char* ws; int G, c;
    DI bool next(int i, pg8::UnitX& u) const { const int L = i * G + c; if (L >= 1024) return false;
        if (L < 768) { pg8::map_unit(L, 64, 12, u.pm, u.pn); u.kind = 0; } else { pg8::map_unit(L - 768, 4, 64, u.pm, u.pn); u.kind = 1; }
        return true; }
    DI pg8::GDesc desc(int k) const { pg8::GDesc d; d.A = (const bf16_t*)(ws + (k == 0 ? OFF_R3 : OFF_WV)); d.Bt = (const bf16_t*)(ws + (k == 0 ? OFF_WKQZ : OFF_R3)); d.ks = 1024; return d; }
};
struct EpiP6 {
    static constexpr bool PERM = true;
    EpiKQZ a; EpiVT b;
    DI void operator()(AccRef acc, const pg8::UnitX& u, int wr, int wc, int fr, int fq) const { const Unit uu{u.pm, u.pn};
        if (u.kind == 0) a(acc, uu, wr, wc, fr, fq); else b(acc, uu, wr, wc, fr, fq); }
};

DI int headperm(int cl) { const int o = cl & 255, wc = o >> 6, bj = (o >> 5) & 1, r = o & 31; return (cl & ~255) + 128 * bj + 32 * wc + r; }
DI void transpose_item(float* scr, const float* src, int ld, int K, int nT, const float* gain, bf16_t* dst, int rowoff, bool perm, int item, int lane) {
    const int kt = item / nT, nt = item - kt * nT, k0 = kt * 64, n0 = nt * 32, lr = lane >> 3, lc = lane & 7;
    float4 v[8];
#pragma unroll
    for (int i = 0; i < 8; ++i) v[i] = *(const float4*)(src + (size_t)(k0 + i * 8 + lr) * ld + n0 + lc * 4);
    float gk[8];
#pragma unroll
    for (int i = 0; i < 8; ++i) gk[i] = gain ? gain[k0 + 8 * lc + i] : 1.f;
#pragma unroll
    for (int i = 0; i < 8; ++i) { float* t = scr + (i * 8 + lr) * 33 + lc * 4; t[0] = v[i].x; t[1] = v[i].y; t[2] = v[i].z; t[3] = v[i].w; }
    asm volatile("s_waitcnt lgkmcnt(0)" ::: "memory");
#pragma unroll
    for (int j = 0; j < 4; ++j) { const int n = lr + 8 * j; const float* t = scr + (8 * lc) * 33 + n;
        int row = rowoff + n0 + n; if (perm) row = headperm(row);
        u32x4 w; w.x = pk2(t[0] * gk[0], t[33] * gk[1]); w.y = pk2(t[66] * gk[2], t[99] * gk[3]); w.z = pk2(t[132] * gk[4], t[165] * gk[5]); w.w = pk2(t[198] * gk[6], t[231] * gk[7]);
        *(u32x4*)(dst + (size_t)row * K + k0 + 8 * lc) = w; }
    asm volatile("s_waitcnt lgkmcnt(0)" ::: "memory");
}
DI void weff_job(float* L, const Params& P, bf16_t* dst, int job) {
    float* As = L; float* Bs = L + 64 * 129;
    const int tid = threadIdx.x, k0 = (job >> 4) * 64, n0 = (job & 15) * 64, g = n0 >> 8, d0 = n0 & 255, kk = tid >> 3, dg = tid & 7;
    float acc[8];
#pragma unroll
    for (int j = 0; j < 8; ++j) acc[j] = 0.f;
    for (int c0 = 0; c0 < 256; c0 += 128) {
        __syncthreads();
#pragma unroll
        for (int i = 0; i < 4; ++i) { const int idx = tid + 512 * i;
            { const int r = idx >> 5, c4 = idx & 31; const float4 v = *(const float4*)(P.a_w_in + (size_t)(k0 + r) * 2048 + g * 256 + c0 + c4 * 4);
              float* t = As + r * 129 + c4 * 4; t[0] = v.x; t[1] = v.y; t[2] = v.z; t[3] = v.w; }
            { const int cc = idx >> 4, d4 = idx & 15; *(float4*)(Bs + cc * 64 + d4 * 4) = *(const float4*)(P.a_w_group + (size_t)(g * 256 + c0 + cc) * 256 + d0 + d4 * 4); } }
        __syncthreads();
#pragma unroll 4
        for (int c = 0; c < 128; ++c) { const float a = As[kk * 129 + c]; const float4 b0 = *(const float4*)(Bs + c * 64 + dg * 8), b1 = *(const float4*)(Bs + c * 64 + dg * 8 + 4);
            acc[0] += a * b0.x; acc[1] += a * b0.y; acc[2] += a * b0.z; acc[3] += a * b0.w; acc[4] += a * b1.x; acc[5] += a * b1.y; acc[6] += a * b1.z; acc[7] += a * b1.w; }
    }
    const float an = P.a_norm[k0 + kk];
#pragma unroll
    for (int j = 0; j < 8; ++j) { const int n = n0 + dg * 8 + j; const float v = acc[j] * an * P.a_scale[n];
        dst[(size_t)n * DM + k0 + kk] = (bf16_t)(pk2(v, v) & 0xffffu); }
}
DI void shadow_p_convert(const Params& P) {
    const float4* pp = (const float4*)P.p; u32x4* pb = (u32x4*)(P.ws + OFF_PB);
    for (int v = xcd_affine_id(); v < 256; v += (int)gridDim.x) {
        for (int j0 = (int)threadIdx.x - 64; j0 < 4096; j0 += 5 * 448) { float4 a[5], b[5];
#pragma unroll
            for (int q = 0; q < 5; ++q) { const int j = j0 + q * 448; if (j < 4096) { const size_t row = (size_t)(j >> 11) * M_TOK + 64 * v + ((j >> 5) & 63); const int c = j & 31;
                a[q] = pp[row * 64 + 2 * c]; b[q] = pp[row * 64 + 2 * c + 1]; } }
#pragma unroll
            for (int q = 0; q < 5; ++q) { const int j = j0 + q * 448; if (j < 4096) { const size_t row = (size_t)(j >> 11) * M_TOK + 64 * v + ((j >> 5) & 63); const int c = j & 31;
                u32x4 u; u.x = pk2(a[q].x, a[q].y); u.y = pk2(a[q].z, a[q].w); u.z = pk2(b[q].x, b[q].y); u.w = pk2(b[q].z, b[q].w); pb[row * 32 + c] = u; } } }
    }
}
DI void deferred_items(const Params& P, float* L, int seam) {
    const int wid = threadIdx.x >> 6, lane = threadIdx.x & 63; unsigned char* ws = P.ws; float* scr = L + wid * (64 * 33);
    const int nitems = (seam == 0) ? 1792 : 2560;
    for (int t = blockIdx.x * 7 + (wid - 1); t < nitems; t += gridDim.x * 7) {
        if (seam == 0) {
            if (t < 512) transpose_item(scr, P.a_w_out, 1024, 1024, 32, nullptr, (bf16_t*)(ws + OFF_WAOUT), 0, false, t, lane);
            else if (t < 640) transpose_item(scr, P.ple_w, 1024, 256, 32, nullptr, (bf16_t*)(ws + OFF_WPLE0), 0, false, t - 512, lane);
            else if (t < 768) transpose_item(scr, P.ple_w + 256 * 1024, 1024, 256, 32, nullptr, (bf16_t*)(ws + OFF_WPLE1), 0, false, t - 640, lane);
            else if (t < 1280) transpose_item(scr, P.w_kv, 2048, 1024, 32, P.kv_norm, (bf16_t*)(ws + OFF_WKQZ), 0, true, t - 768, lane);
            else transpose_item(scr, P.w_kv + 1024, 2048, 1024, 32, P.kv_norm, (bf16_t*)(ws + OFF_WV), 0, false, t - 1280, lane);
        } else {
            if (t < 512) transpose_item(scr, P.ple_gate_w, 1024, 1024, 32, nullptr, (bf16_t*)(ws + OFF_WG0), 0, false, t, lane);
            else if (t < 1536) transpose_item(scr, P.b_w_in, 2048, 1024, 64, P.b_norm, (bf16_t*)(ws + OFF_WKQZ), 1024, true, t - 512, lane);
            else if (t < 2048) transpose_item(scr, P.b_w_out, 1024, 1024, 32, nullptr, (bf16_t*)(ws + OFF_WBOUT), 0, false, t - 1536, lane);
            else transpose_item(scr, P.ple_gate_w + 1024 * 1024, 1024, 1024, 32, nullptr, (bf16_t*)(ws + OFF_WG1), 0, false, t - 2048, lane);
        }
    }
}
struct GrpBarrier { unsigned* cnt; unsigned* gen; unsigned* tmo; unsigned nmem; };
DI void grp_barrier(const GrpBarrier& gb) {
    asm volatile("s_waitcnt vmcnt(0)" ::: "memory");
    __syncthreads();
    if (threadIdx.x == 0) {
        const unsigned old = xb_add(gb.cnt, 1u), g = old / gb.nmem;
        if (old + 1u == (g + 1u) * gb.nmem) xb_add(gb.gen, 1u);
        else XB_SPIN(xb_ld(gb.gen) == g, gb.tmo - XB_TMO);
        __builtin_amdgcn_fence(__ATOMIC_ACQUIRE, "agent");
        asm volatile("s_waitcnt vmcnt(0)" ::: "memory");
    }
    __syncthreads();
}
DI void phase0(const Params& P, float* L) {
    const int tid = threadIdx.x, wid = tid >> 6, lane = tid & 63, w = blockIdx.x, G = gridDim.x;
    unsigned char* ws = P.ws;
    { float* ss1 = (float*)(ws + OFF_RSTD1); for (int i = w * 512 + tid; i < M_TOK; i += G * 512) ss1[i] = 0.f; }
    if ((w & 1) == 0) { for (int job = w; job < 256; job += G) weff_job(L, P, (bf16_t*)(ws + OFF_WIN1), job); __syncthreads(); }
    { float* scr = L + wid * (64 * 33);
      for (int t = w * 8 + wid; t < 512; t += G * 8) transpose_item(scr, P.a_w_in + 1024, 2048, 1024, 32, P.a_norm, (bf16_t*)(ws + OFF_WIN1) + (size_t)1024 * 1024, 0, false, t, lane); }
    { bf16_t* xb = (bf16_t*)(ws + OFF_R1); float* rstd0 = (float*)(ws + OFF_RSTD0);
      for (int row = (xcd_affine_id() * 8 + wid) * 8; row < M_TOK; row += G * 64) {
          float4 v[8][4];
#pragma unroll
          for (int q = 0; q < 8; ++q)
#pragma unroll
              for (int j = 0; j < 4; ++j) v[q][j] = ((const float4*)(P.x + (size_t)(row + q) * DM) + lane)[64 * j];
#pragma unroll
          for (int q = 0; q < 8; ++q) { float s = 0.f;
#pragma unroll
              for (int j = 0; j < 4; ++j) s += (v[q][j].x * v[q][j].x + v[q][j].y * v[q][j].y) + (v[q][j].z * v[q][j].z + v[q][j].w * v[q][j].w);
              s = wave_sum(s);
              uint2* o = (uint2*)(xb + (size_t)(row + q) * DM) + lane;
#pragma unroll
              for (int j = 0; j < 4; ++j) { uint2 u; u.x = pk2(v[q][j].x, v[q][j].y); u.y = pk2(v[q][j].z, v[q][j].w); o[64 * j] = u; }
              if (lane == 0) rstd0[row + q] = rsqrtf(s * (1.f / DM) + EPS); } } }
    if ((w & 1) != 0) { __syncthreads(); for (int job = w; job < 256; job += G) weff_job(L, P, (bf16_t*)(ws + OFF_WIN1), job); }
}
DI void unpack8(const u32x4 q, float (&f)[8]) { f[0] = bflo(q.x); f[1] = bfhi(q.x); f[2] = bflo(q.y); f[3] = bfhi(q.y); f[4] = bflo(q.z); f[5] = bfhi(q.z); f[6] = bflo(q.w); f[7] = bfhi(q.w); }
DI void pool_phase(const Params& P) {
    const bf16_t* ug = (const bf16_t*)(P.ws + OFF_R2); const bf16_t* sz = (const bf16_t*)(P.ws + OFF_R3); bf16_t* Gd = (bf16_t*)(P.ws + OFF_R1);
    const int nth = gridDim.x * 512;
    for (int idx = xcd_affine_id() * 512 + threadIdx.x; idx < 131072; idx += nth) {
        const int chunk = idx & 127, run = idx >> 7, row0 = run * 16, t0 = row0 & (SEQ - 1), c0 = chunk * 8, wlen = 2 << (chunk >> 5);
        const u32x4* up = (const u32x4*)(ug + (size_t)row0 * DM + c0); const u32x4* zp = (const u32x4*)(sz + (size_t)row0 * DM + c0); u32x4* gp = (u32x4*)(Gd + (size_t)row0 * DM + c0);
        float s[8], c[8], z[8];
#pragma unroll
        for (int j = 0; j < 8; ++j) s[j] = 0.f;
        { const bool hist = t0 > 0;
#pragma unroll
          for (int j = 1; j <= 16; ++j) {
              const int jj = hist ? (j <= wlen ? j : wlen) : 0; const float mk = (hist && j <= wlen) ? 1.f : 0.f;
              unpack8(up[-(jj * 128)], c);
#pragma unroll
              for (int q = 0; q < 8; ++q) s[q] += mk * c[q]; } }
        const float inv_full = 1.f / (float)wlen;
#pragma unroll 4
        for (int rr = 0; rr < 16; ++rr) {
            const int t = t0 + rr;
            if (t >= wlen) { unpack8(up[(rr - wlen) * 128], c);
#pragma unroll
                for (int q = 0; q < 8; ++q) s[q] -= c[q]; }
            unpack8(up[rr * 128], c); unpack8(zp[rr * 128], z);
            const float inv = (t + 1 < wlen) ? 1.f / (float)(t + 1) : inv_full;
            float o[8];
#pragma unroll
            for (int q = 0; q < 8; ++q) { s[q] += c[q]; o[q] = (s[q] * inv - c[q]) * z[q]; }
            u32x4 w; w.x = pk2(o[0], o[1]); w.y = pk2(o[2], o[3]); w.z = pk2(o[4], o[5]); w.w = pk2(o[6], o[7]); gp[rr * 128] = w;
        }
    }
}
#define MFMA32(a, b, c) __builtin_amdgcn_mfma_f32_32x32x16_bf16((a), (b), (c), 0, 0, 0)
DI void attn_phase(const Params& P, PG8_LAS unsigned char* lds) {
    constexpr int HIST = 128, WIN = 384, KP = 144, VP = 776, NF = 6, VCH = 48;
    PG8_LAS unsigned char* Kl = lds; PG8_LAS unsigned char* Vl = lds + WIN * KP;
    const bf16_t* kk = (const bf16_t*)(P.ws + OFF_R1); const bf16_t* qq = (const bf16_t*)(P.ws + OFF_R2); const bf16_t* vt = (const bf16_t*)(P.ws + OFF_R4);
    const bf16_t* sz2 = (const bf16_t*)(P.ws + OFF_R4 + 32 * MiB); bf16_t* g2 = (bf16_t*)P.out;
    const int tid = threadIdx.x, wid = tid >> 6, lane = tid & 63, r = lane & 31, hh = lane >> 5;
#define ATT_LOAD_FILL(IT, KV, VV) do { const int _bh = (IT) >> 3, _wlo = ((IT) & 7) * 256 - HIST; const bf16_t* _Kg = kk + (size_t)_bh * SEQ * 64; const bf16_t* _Vg = vt + (size_t)_bh * 64 * SEQ; \
        _Pragma("unroll") for (int i = 0; i < NF; ++i) { const int c = tid + 512 * i, row = c >> 3, part = c & 7, key = _wlo + row; if (key >= 0) KV[i] = *(const u32x4*)(_Kg + (size_t)key * 64 + part * 8); } \
        _Pragma("unroll") for (int i = 0; i < NF; ++i) { const int c = tid + 512 * i, d = c / VCH, part = c - d * VCH, key0 = _wlo + part * 8; if (key0 >= 0) VV[i] = *(const u32x4*)(_Vg + (size_t)d * SEQ + key0); } } while (0)
#define ATT_LOAD_Q(IT, QF) do { const bf16_t* _Qp = qq + ((size_t)((IT) >> 3) * SEQ + ((IT) & 7) * 256 + 32 * wid + r) * 64 + hh * 8; \
        _Pragma("unroll") for (int ks = 0; ks < 4; ++ks) QF[ks] = *(const s16x8*)(_Qp + ks * 16); } while (0)
    u32x4 kv[NF], vv[NF];
    const bool aff = (gridDim.x & 7) == 0; const int islot0 = aff ? (int)(blockIdx.x >> 3) : (int)blockIdx.x, istep = aff ? (int)(gridDim.x >> 3) : (int)gridDim.x, ibase = aff ? (int)(blockIdx.x & 7) * 128 : 0, ilim = aff ? 128 : 1024;
    if (islot0 < ilim) { ATT_LOAD_FILL(ibase + islot0, kv, vv); }
    for (int islot = islot0; islot < ilim; islot += istep) {
        const int item = ibase + islot;
        const int qc = item & 7, bh = item >> 3, t0 = qc * 256, wlo = t0 - HIST, tq = t0 + 32 * wid;
        const bf16_t* Kg = kk + (size_t)bh * SEQ * 64; const bf16_t* Vg = vt + (size_t)bh * 64 * SEQ;
        const int b = bh >> 4, h = bh & 15; const size_t rowo = ((size_t)b * SEQ + tq + r) * DM + h * 64 + 4 * hh;
        asm volatile("s_waitcnt lgkmcnt(0)" ::: "memory"); __builtin_amdgcn_s_barrier(); asm volatile("" ::: "memory");
#pragma unroll
        for (int i = 0; i < NF; ++i) { const int c = tid + 512 * i, row = c >> 3, part = c & 7, key = wlo + row;
            if (key >= 0) *(PG8_LAS u32x4*)(Kl + row * KP + part * 16) = kv[i]; }
#pragma unroll
        for (int i = 0; i < NF; ++i) { const int c = tid + 512 * i, d = c / VCH, part = c - d * VCH, key0 = wlo + part * 8;
            if (key0 >= 0) { PG8_LAS u32x2_t* w = (PG8_LAS u32x2_t*)(Vl + d * VP + part * 16); u32x2_t a = {vv[i].x, vv[i].y}, bb = {vv[i].z, vv[i].w}; w[0] = a; w[1] = bb; } }
        s16x8 qf[4]; ATT_LOAD_Q(item, qf);
        asm volatile("s_waitcnt lgkmcnt(0)" ::: "memory"); __builtin_amdgcn_s_barrier(); asm volatile("" ::: "memory");
        const size_t rowc = ((size_t)b * SEQ + tq + (lane >> 3)) * DM + h * 64 + (lane & 7) * 8;
        u32x4 zc[4];
#pragma unroll
        for (int i = 0; i < 4; ++i) zc[i] = *(const u32x4*)(sz2 + rowc + (size_t)(8 * i) * DM);
        const int nitem = (islot + istep < ilim) ? item + istep : 1024;
        u32x4 kvn[NF], vvn[NF];
        if (nitem < 1024) { ATT_LOAD_FILL(nitem, kvn, vvn); }
        f32x16 o0, o1;
#pragma unroll
        for (int i = 0; i < 16; ++i) { o0[i] = 0.f; o1[i] = 0.f; }
        float carry = 1.f;
        for (int s0 = tq; s0 >= 0; s0 -= 32) {
            s16x8 kf[4]; s16x4 vf[2][2][2];
            if (s0 >= wlo) {
                PG8_LAS const unsigned char* kp = Kl + (s0 - wlo + r) * KP + hh * 16; PG8_LAS const unsigned char* vp = Vl + r * VP + (s0 - wlo + 4 * hh) * 2;
#pragma unroll
                for (int ks = 0; ks < 4; ++ks) kf[ks] = *(PG8_LAS const s16x8*)(kp + ks * 32);
#pragma unroll
                for (int dt = 0; dt < 2; ++dt)
#pragma unroll
                    for (int s = 0; s < 2; ++s)
#pragma unroll
                        for (int pt = 0; pt < 2; ++pt) vf[dt][s][pt] = *(PG8_LAS const s16x4*)(vp + dt * 32 * VP + (16 * s + 8 * pt) * 2);
            } else {
                const bf16_t* kp = Kg + (size_t)(s0 + r) * 64 + hh * 8; const bf16_t* vp = Vg + (size_t)r * SEQ + s0 + 4 * hh;
#pragma unroll
                for (int ks = 0; ks < 4; ++ks) kf[ks] = *(const s16x8*)(kp + ks * 16);
#pragma unroll
                for (int dt = 0; dt < 2; ++dt)
#pragma unroll
                    for (int s = 0; s < 2; ++s)
#pragma unroll
                        for (int pt = 0; pt < 2; ++pt) vf[dt][s][pt] = *(const s16x4*)(vp + (size_t)dt * 32 * SEQ + 16 * s + 8 * pt);
            }
            f32x16 x;
#pragma unroll
            for (int i = 0; i < 16; ++i) x[i] = 0.f;
#pragma unroll
            for (int ks = 0; ks < 4; ++ks) x = MFMA32(kf[ks], qf[ks], x);
            float beta[16], keep[16];
            const bool diag = (s0 == tq);
#pragma unroll
            for (int i = 0; i < 16; ++i) {
                const float l = fmaxf(x[i], -120.f);
                const float e = __builtin_amdgcn_exp2f(-l);
                float bt = __builtin_amdgcn_rcpf(1.f + e), kp = e * bt;
                beta[i] = bt; keep[i] = kp;
            }
            if (diag) {
#pragma unroll
                for (int i = 0; i < 16; ++i) { const bool valid = ((i & 3) + 8 * (i >> 2) + 4 * hh) < r; beta[i] = valid ? beta[i] : 0.f; keep[i] = valid ? keep[i] : 1.f; }
            }
            float Gp[4], PG[4];
#pragma unroll
            for (int g = 0; g < 4; ++g) { Gp[g] = (keep[4 * g] * keep[4 * g + 1]) * (keep[4 * g + 2] * keep[4 * g + 3]); PG[g] = __shfl_xor(Gp[g], 32); }
            float base[4];
            { float so = 1.f, sp = 1.f;
#pragma unroll
              for (int g = 3; g >= 0; --g) { base[g] = carry * so * sp * (hh == 0 ? PG[g] : 1.f); so *= Gp[g]; sp *= PG[g]; }
              carry = carry * so * sp; }
            float a[16];
#pragma unroll
            for (int g = 0; g < 4; ++g) { float run = base[g];
                a[4 * g + 3] = beta[4 * g + 3] * run; run *= keep[4 * g + 3];
                a[4 * g + 2] = beta[4 * g + 2] * run; run *= keep[4 * g + 2];
                a[4 * g + 1] = beta[4 * g + 1] * run; run *= keep[4 * g + 1];
                a[4 * g] = beta[4 * g] * run; }
#pragma unroll
            for (int s = 0; s < 2; ++s) {
                u32x4 pw; pw.x = pk2(a[8 * s], a[8 * s + 1]); pw.y = pk2(a[8 * s + 2], a[8 * s + 3]); pw.z = pk2(a[8 * s + 4], a[8 * s + 5]); pw.w = pk2(a[8 * s + 6], a[8 * s + 7]);
                const s16x8 pf = __builtin_bit_cast(s16x8, pw);
                const s16x8 va = __builtin_shufflevector(vf[0][s][0], vf[0][s][1], 0, 1, 2, 3, 4, 5, 6, 7);
                const s16x8 vb = __builtin_shufflevector(vf[1][s][0], vf[1][s][1], 0, 1, 2, 3, 4, 5, 6, 7);
                o0 = MFMA32(va, pf, o0); o1 = MFMA32(vb, pf, o1);
            }
            if (__all(carry < 1e-12f)) break;
        }
        { PG8_LAS unsigned char* S = lds + WIN * KP + 64 * VP + wid * 4608;
#pragma unroll
          for (int i = 0; i < 4; ++i) *(PG8_LAS u32x4*)(S + ((lane >> 3) + 8 * i) * 144 + (lane & 7) * 16) = zc[i];
          asm volatile("s_waitcnt lgkmcnt(0)" ::: "memory");
          PG8_LAS unsigned char* Sr = S + r * 144 + 8 * hh;
#pragma unroll
          for (int g = 0; g < 4; ++g) {
              const u32x2_t z0 = *(PG8_LAS const u32x2_t*)(Sr + 16 * g), z1 = *(PG8_LAS const u32x2_t*)(Sr + 64 + 16 * g);
              u32x2_t w0, w1;
              w0.x = pk2(o0[4 * g] * bflo(z0.x), o0[4 * g + 1] * bfhi(z0.x)); w0.y = pk2(o0[4 * g + 2] * bflo(z0.y), o0[4 * g + 3] * bfhi(z0.y));
              w1.x = pk2(o1[4 * g] * bflo(z1.x), o1[4 * g + 1] * bfhi(z1.x)); w1.y = pk2(o1[4 * g + 2] * bflo(z1.y), o1[4 * g + 3] * bfhi(z1.y));
              *(PG8_LAS u32x2_t*)(Sr + 16 * g) = w0; *(PG8_LAS u32x2_t*)(Sr + 64 + 16 * g) = w1; }
          asm volatile("s_waitcnt lgkmcnt(0)" ::: "memory");
#pragma unroll
          for (int i = 0; i < 4; ++i) { const u32x4 v = *(PG8_LAS const u32x4*)(S + ((lane >> 3) + 8 * i) * 144 + (lane & 7) * 16); *(u32x4*)(g2 + rowc + (size_t)(8 * i) * DM) = v; }
          asm volatile("s_waitcnt lgkmcnt(0)" ::: "memory"); }
#pragma unroll
        for (int i = 0; i < NF; ++i) { kv[i] = kvn[i]; vv[i] = vvn[i]; }
    }
#undef ATT_LOAD_FILL
#undef ATT_LOAD_Q
}

__global__ __launch_bounds__(512, 2) void yoco_fwd(Params P) {
    extern __shared__ __attribute__((aligned(16))) unsigned char shm[];
    PG8_LAS unsigned char* lds = (PG8_LAS unsigned char*)shm;
    unsigned char* ws = P.ws;
    bf16_t* R1 = (bf16_t*)(ws + OFF_R1); bf16_t* R2 = (bf16_t*)(ws + OFF_R2); bf16_t* R3 = (bf16_t*)(ws + OFF_R3); bf16_t* R4 = (bf16_t*)(ws + OFF_R4);
    float* rstd0 = (float*)(ws + OFF_RSTD0); float* rstd1 = (float*)(ws + OFF_RSTD1); float* ssp = (float*)(ws + OFF_SSP);
    const bf16_t* pb = (const bf16_t*)(ws + OFF_PB); bf16_t* E1b = (bf16_t*)(ws + OFF_E1);
#define PH(k) if (P.ph_lo <= (k) && (k) < P.ph_hi)
#define SYNC(k) if (fused) { if ((k) < 2) xcd_barrier(xb, [&]() { deferred_items(P, (float*)shm, (k)); }); else if ((k) == 2) xcd_barrier(xb, [&]() { shadow_p_convert(P); }); else if (grp_ok) grp_barrier(gb); else xcd_barrier(xb, []() {}); }
    const bool fused = (P.ph_hi - P.ph_lo) > 1;
    volatile LAS unsigned* st = (volatile LAS unsigned*)(lds + LDS_ST);
    unsigned* bar = (unsigned*)(ws + OFF_BAR);
    if (fused) { if (threadIdx.x == 0) { st[0] = 0u; st[1] = 0u; } __syncthreads(); }
    XcdBarrier xb; xb.bar = bar; xb.x = 0u; xb.st = st;
    if (fused) xb = xcd_barrier_post(bar, st);
    unsigned* gtab = (unsigned*)(ws + OFF_BAR + 16384 + 8192);
    if (fused && threadIdx.x == 0) gtab[blockIdx.x] = xb.x;
    bool grp_ok = false;
    GrpBarrier gb;
    PH(0) phase0(P, (float*)shm);
    SYNC(0)
    gb.cnt = (unsigned*)(ws + OFF_BAR + 16384) + 64 * (blockIdx.x & 7); gb.gen = (unsigned*)(ws + OFF_BAR + 16384 + 4096) + 64 * (blockIdx.x & 7); gb.tmo = bar + XB_TMO; gb.nmem = gridDim.x >> 3;
    if (fused) { const int t = threadIdx.x; int pred = 1;
        if (gridDim.x == 256 && t < 256) pred = (gtab[t] == gtab[t & 7]);
        grp_ok = (gridDim.x == 256) && (__syncthreads_and(pred) != 0); }
    PH(1) { Epi1 E{R2, R3, rstd0}; run_gemm(lds, R1, (const bf16_t*)(ws + OFF_WIN1), M_TOK, 2048, 1024, E); }
    SYNC(1)
    PH(2) pool_phase(P);
    SYNC(2)
    PH(3) { EpiResB<true> E{P.x, nullptr, R2}; run_gemm(lds, R1, (const bf16_t*)(ws + OFF_WAOUT), M_TOK, 1024, 1024, E); }
    SYNC(3)
    PH(4) { SchedPG S{ws, 0, (int)gridDim.x, (int)blockIdx.x}; EpiPG<true> E{EpiE{E1b}, EpiGate<true>{R2, E1b, R3, rstd1, nullptr}}; pg8::gemm_stream(lds, S, E); }
    SYNC(4)
    PH(6) { SchedP6 S{ws, (int)gridDim.x, (int)blockIdx.x};
            EpiP6 E{EpiKQZ{R1, R2, R4 + (size_t)M_TOK * DM, rstd1, P.k_norm, P.b_q_norm}, EpiVT{R4, rstd1}}; pg8::gemm_stream(lds, S, E); }
    SYNC(6)
    PH(7) attn_phase(P, lds);
    SYNC(7)
    PH(8) { EpiResB<false> E{nullptr, R3, R2}; run_gemm(lds, (const bf16_t*)P.out, (const bf16_t*)(ws + OFF_WBOUT), M_TOK, 1024, 1024, E); }
    SYNC(8)
    PH(9) { SchedPG S{ws, 1, (int)gridDim.x, (int)blockIdx.x}; EpiPG<false> E{EpiE{E1b}, EpiGate<false>{R2, E1b, nullptr, nullptr, P.out}}; pg8::gemm_stream(lds, S, E); }
}

extern "C" void kernel_launch(void* const* d_in, const int* in_sizes, int n_in, void* d_out, int out_size, void* d_ws, size_t ws_size, hipStream_t stream) {
    static int grid = 0;
    if (grid == 0) {
        int dev = 0, cus = 0, per_cu = 0;
        if (n_in != 16 || out_size != M_TOK * DM || ws_size < WS_END) { fprintf(stderr, "kernel_launch: unexpected shapes (n_in %d out %d ws %zu)\n", n_in, out_size, ws_size); grid = -1; return; }
        (void)hipGetDevice(&dev); (void)hipDeviceGetAttribute(&cus, hipDeviceAttributeMultiprocessorCount, dev);
        if (hipFuncSetAttribute((const void*)yoco_fwd, hipFuncAttributeMaxDynamicSharedMemorySize, LDS_BYTES) != hipSuccess) { fprintf(stderr, "kernel_launch: hipFuncSetAttribute failed\n"); grid = -1; return; }
        (void)hipOccupancyMaxActiveBlocksPerMultiprocessor(&per_cu, (const void*)yoco_fwd, 512, LDS_BYTES);
        if (per_cu < 1) { fprintf(stderr, "kernel_launch: occupancy query says %d blocks per CU\n", per_cu); (void)hipGetLastError(); per_cu = 1; }
        grid = cus;
    }
    if (grid < 0) return;
    Params p{};
    const float** pp = (const float**)&p;
    for (int i = 0; i < 16; ++i) pp[i] = (const float*)d_in[i];
    p.out = (float*)d_out; p.ws = (unsigned char*)d_ws;
    p.ph_lo = 0; p.ph_hi = NPHASE;
    if (hipMemsetAsync((unsigned char*)d_ws + OFF_BAR, 0, 32768, stream) != hipSuccess) { fprintf(stderr, "kernel_launch: memset of the barrier words failed\n"); return; }
    void* args[] = {&p};
    hipError_t e = hipLaunchCooperativeKernel((const void*)yoco_fwd, dim3(grid), dim3(512), args, LDS_BYTES, stream);
    if (e != hipSuccess) fprintf(stderr, "kernel_launch: cooperative launch failed: %s (grid %d)\n", hipGetErrorString(e), grid);
}
```

```cpp
#include <hip/hip_runtime.h>
#include <cstdio>
namespace pg8 {
#define PG8_LAS __attribute__((address_space(3)))
typedef unsigned short bf16_t;
typedef short bf16x8 __attribute__((ext_vector_type(8)));
typedef float f32x4 __attribute__((ext_vector_type(4)));
typedef unsigned u32x4 __attribute__((ext_vector_type(4)));
constexpr int BM = 256, BK = 64, HALF = 128, HTB = HALF * BK * 2  , STAGE_BYTES = 8 * HTB, NXCD = 8, WGM = 8;

__host__ __device__ __forceinline__ int lds_byte(int r, int c) { const int st = (r >> 4) * 2 + (c >> 5), rr = r & 15, cc = c & 31, ob = rr * 64 + cc * 2; return st * 1024 + (ob ^ (((ob >> 9) & 1) << 5)); }
__host__ __device__ __forceinline__ void stage_rc(int b, int& R, int& C) { const int st = b / 1024, sb = b % 1024, swz = sb ^ (((sb >> 9) & 1) << 5); R = (st >> 1) * 16 + swz / 64; C = (st & 1) * 32 + (swz % 64) / 2; }
__host__ __device__ __forceinline__ int perm32(int rho) { const int n = rho >> 4, i = rho & 15; return 8 * (i >> 2) + 4 * n + (i & 3); }

struct Unit { int pm, pn; };
struct Gemm { const bf16_t* A; const bf16_t* Bt; int M, N, K; };
struct StaticOrder {
    int nM, nN, nwg, G, c;
    __host__ __device__ void init(int M, int N, int G_, int c_) { nM = M / BM; nN = N / BM; nwg = nM * nN; G = G_; c = c_; }
    __host__ __device__ bool next(int i, Unit& u) const {
        const long L = (long)i * G + c; if (L >= nwg) return false;
        int wgid = (int)L; { const int q = nwg / NXCD, r = nwg % NXCD, xcd = wgid % NXCD, off = wgid / NXCD; wgid = (xcd < r ? xcd * (q + 1) : r * (q + 1) + (xcd - r) * q) + off; }
        const int nig = WGM * nN, gid = wgid / nig, fm = gid * WGM, gsz = (nM - fm) < WGM ? (nM - fm) : WGM;
        u.pm = fm + ((wgid % nig) % gsz); u.pn = (wgid % nig) / gsz; return true;
    }
    __device__ __forceinline__ void a_ready(const Unit&) const {}
    __device__ __forceinline__ void done(const Unit&) const {}
};
template <class Epi, class Sched, bool STAMP = false>
__device__ __forceinline__ void gemm_phase(PG8_LAS unsigned char* lds, const Gemm g, const Sched& S, const Epi& E, unsigned long long* stamps) {
    const int tid = threadIdx.x, wid = __builtin_amdgcn_readfirstlane(tid >> 6), lane = tid & 63, wr = wid >> 2, wc = wid & 3, fr = lane & 15, fq = lane >> 4;
    const int K = g.K, nt = K / BK;
    int ts_lo = 0, ts_hi = 0, nts = 0; const unsigned long long rt_entry = STAMP ? (unsigned long long)wall_clock64() : 0ull;
#define PG8_STAMP() do { if (STAMP && wid == 0 && nts < 64) { const unsigned long long _c = (unsigned long long)clock64(); \
        ts_lo = (lane == nts) ? (int)(unsigned)_c : ts_lo; ts_hi = (lane == nts) ? (int)(unsigned)(_c >> 32) : ts_hi; ++nts; } } while (0)
    PG8_STAMP();
    unsigned voffA[2], voffB[2];
#pragma unroll
    for (int i = 0; i < 2; ++i) { int R, C; stage_rc(tid * 16 + i * 8192, R, C); const int Rb = Epi::PERM ? ((R & ~31) + perm32(R & 31)) : R;
        voffA[i] = (unsigned)(R * K + C) * 2u; voffB[i] = (unsigned)(Rb * K + C) * 2u; }
    const size_t kstep = (size_t)(BK * 2);
    const size_t hstep = (size_t)HALF * K * 2;
    const size_t tstep = 2 * hstep;
    const unsigned ldsw = (unsigned)wid * 1024u;
    const int aoff = lds_byte(wr * 64 + fr, fq * 8), boff = lds_byte(wc * 32 + fr, fq * 8);
#define PG8_SA(b, h) (((b) * 2 + (h)) * HTB)
#define PG8_SB(b, h) ((4 + (b) * 2 + (h)) * HTB)
#define PG8_STAGE(bufoff, gbase, voff) do { _Pragma("unroll") for (int _i = 0; _i < 2; ++_i) \
        __builtin_amdgcn_global_load_lds((const unsigned*)((const char*)(gbase) + (voff)[_i]), (PG8_LAS unsigned*)(lds + (bufoff) + ldsw + _i * 8192), 16, 0, 0); } while (0)
#define PG8_LDA(dst, b, h) do { _Pragma("unroll") for (int m = 0; m < 4; ++m) _Pragma("unroll") for (int k = 0; k < 2; ++k) dst[m][k] = *(const PG8_LAS bf16x8*)(lds + PG8_SA(b, h) + aoff + m * 2048 + k * 1024); } while (0)
#define PG8_LDB(dst, b, h) do { _Pragma("unroll") for (int n = 0; n < 2; ++n) _Pragma("unroll") for (int k = 0; k < 2; ++k) dst[n][k] = *(const PG8_LAS bf16x8*)(lds + PG8_SB(b, h) + boff + n * 2048 + k * 1024); } while (0)
#define PG8_MMA(ai, bj, At, Bt) do { __builtin_amdgcn_s_setprio(1); _Pragma("unroll") for (int m = 0; m < 4; ++m) _Pragma("unroll") for (int n = 0; n < 2; ++n) _Pragma("unroll") for (int k = 0; k < 2; ++k) \
        acc[ai][bj][m][n] = __builtin_amdgcn_mfma_f32_16x16x32_bf16(Bt[n][k], At[m][k], acc[ai][bj][m][n], 0, 0, 0); __builtin_amdgcn_s_setprio(0); } while (0)
#define PG8_WAIT_V(n) asm volatile("s_waitcnt vmcnt(" #n ")" ::: "memory")
#define PG8_WAIT_L(n) asm volatile("s_waitcnt lgkmcnt(" #n ")" ::: "memory")
#define PG8_BAR __builtin_amdgcn_s_barrier()
#define PG8_SCHED __builtin_amdgcn_sched_barrier(0)
    Unit cur, nxt; int ui = 0;
    if (!S.next(0, cur)) return;
    f32x4 acc[2][2][4][2];
#pragma unroll
    for (int a = 0; a < 2; ++a)
#pragma unroll
        for (int b = 0; b < 2; ++b)
#pragma unroll
            for (int m = 0; m < 4; ++m)
#pragma unroll
                for (int n = 0; n < 2; ++n) acc[a][b][m][n] = (f32x4){0.f, 0.f, 0.f, 0.f};
    bf16x8 At[4][2], B0[2][2], B1[2][2];
    const char* cA = (const char*)g.A + (size_t)cur.pm * tstep; const char* cB = (const char*)g.Bt + (size_t)cur.pn * tstep;
    S.a_ready(cur);
    PG8_STAGE(PG8_SB(0, 0), cB, voffB); PG8_STAGE(PG8_SA(0, 0), cA, voffA); PG8_STAGE(PG8_SB(0, 1), cB + hstep, voffB); PG8_STAGE(PG8_SA(0, 1), cA + hstep, voffA);
    if (wr == 1) PG8_BAR;
    PG8_WAIT_V(4); PG8_BAR;
    PG8_STAGE(PG8_SB(1, 0), cB + kstep, voffB); PG8_STAGE(PG8_SA(1, 0), cA + kstep, voffA); PG8_STAGE(PG8_SB(1, 1), cB + hstep + kstep, voffB);
    PG8_WAIT_V(6); PG8_BAR;
    PG8_STAMP();
    for (;;) {
        const bool has_next = S.next(ui + 1, nxt);
        const char* nA = has_next ? (const char*)g.A + (size_t)nxt.pm * tstep : cA; const char* nB = has_next ? (const char*)g.Bt + (size_t)nxt.pn * tstep : cB;
        for (int t = 0; t < nt; t += 2) {
            const bool last = (t == nt - 2);
            const char* a1 = cA + (size_t)(t + 1) * kstep;
            const char* a2 = last ? nA : cA + (size_t)(t + 2) * kstep; const char* b2 = last ? nB : cB + (size_t)(t + 2) * kstep;
            const char* a3 = a2 + kstep; const char* b3 = b2 + kstep;
            if (last && has_next) S.a_ready(nxt);
            PG8_LDB(B0, 0, 0); PG8_SCHED; PG8_LDA(At, 0, 0); PG8_STAGE(PG8_SA(1, 1), a1 + hstep, voffA);
            PG8_WAIT_L(8); PG8_BAR; PG8_WAIT_L(0); PG8_MMA(0, 0, At, B0); PG8_BAR; PG8_SCHED;
            PG8_LDB(B1, 0, 1); PG8_STAGE(PG8_SB(0, 0), b2, voffB);
            PG8_BAR; PG8_WAIT_L(0); PG8_MMA(0, 1, At, B1); PG8_BAR;
            PG8_LDA(At, 0, 1); PG8_STAGE(PG8_SA(0, 0), a2, voffA);
            PG8_BAR; PG8_WAIT_L(0); PG8_MMA(1, 0, At, B0); PG8_BAR; PG8_SCHED;
            PG8_STAGE(PG8_SB(0, 1), b2 + hstep, voffB);
            PG8_WAIT_V(6); PG8_BAR; PG8_MMA(1, 1, At, B1); PG8_BAR;
            PG8_LDB(B0, 1, 0); PG8_SCHED; PG8_LDA(At, 1, 0); PG8_STAGE(PG8_SA(0, 1), a2 + hstep, voffA);
            PG8_WAIT_L(8); PG8_BAR; PG8_WAIT_L(0); PG8_MMA(0, 0, At, B0); PG8_BAR; PG8_SCHED;
            PG8_LDB(B1, 1, 1); PG8_STAGE(PG8_SB(1, 0), b3, voffB);
            PG8_BAR; PG8_WAIT_L(0); PG8_MMA(0, 1, At, B1); PG8_BAR;
            PG8_LDA(At, 1, 1); PG8_STAGE(PG8_SA(1, 0), a3, voffA);
            PG8_BAR; PG8_WAIT_L(0); PG8_MMA(1, 0, At, B0); PG8_BAR; PG8_SCHED;
            PG8_STAGE(PG8_SB(1, 1), b3 + hstep, voffB);
            PG8_WAIT_V(6); PG8_BAR; PG8_MMA(1, 1, At, B1); PG8_BAR;
        }
        PG8_STAMP();
        if constexpr (!Epi::AFTER_DRAIN) { E(acc, cur, wr, wc, fr, fq); S.done(cur); }
        PG8_STAMP();
        if (!has_next) break;
#pragma unroll
        for (int a = 0; a < 2; ++a)
#pragma unroll
            for (int b = 0; b < 2; ++b)
#pragma unroll
                for (int m = 0; m < 4; ++m)
#pragma unroll
                    for (int n = 0; n < 2; ++n) acc[a][b][m][n] = (f32x4){0.f, 0.f, 0.f, 0.f};
        cur = nxt; cA = nA; cB = nB; ++ui;
    }
    PG8_WAIT_V(0);
    if (wr == 0) PG8_BAR;
    PG8_BAR;
    if constexpr (Epi::AFTER_DRAIN) { E.fused(acc, cur, wr, wc, fr, fq, lds, wid, lane); S.done(cur); }
    PG8_STAMP();
    if (STAMP && wid == 0) { stamps[lane] = lane < nts ? (((unsigned long long)(unsigned)ts_hi << 32) | (unsigned)ts_lo) : 0ull;
        if (lane == 62) stamps[62] = rt_entry; if (lane == 63) stamps[63] = (unsigned long long)wall_clock64(); }
#undef PG8_STAMP
#undef PG8_SA
#undef PG8_SB
#undef PG8_STAGE
#undef PG8_LDA
#undef PG8_LDB
#undef PG8_MMA
#undef PG8_WAIT_V
#undef PG8_WAIT_L
#undef PG8_BAR
#undef PG8_SCHED
}
}
namespace pg8 {
struct UnitX { int pm, pn, kind; };
struct GDesc { const bf16_t* A; const bf16_t* Bt; int ks; };
__device__ __forceinline__ void map_unit(int L, int nM, int nN, int& pm, int& pn) {
    const int nwg = nM * nN; int wgid = L; { const int q = nwg / NXCD, r = nwg % NXCD, xcd = wgid % NXCD, off = wgid / NXCD; wgid = (xcd < r ? xcd * (q + 1) : r * (q + 1) + (xcd - r) * q) + off; }
    const int nig = WGM * nN, gid = wgid / nig, fm = gid * WGM, gsz = (nM - fm) < WGM ? (nM - fm) : WGM;
    pm = fm + ((wgid % nig) % gsz); pn = (wgid % nig) / gsz;
}
template <class Epi, class Sched>
__device__ __forceinline__ void gemm_stream(PG8_LAS unsigned char* lds, const Sched& S, const Epi& E) {
    const int tid = threadIdx.x, wid = __builtin_amdgcn_readfirstlane(tid >> 6), lane = tid & 63, wr = wid >> 2, wc = wid & 3, fr = lane & 15, fq = lane >> 4;
    const size_t kstep = (size_t)(BK * 2);
    const unsigned ldsw = (unsigned)wid * 1024u;
    const int aoff = lds_byte(wr * 64 + fr, fq * 8), boff = lds_byte(wc * 32 + fr, fq * 8);
#define PG8_SA(b, h) (((b) * 2 + (h)) * HTB)
#define PG8_SB(b, h) ((4 + (b) * 2 + (h)) * HTB)
#define PG8_STAGE(bufoff, gbase, voff) do { _Pragma("unroll") for (int _i = 0; _i < 2; ++_i) \
        __builtin_amdgcn_global_load_lds((const unsigned*)((const char*)(gbase) + (voff)[_i]), (PG8_LAS unsigned*)(lds + (bufoff) + ldsw + _i * 8192), 16, 0, 0); } while (0)
#define PG8_LDA(dst, b, h) do { _Pragma("unroll") for (int m = 0; m < 4; ++m) _Pragma("unroll") for (int k = 0; k < 2; ++k) dst[m][k] = *(const PG8_LAS bf16x8*)(lds + PG8_SA(b, h) + aoff + m * 2048 + k * 1024); } while (0)
#define PG8_LDB(dst, b, h) do { _Pragma("unroll") for (int n = 0; n < 2; ++n) _Pragma("unroll") for (int k = 0; k < 2; ++k) dst[n][k] = *(const PG8_LAS bf16x8*)(lds + PG8_SB(b, h) + boff + n * 2048 + k * 1024); } while (0)
#define PG8_MMA(ai, bj, At, Bt) do { __builtin_amdgcn_s_setprio(1); _Pragma("unroll") for (int m = 0; m < 4; ++m) _Pragma("unroll") for (int n = 0; n < 2; ++n) _Pragma("unroll") for (int k = 0; k < 2; ++k) \
        acc[ai][bj][m][n] = __builtin_amdgcn_mfma_f32_16x16x32_bf16(Bt[n][k], At[m][k], acc[ai][bj][m][n], 0, 0, 0); __builtin_amdgcn_s_setprio(0); } while (0)
#define PG8_WAIT_V(n) asm volatile("s_waitcnt vmcnt(" #n ")" ::: "memory")
#define PG8_WAIT_L(n) asm volatile("s_waitcnt lgkmcnt(" #n ")" ::: "memory")
#define PG8_BAR __builtin_amdgcn_s_barrier()
#define PG8_SCHED __builtin_amdgcn_sched_barrier(0)
    UnitX cur, nxt; int ui = 0;
    if (!S.next(0, cur)) return;
    f32x4 acc[2][2][4][2];
#pragma unroll
    for (int a = 0; a < 2; ++a)
#pragma unroll
        for (int b = 0; b < 2; ++b)
#pragma unroll
            for (int m = 0; m < 4; ++m)
#pragma unroll
                for (int n = 0; n < 2; ++n) acc[a][b][m][n] = (f32x4){0.f, 0.f, 0.f, 0.f};
    bf16x8 At[4][2], B0[2][2], B1[2][2];
    GDesc dc = S.desc(cur.kind);
    int ksC = dc.ks; size_t hsC = (size_t)HALF * ksC * 2;
    unsigned vAc[2], vBc[2];
#pragma unroll
    for (int i = 0; i < 2; ++i) { int R, C; stage_rc(tid * 16 + i * 8192, R, C); const int Rb = (R & ~31) + perm32(R & 31);
        vAc[i] = (unsigned)(R * ksC + C) * 2u; vBc[i] = (unsigned)(Rb * ksC + C) * 2u; }
    int shC = 31 - __builtin_clz((unsigned)ksC * 2u);
    const char* cA = (const char*)dc.A + (size_t)cur.pm * 2 * hsC; const char* cB = (const char*)dc.Bt + (size_t)cur.pn * 2 * hsC;
    PG8_STAGE(PG8_SB(0, 0), cB, vBc); PG8_STAGE(PG8_SA(0, 0), cA, vAc); PG8_STAGE(PG8_SB(0, 1), cB + hsC, vBc); PG8_STAGE(PG8_SA(0, 1), cA + hsC, vAc);
    if (wr == 1) PG8_BAR;
    PG8_WAIT_V(4); PG8_BAR;
    PG8_STAGE(PG8_SB(1, 0), cB + kstep, vBc); PG8_STAGE(PG8_SA(1, 0), cA + kstep, vAc); PG8_STAGE(PG8_SB(1, 1), cB + hsC + kstep, vBc);
    PG8_WAIT_V(6); PG8_BAR;
    for (;;) {
        const bool has_next = S.next(ui + 1, nxt);
        const char* nA = cA; const char* nB = cB; int ksN = ksC; size_t hsN = hsC;
        if (has_next) { const GDesc dn = S.desc(nxt.kind); ksN = dn.ks; hsN = (size_t)HALF * ksN * 2;
            nA = (const char*)dn.A + (size_t)nxt.pm * 2 * hsN; nB = (const char*)dn.Bt + (size_t)nxt.pn * 2 * hsN; }
        const int shN = 31 - __builtin_clz((unsigned)ksN * 2u); const unsigned cmask = (unsigned)ksC * 2u - 1u;
        const int nt = ksC / BK;
        for (int t = 0; t < nt; t += 2) {
            const bool last = (t == nt - 2);
            const char* a1 = cA + (size_t)(t + 1) * kstep;
            const char* a2 = last ? nA : cA + (size_t)(t + 2) * kstep; const char* b2 = last ? nB : cB + (size_t)(t + 2) * kstep;
            const char* a3 = a2 + kstep; const char* b3 = b2 + kstep;
            const size_t hs2 = last ? hsN : hsC;
            unsigned vA2[2], vB2[2];
#pragma unroll
            for (int i = 0; i < 2; ++i) { vA2[i] = last ? (((vAc[i] >> shC) << shN) | (vAc[i] & cmask)) : vAc[i]; vB2[i] = last ? (((vBc[i] >> shC) << shN) | (vBc[i] & cmask)) : vBc[i]; }
            PG8_LDB(B0, 0, 0); PG8_SCHED; PG8_LDA(At, 0, 0); PG8_STAGE(PG8_SA(1, 1), a1 + hsC, vAc);
            PG8_WAIT_L(8); PG8_BAR; PG8_WAIT_L(0); PG8_MMA(0, 0, At, B0); PG8_BAR; PG8_SCHED;
            PG8_LDB(B1, 0, 1); PG8_STAGE(PG8_SB(0, 0), b2, vB2);
            PG8_BAR; PG8_WAIT_L(0); PG8_MMA(0, 1, At, B1); PG8_BAR;
            PG8_LDA(At, 0, 1); PG8_STAGE(PG8_SA(0, 0), a2, vA2);
            PG8_BAR; PG8_WAIT_L(0); PG8_MMA(1, 0, At, B0); PG8_BAR; PG8_SCHED;
            PG8_STAGE(PG8_SB(0, 1), b2 + hs2, vB2);
            PG8_WAIT_V(6); PG8_BAR; PG8_MMA(1, 1, At, B1); PG8_BAR;
            PG8_LDB(B0, 1, 0); PG8_SCHED; PG8_LDA(At, 1, 0); PG8_STAGE(PG8_SA(0, 1), a2 + hs2, vA2);
            PG8_WAIT_L(8); PG8_BAR; PG8_WAIT_L(0); PG8_MMA(0, 0, At, B0); PG8_BAR; PG8_SCHED;
            PG8_LDB(B1, 1, 1); PG8_STAGE(PG8_SB(1, 0), b3, vB2);
            PG8_BAR; PG8_WAIT_L(0); PG8_MMA(0, 1, At, B1); PG8_BAR;
            PG8_LDA(At, 1, 1); PG8_STAGE(PG8_SA(1, 0), a3, vA2);
            PG8_BAR; PG8_WAIT_L(0); PG8_MMA(1, 0, At, B0); PG8_BAR; PG8_SCHED;
            PG8_STAGE(PG8_SB(1, 1), b3 + hs2, vB2);
            PG8_WAIT_V(6); PG8_BAR; PG8_MMA(1, 1, At, B1); PG8_BAR;
        }
        E(acc, cur, wr, wc, fr, fq);
        if (!has_next) break;
#pragma unroll
        for (int a = 0; a < 2; ++a)
#pragma unroll
            for (int b = 0; b < 2; ++b)
#pragma unroll
                for (int m = 0; m < 4; ++m)
#pragma unroll
                    for (int n = 0; n < 2; ++n) acc[a][b][m][n] = (f32x4){0.f, 0.f, 0.f, 0.f};
#pragma unroll
        for (int i = 0; i < 2; ++i) { vAc[i] = ((vAc[i] >> shC) << shN) | (vAc[i] & cmask); vBc[i] = ((vBc[i] >> shC) << shN) | (vBc[i] & cmask); }
        cur = nxt; cA = nA; cB = nB; ksC = ksN; hsC = hsN; shC = shN; ++ui;
    }
    PG8_WAIT_V(0);
    if (wr == 0) PG8_BAR;
    PG8_BAR;
#undef PG8_SA
#undef PG8_SB
#undef PG8_STAGE
#undef PG8_LDA
#undef PG8_LDB
#undef PG8_MMA
#undef PG8_WAIT_V
#undef PG8_WAIT_L
#undef PG8_BAR
#undef PG8_SCHED
}
}
#define XB_TMO      128
#define XB_XCNT(j)  (256  + 64 * (j))
#define XB_XSUB(j)  (1280 + 64 * (j))
#define XB_XGEN(j)  (2304 + 64 * (j))
#define XB_TOP      3328
#define XB_TOPGEN   3392
#define XCD_BAR_WORDS 3456
#define XB_SPIN_CAP (1u << 18)
#define LAS __attribute__((address_space(3)))
__device__ __forceinline__ unsigned xb_ld(unsigned* p)              { return __hip_atomic_load(p, __ATOMIC_RELAXED, __HIP_MEMORY_SCOPE_AGENT); }
__device__ __forceinline__ unsigned xb_add(unsigned* p, unsigned v) { return __hip_atomic_fetch_add(p, v, __ATOMIC_RELAXED, __HIP_MEMORY_SCOPE_AGENT); }
__device__ __forceinline__ unsigned xb_xcc_id() { return (unsigned)__builtin_amdgcn_s_getreg((3 << 11) | 20) & 0xFu; }
#define XB_SPIN(cond, bar) do { unsigned _sp = 0; while (cond) { __builtin_amdgcn_s_sleep(1); \
    if ((++_sp & 255u) == 0u) { if (xb_ld(&(bar)[XB_TMO])) break; if (_sp > XB_SPIN_CAP) { atomicAdd(&(bar)[XB_TMO], 1u); break; } } } } while (0)

struct XcdBarrier {
    unsigned* bar; unsigned x;
    volatile LAS unsigned* st;
};

__device__ __forceinline__ XcdBarrier xcd_barrier_post(unsigned* bar, volatile LAS unsigned* st) {
    XcdBarrier b; b.bar = bar; b.x = xb_xcc_id(); b.st = st;
    if (threadIdx.x == 0) (void)xb_add(&bar[XB_XCNT(b.x)], 1u);
    return b;
}
__device__ __forceinline__ void xcd_barrier_complete(unsigned* bar, unsigned x, unsigned& nloc, unsigned& nx) {
    const unsigned G = gridDim.x * gridDim.y * gridDim.z;
    unsigned sum, cnt, mine, sp = 0u;
    for (;;) {
        sum = 0u; cnt = 0u; mine = 0u;
#pragma unroll
        for (unsigned j = 0; j < 16; ++j) { const unsigned c = xb_ld(&bar[XB_XCNT(j)]); sum += c; cnt += (c > 0u) ? 1u : 0u; mine = (j == x) ? c : mine; }
        if (sum == G) break;
        __builtin_amdgcn_s_sleep(1);
        if ((++sp & 255u) == 0u) { if (xb_ld(&bar[XB_TMO])) break; if (sp > XB_SPIN_CAP) { atomicAdd(&bar[XB_TMO], 1u); break; } }
    }
    nloc = mine > 0u ? mine : 1u; nx = cnt > 0u ? cnt : 1u;
}

template <class F> __device__ __forceinline__ void xcd_barrier(const XcdBarrier& b, F&& shadow) {
    asm volatile("s_waitcnt vmcnt(0)" ::: "memory");
    __syncthreads();
    if (threadIdx.x == 0) {
        unsigned* bar = b.bar;
        __builtin_amdgcn_s_waitcnt(0);
        unsigned nloc = b.st[0], nx = b.st[1];
        if (nloc == 0u) { xcd_barrier_complete(bar, b.x, nloc, nx); b.st[0] = nloc; b.st[1] = nx; }
        const unsigned old = xb_add(&bar[XB_XSUB(b.x)], 1u);
        const unsigned gen = old / nloc;
        if (old + 1u == (gen + 1u) * nloc) {
            __builtin_amdgcn_fence(__ATOMIC_RELEASE, "agent");
            asm volatile("s_waitcnt vmcnt(0)" ::: "memory");
            const unsigned og = xb_add(&bar[XB_TOP], 1u);
            const unsigned tg = og / nx;
            if (og + 1u == (tg + 1u) * nx) xb_add(&bar[XB_TOPGEN], 1u);
            else XB_SPIN(xb_ld(&bar[XB_TOPGEN]) == tg, bar);
            __builtin_amdgcn_fence(__ATOMIC_ACQUIRE, "agent");
            xb_add(&bar[XB_XGEN(b.x)], 1u);
            asm volatile("s_waitcnt vmcnt(0)" ::: "memory");
        } else {
            XB_SPIN(xb_ld(&bar[XB_XGEN(b.x)]) == gen, bar);
            __builtin_amdgcn_fence(__ATOMIC_ACQUIRE, "agent");
            asm volatile("s_waitcnt vmcnt(0)" ::: "memory");
        }
    } else if (threadIdx.x >= 64) shadow();
    __syncthreads();
}
using pg8::f32x4; using pg8::u32x4; using pg8::bf16_t; using pg8::Unit;
#define DI __device__ __forceinline__
constexpr int M_TOK = 16384, DM = 1024, SEQ = 2048, NPHASE = 10;
constexpr float EPS = 1e-6f;
constexpr int LDS_ST = 147456, LDS_BYTES = LDS_ST + 16;
constexpr size_t MiB = 1024 * 1024;
constexpr size_t OFF_WIN1 = 0, OFF_WAOUT = 4 * MiB, OFF_WPLE0 = 6 * MiB, OFF_WPLE1 = 6 * MiB + 512 * 1024, OFF_WG0 = 7 * MiB, OFF_WG1 = 9 * MiB,
                 OFF_WKQZ = 11 * MiB, OFF_WV = 17 * MiB, OFF_WBOUT = 19 * MiB, OFF_PB = 21 * MiB, OFF_R1 = 37 * MiB, OFF_R2 = 69 * MiB, OFF_R3 = 101 * MiB,
                 OFF_R4 = 133 * MiB, OFF_RSTD0 = 197 * MiB, OFF_RSTD1 = 197 * MiB + 65536, OFF_SSP = 197 * MiB + 131072, OFF_BAR = 199 * MiB, OFF_E1 = 200 * MiB, WS_END = 232 * MiB;

struct Params {
    const float *x, *p, *a_norm, *a_w_in, *a_w_group, *a_scale, *a_w_out, *kv_norm, *w_kv, *k_norm, *b_norm, *b_w_in, *b_q_norm, *b_w_out, *ple_w, *ple_gate_w;
    float* out; unsigned char* ws; int ph_lo, ph_hi;
};

typedef __bf16 bf16x2_t __attribute__((ext_vector_type(2)));
typedef float f32x2_t __attribute__((ext_vector_type(2)));
typedef unsigned u32x2_t __attribute__((ext_vector_type(2)));
typedef short s16x8 __attribute__((ext_vector_type(8)));
typedef short s16x4 __attribute__((ext_vector_type(4)));
typedef float f32x16 __attribute__((ext_vector_type(16)));
DI unsigned pk2(float lo, float hi) { f32x2_t v = {lo, hi}; bf16x2_t r = __builtin_convertvector(v, bf16x2_t); return __builtin_bit_cast(unsigned, r); }
DI float bflo(unsigned u) { return __uint_as_float(u << 16); }
DI float bfhi(unsigned u) { return __uint_as_float(u & 0xffff0000u); }
DI u32x4 pk8(f32x4 a, f32x4 b) { u32x4 w; w.x = pk2(a[0], a[1]); w.y = pk2(a[2], a[3]); w.z = pk2(b[0], b[1]); w.w = pk2(b[2], b[3]); return w; }
DI int xcd_affine_id() { const int G = (int)gridDim.x, w = (int)blockIdx.x; return (G & 7) ? w : (w & 7) * (G >> 3) + (w >> 3); }
DI float wave_sum(float v) {
#pragma unroll
    for (int o = 1; o < 64; o <<= 1) v += __shfl_xor(v, o);
    return v;
}
DI float sigm(float v) { return __builtin_amdgcn_rcpf(1.f + __expf(-v)); }
DI f32x4 silu4(f32x4 v) { f32x4 r; r[0] = v[0] * sigm(v[0]); r[1] = v[1] * sigm(v[1]); r[2] = v[2] * sigm(v[2]); r[3] = v[3] * sigm(v[3]); return r; }
DI f32x4 sigm4(f32x4 v) { f32x4 r; r[0] = sigm(v[0]); r[1] = sigm(v[1]); r[2] = sigm(v[2]); r[3] = sigm(v[3]); return r; }

typedef const f32x4 (&AccRef)[2][2][4][2];

struct Epi1 {
    static constexpr bool PERM = true, AFTER_DRAIN = false;
    bf16_t* ug; bf16_t* sz; const float* rstd0;
    DI void operator()(AccRef acc, const Unit& u, int wr, int wc, int fr, int fq) const {
        const int row0 = u.pm * 256 + wr * 64 + fr; const bool isz = u.pn >= 4;
        bf16_t* base = (isz ? sz : ug) + (u.pn & 3) * 256 + wc * 32 + 8 * fq;
        float rsv[2][4];
#pragma unroll
        for (int ai = 0; ai < 2; ++ai)
#pragma unroll
            for (int m = 0; m < 4; ++m) rsv[ai][m] = rstd0[row0 + ai * 128 + m * 16];
#pragma unroll
        for (int ai = 0; ai < 2; ++ai)
#pragma unroll
            for (int m = 0; m < 4; ++m) { const int row = row0 + ai * 128 + m * 16; const float rs = rsv[ai][m]; bf16_t* rowp = base + (size_t)row * DM;
#pragma unroll
                for (int bj = 0; bj < 2; ++bj) { f32x4 v0 = acc[ai][bj][m][0] * rs, v1 = acc[ai][bj][m][1] * rs;
                    if (isz) { v0 = silu4(v0); v1 = silu4(v1); }
                    *(u32x4*)(rowp + bj * 128) = pk8(v0, v1); } }
    }
};
struct EpiE {
    static constexpr bool PERM = true, AFTER_DRAIN = false;
    bf16_t* e;
    DI void operator()(AccRef acc, const Unit& u, int wr, int wc, int fr, int fq) const {
        const int row0 = u.pm * 256 + wr * 64 + fr; bf16_t* base = e + u.pn * 256 + wc * 32 + 8 * fq;
#pragma unroll
        for (int ai = 0; ai < 2; ++ai)
#pragma unroll
            for (int m = 0; m < 4; ++m) { bf16_t* rowp = base + (size_t)(row0 + ai * 128 + m * 16) * DM;
#pragma unroll
                for (int bj = 0; bj < 2; ++bj) *(u32x4*)(rowp + bj * 128) = pk8(acc[ai][bj][m][0], acc[ai][bj][m][1]); }
    }
};
DI void unpk8(const u32x4 q, f32x4& lo, f32x4& hi) { lo = (f32x4){bflo(q.x), bfhi(q.x), bflo(q.y), bfhi(q.y)}; hi = (f32x4){bflo(q.z), bfhi(q.z), bflo(q.w), bfhi(q.w)}; }
template <bool SRCF32> struct EpiResB {
    static constexpr bool PERM = true, AFTER_DRAIN = false;
    const float* srcf; const bf16_t* srcb; bf16_t* xb;
    DI void operator()(AccRef acc, const Unit& u, int wr, int wc, int fr, int fq) const {
        const int row0 = u.pm * 256 + wr * 64 + fr, col0 = u.pn * 256 + wc * 32 + 8 * fq;
#pragma unroll
        for (int ai = 0; ai < 2; ++ai) {
            f32x4 a[4][2][2];
#pragma unroll
            for (int m = 0; m < 4; ++m) { const size_t o = (size_t)(row0 + ai * 128 + m * 16) * DM + col0;
#pragma unroll
                for (int bj = 0; bj < 2; ++bj) {
                    if (SRCF32) { a[m][bj][0] = __builtin_nontemporal_load((const f32x4*)(srcf + o + bj * 128)); a[m][bj][1] = __builtin_nontemporal_load((const f32x4*)(srcf + o + bj * 128 + 4)); }
                    else { const u32x4 q = *(const u32x4*)(srcb + o + bj * 128); unpk8(q, a[m][bj][0], a[m][bj][1]); } } }
#pragma unroll
            for (int m = 0; m < 4; ++m) { const size_t o = (size_t)(row0 + ai * 128 + m * 16) * DM + col0;
#pragma unroll
                for (int bj = 0; bj < 2; ++bj) *(u32x4*)(xb + o + bj * 128) = pk8(a[m][bj][0] + acc[ai][bj][m][0], a[m][bj][1] + acc[ai][bj][m][1]); }
        }
    }
};
template <bool NEXT> struct EpiGate {
    static constexpr bool PERM = true, AFTER_DRAIN = false;
    const bf16_t* xin; const bf16_t* e; bf16_t* xb; float* ssp; float* outf;
    DI void operator()(AccRef acc, const Unit& u, int wr, int wc, int fr, int fq) const {
        const int row0 = u.pm * 256 + wr * 64 + fr, col0 = u.pn * 256 + wc * 32 + 8 * fq;
#pragma unroll
        for (int ai = 0; ai < 2; ++ai) {
            u32x4 xv[4][2], ev[4][2];
#pragma unroll
            for (int m = 0; m < 4; ++m) { const size_t o = (size_t)(row0 + ai * 128 + m * 16) * DM + col0;
#pragma unroll
                for (int bj = 0; bj < 2; ++bj) { xv[m][bj] = *(const u32x4*)(xin + o + bj * 128); ev[m][bj] = *(const u32x4*)(e + o + bj * 128); } }
#pragma unroll
            for (int m = 0; m < 4; ++m) { const int row = row0 + ai * 128 + m * 16; const size_t o = (size_t)row * DM + col0; float ss = 0.f;
#pragma unroll
                for (int bj = 0; bj < 2; ++bj) { f32x4 a0, a1, e0, e1; unpk8(xv[m][bj], a0, a1); unpk8(ev[m][bj], e0, e1);
                    const f32x4 v0 = a0 + e0 * sigm4(acc[ai][bj][m][0]), v1 = a1 + e1 * sigm4(acc[ai][bj][m][1]);
                    if (NEXT) { *(u32x4*)(xb + o + bj * 128) = pk8(v0, v1);
                        ss += (v0[0] * v0[0] + v0[1] * v0[1]) + (v0[2] * v0[2] + v0[3] * v0[3]) + (v1[0] * v1[0] + v1[1] * v1[1]) + (v1[2] * v1[2] + v1[3] * v1[3]); }
                    else { __builtin_nontemporal_store(v0, (f32x4*)(outf + o + bj * 128)); __builtin_nontemporal_store(v1, (f32x4*)(outf + o + bj * 128 + 4)); } }
                if (NEXT) { ss += __shfl_xor(ss, 16); ss += __shfl_xor(ss, 32); if (fq == 0) atomicAdd(ssp + row, ss); } }
        }
    }
};
struct EpiKQZ {
    static constexpr bool PERM = true, AFTER_DRAIN = false;
    bf16_t *kk, *qq, *sz2; const float *rstd1, *k_norm, *q_norm;
    DI void operator()(AccRef acc, const Unit& u, int wr, int wc, int fr, int fq) const {
        const int row0 = u.pm * 256 + wr * 64 + fr, kind = u.pn >> 2, pq = u.pn & 3;
        float rsv[2][4];
#pragma unroll
        for (int ai = 0; ai < 2; ++ai)
#pragma unroll
            for (int m = 0; m < 4; ++m) rsv[ai][m] = rstd1[row0 + ai * 128 + m * 16];
        if (kind == 2) {
            bf16_t* base = sz2 + pq * 256 + 64 * wc + 8 * fq;
#pragma unroll
            for (int ai = 0; ai < 2; ++ai)
#pragma unroll
                for (int m = 0; m < 4; ++m) { const int row = row0 + ai * 128 + m * 16; const float rs = rsqrtf(rsv[ai][m] * (1.f / DM) + EPS); bf16_t* rowp = base + (size_t)row * DM;
#pragma unroll
                    for (int bj = 0; bj < 2; ++bj) *(u32x4*)(rowp + bj * 32) = pk8(silu4(acc[ai][bj][m][0] * rs), silu4(acc[ai][bj][m][1] * rs)); }
        } else {
            const float* gn = kind ? q_norm : k_norm; const float mul = kind ? 0.125f * 1.4426950408889634f : 1.f;
            bf16_t* dst = kind ? qq : kk; const int head = pq * 4 + wc;
            f32x4 g[2][2];
#pragma unroll
            for (int bj = 0; bj < 2; ++bj)
#pragma unroll
                for (int n = 0; n < 2; ++n) g[bj][n] = *(const f32x4*)(gn + 32 * bj + 8 * fq + 4 * n) * mul;
#pragma unroll
            for (int ai = 0; ai < 2; ++ai)
#pragma unroll
                for (int m = 0; m < 4; ++m) { const int row = row0 + ai * 128 + m * 16; const float rs = rsqrtf(rsv[ai][m] * (1.f / DM) + EPS); const int b = row >> 11, s = row & 2047;
                    f32x4 v[2][2]; float ss = 0.f;
#pragma unroll
                    for (int bj = 0; bj < 2; ++bj)
#pragma unroll
                        for (int n = 0; n < 2; ++n) { v[bj][n] = acc[ai][bj][m][n] * rs; ss += (v[bj][n][0] * v[bj][n][0] + v[bj][n][1] * v[bj][n][1]) + (v[bj][n][2] * v[bj][n][2] + v[bj][n][3] * v[bj][n][3]); }
                    ss += __shfl_xor(ss, 16); ss += __shfl_xor(ss, 32);
                    const float hr = rsqrtf(ss * (1.f / 64.f) + EPS);
                    bf16_t* rowp = dst + ((size_t)(b * 16 + head) * SEQ + s) * 64 + 8 * fq;
#pragma unroll
                    for (int bj = 0; bj < 2; ++bj) *(u32x4*)(rowp + 32 * bj) = pk8(v[bj][0] * hr * g[bj][0], v[bj][1] * hr * g[bj][1]); }
        }
    }
};
struct EpiVT {
    static constexpr bool PERM = true, AFTER_DRAIN = false;
    bf16_t* vt; const float* rstd1;
    DI void operator()(AccRef acc, const Unit& u, int wr, int wc, int fr, int fq) const {
        const int c0 = u.pm * 256 + wr * 64 + fr, tok0 = u.pn * 256 + wc * 32 + 8 * fq;
        f32x4 rs[2][2];
#pragma unroll
        for (int bj = 0; bj < 2; ++bj)
#pragma unroll
            for (int n = 0; n < 2; ++n) { const f32x4 q = *(const f32x4*)(rstd1 + tok0 + 128 * bj + 4 * n);
#pragma unroll
                for (int j = 0; j < 4; ++j) rs[bj][n][j] = rsqrtf(q[j] * (1.f / DM) + EPS); }
#pragma unroll
        for (int ai = 0; ai < 2; ++ai)
#pragma unroll
            for (int m = 0; m < 4; ++m) { const int c = c0 + ai * 128 + m * 16;
#pragma unroll
                for (int bj = 0; bj < 2; ++bj) { const int tok = tok0 + 128 * bj, b = tok >> 11, s = tok & 2047;
                    *(u32x4*)(vt + ((size_t)b * DM + c) * SEQ + s) = pk8(acc[ai][bj][m][0] * rs[bj][0], acc[ai][bj][m][1] * rs[bj][1]); } }
    }
};
template <class Epi> DI void run_gemm(PG8_LAS unsigned char* lds, const bf16_t* A, const bf16_t* Bt, int M, int N, int K, const Epi& E) {
    pg8::Gemm g{A, Bt, M, N, K}; pg8::StaticOrder S; S.init(M, N, (int)gridDim.x, (int)blockIdx.x);
    pg8::gemm_phase<Epi, pg8::StaticOrder, false>(lds, g, S, E, nullptr);
}

struct SchedPG {
    const unsigned char* ws; int layer, G, c;
    DI bool next(int i, pg8::UnitX& u) const { const int L = i * G + c; if (L >= 512) return false;
        pg8::map_unit(L & 255, 64, 4, u.pm, u.pn); u.kind = L >> 8; return true; }
    DI pg8::GDesc desc(int k) const { pg8::GDesc d;
        const size_t oa = k == 0 ? OFF_PB + (size_t)layer * M_TOK * 256 * 2 : OFF_R2, ob = k == 0 ? (layer ? OFF_WPLE1 : OFF_WPLE0) : (layer ? OFF_WG1 : OFF_WG0);
        d.A = (const bf16_t*)(ws + oa); d.Bt = (const bf16_t*)(ws + ob); d.ks = k == 0 ? 256 : 1024; return d; }
    DI void a_ready(const pg8::UnitX&) const {}
    DI void done(const pg8::UnitX&) const {}
};
template <bool NEXT> struct EpiPG {
    static constexpr bool PERM = true;
    EpiE e; EpiGate<NEXT> g;
    DI void operator()(AccRef acc, const pg8::UnitX& u, int wr, int wc, int fr, int fq) const { const Unit uu{u.pm, u.pn};
        if (u.kind == 0) e(acc, uu, wr, wc, fr, fq); else g(acc, uu, wr, wc, fr, fq); }
};
struct SchedP6 {
    const unsigned char* ws; int G, c;
    DI bool next(int i, pg8::UnitX& u) const { const int L = i * G + c; if (L >= 1024) return false;
        if (L < 768) { pg8::map_unit(L, 64, 12, u.pm, u.pn); u.kind = 0; } else { pg8::map_unit(L - 768, 4, 64, u.pm, u.pn); u.kind = 1; }
        return true; }
    DI pg8::GDesc desc(int k) const { pg8::GDesc d; d.A = (const bf16_t*)(ws + (k == 0 ? OFF_R3 : OFF_WV)); d.Bt = (const bf16_t*)(ws + (k == 0 ? OFF_WKQZ : OFF_R3)); d.ks = 1024; return d; }
};
struct EpiP6 {
    static constexpr bool PERM = true;
    EpiKQZ a; EpiVT b;
    DI void operator()(AccRef acc, const pg8::UnitX& u, int wr, int wc, int fr, int fq) const { const Unit uu{u.pm, u.pn};
        if (u.kind == 0) a(acc, uu, wr, wc, fr, fq); else b(acc, uu, wr, wc, fr, fq); }
};

DI int headperm(int cl) { const int o = cl & 255, wc = o >> 6, bj = (o >> 5) & 1, r = o & 31; return (cl & ~255) + 128 * bj + 32 * wc + r; }
DI void transpose_item(float* scr, const float* src, int ld, int K, int nT, const float* gain, bf16_t* dst, int rowoff, bool perm, int item, int lane) {
    const int kt = item / nT, nt = item - kt * nT, k0 = kt * 64, n0 = nt * 32, lr = lane >> 3, lc = lane & 7;
    float4 v[8];
#pragma unroll
    for (int i = 0; i < 8; ++i) v[i] = *(const float4*)(src + (size_t)(k0 + i * 8 + lr) * ld + n0 + lc * 4);
    float gk[8];
#pragma unroll
    for (int i = 0; i < 8; ++i) gk[i] = gain ? gain[k0 + 8 * lc + i] : 1.f;
#pragma unroll
    for (int i = 0; i < 8; ++i) { float* t = scr + (i * 8 + lr) * 33 + lc * 4; t[0] = v[i].x; t[1] = v[i].y; t[2] = v[i].z; t[3] = v[i].w; }
    asm volatile("s_waitcnt lgkmcnt(0)" ::: "memory");
#pragma unroll
    for (int j = 0; j < 4; ++j) { const int n = lr + 8 * j; const float* t = scr + (8 * lc) * 33 + n;
        int row = rowoff + n0 + n; if (perm) row = headperm(row);
        u32x4 w; w.x = pk2(t[0] * gk[0], t[33] * gk[1]); w.y = pk2(t[66] * gk[2], t[99] * gk[3]); w.z = pk2(t[132] * gk[4], t[165] * gk[5]); w.w = pk2(t[198] * gk[6], t[231] * gk[7]);
        *(u32x4*)(dst + (size_t)row * K + k0 + 8 * lc) = w; }
    asm volatile("s_waitcnt lgkmcnt(0)" ::: "memory");
}
DI void weff_job(float* L, const Params& P, bf16_t* dst, int job) {
    float* As = L; float* Bs = L + 64 * 129;
    const int tid = threadIdx.x, k0 = (job >> 4) * 64, n0 = (job & 15) * 64, g = n0 >> 8, d0 = n0 & 255, kk = tid >> 3, dg = tid & 7;
    float acc[8];
#pragma unroll
    for (int j = 0; j < 8; ++j) acc[j] = 0.f;
    for (int c0 = 0; c0 < 256; c0 += 128) {
        __syncthreads();
#pragma unroll
        for (int i = 0; i < 4; ++i) { const int idx = tid + 512 * i;
            { const int r = idx >> 5, c4 = idx & 31; const float4 v = *(const float4*)(P.a_w_in + (size_t)(k0 + r) * 2048 + g * 256 + c0 + c4 * 4);
              float* t = As + r * 129 + c4 * 4; t[0] = v.x; t[1] = v.y; t[2] = v.z; t[3] = v.w; }
            { const int cc = idx >> 4, d4 = idx & 15; *(float4*)(Bs + cc * 64 + d4 * 4) = *(const float4*)(P.a_w_group + (size_t)(g * 256 + c0 + cc) * 256 + d0 + d4 * 4); } }
        __syncthreads();
#pragma unroll 4
        for (int c = 0; c < 128; ++c) { const float a = As[kk * 129 + c]; const float4 b0 = *(const float4*)(Bs + c * 64 + dg * 8), b1 = *(const float4*)(Bs + c * 64 + dg * 8 + 4);
            acc[0] += a * b0.x; acc[1] += a * b0.y; acc[2] += a * b0.z; acc[3] += a * b0.w; acc[4] += a * b1.x; acc[5] += a * b1.y; acc[6] += a * b1.z; acc[7] += a * b1.w; }
    }
    const float an = P.a_norm[k0 + kk];
#pragma unroll
    for (int j = 0; j < 8; ++j) { const int n = n0 + dg * 8 + j; const float v = acc[j] * an * P.a_scale[n];
        dst[(size_t)n * DM + k0 + kk] = (bf16_t)(pk2(v, v) & 0xffffu); }
}
DI void shadow_p_convert(const Params& P) {
    const float4* pp = (const float4*)P.p; u32x4* pb = (u32x4*)(P.ws + OFF_PB);
    for (int v = xcd_affine_id(); v < 256; v += (int)gridDim.x) {
        for (int j0 = (int)threadIdx.x - 64; j0 < 4096; j0 += 5 * 448) { float4 a[5], b[5];
#pragma unroll
            for (int q = 0; q < 5; ++q) { const int j = j0 + q * 448; if (j < 4096) { const size_t row = (size_t)(j >> 11) * M_TOK + 64 * v + ((j >> 5) & 63); const int c = j & 31;
                a[q] = pp[row * 64 + 2 * c]; b[q] = pp[row * 64 + 2 * c + 1]; } }
#pragma unroll
            for (int q = 0; q < 5; ++q) { const int j = j0 + q * 448; if (j < 4096) { const size_t row = (size_t)(j >> 11) * M_TOK + 64 * v + ((j >> 5) & 63); const int c = j & 31;
                u32x4 u; u.x = pk2(a[q].x, a[q].y); u.y = pk2(a[q].z, a[q].w); u.z = pk2(b[q].x, b[q].y); u.w = pk2(b[q].z, b[q].w); pb[row * 32 + c] = u; } } }
    }
}
DI void deferred_items(const Params& P, float* L, int seam) {
    const int wid = threadIdx.x >> 6, lane = threadIdx.x & 63; unsigned char* ws = P.ws; float* scr = L + wid * (64 * 33);
    const int nitems = (seam == 0) ? 1792 : 2560;
    for (int t = blockIdx.x * 7 + (wid - 1); t < nitems; t += gridDim.x * 7) {
        if (seam == 0) {
            if (t < 512) transpose_item(scr, P.a_w_out, 1024, 1024, 32, nullptr, (bf16_t*)(ws + OFF_WAOUT), 0, false, t, lane);
            else if (t < 640) transpose_item(scr, P.ple_w, 1024, 256, 32, nullptr, (bf16_t*)(ws + OFF_WPLE0), 0, false, t - 512, lane);
            else if (t < 768) transpose_item(scr, P.ple_w + 256 * 1024, 1024, 256, 32, nullptr, (bf16_t*)(ws + OFF_WPLE1), 0, false, t - 640, lane);
            else if (t < 1280) transpose_item(scr, P.w_kv, 2048, 1024, 32, P.kv_norm, (bf16_t*)(ws + OFF_WKQZ), 0, true, t - 768, lane);
            else transpose_item(scr, P.w_kv + 1024, 2048, 1024, 32, P.kv_norm, (bf16_t*)(ws + OFF_WV), 0, false, t - 1280, lane);
        } else {
            if (t < 512) transpose_item(scr, P.ple_gate_w, 1024, 1024, 32, nullptr, (bf16_t*)(ws + OFF_WG0), 0, false, t, lane);
            else if (t < 1536) transpose_item(scr, P.b_w_in, 2048, 1024, 64, P.b_norm, (bf16_t*)(ws + OFF_WKQZ), 1024, true, t - 512, lane);
            else if (t < 2048) transpose_item(scr, P.b_w_out, 1024, 1024, 32, nullptr, (bf16_t*)(ws + OFF_WBOUT), 0, false, t - 1536, lane);
            else transpose_item(scr, P.ple_gate_w + 1024 * 1024, 1024, 1024, 32, nullptr, (bf16_t*)(ws + OFF_WG1), 0, false, t - 2048, lane);
        }
    }
}
struct GrpBarrier { unsigned* cnt; unsigned* gen; unsigned* tmo; unsigned nmem; };
DI void grp_barrier(const GrpBarrier& gb) {
    asm volatile("s_waitcnt vmcnt(0)" ::: "memory");
    __syncthreads();
    if (threadIdx.x == 0) {
        const unsigned old = xb_add(gb.cnt, 1u), g = old / gb.nmem;
        if (old + 1u == (g + 1u) * gb.nmem) xb_add(gb.gen, 1u);
        else XB_SPIN(xb_ld(gb.gen) == g, gb.tmo - XB_TMO);
        __builtin_amdgcn_fence(__ATOMIC_ACQUIRE, "agent");
        asm volatile("s_waitcnt vmcnt(0)" ::: "memory");
    }
    __syncthreads();
}
DI void phase0(const Params& P, float* L) {
    const int tid = threadIdx.x, wid = tid >> 6, lane = tid & 63, w = blockIdx.x, G = gridDim.x;
    unsigned char* ws = P.ws;
    { float* ss1 = (float*)(ws + OFF_RSTD1); for (int i = w * 512 + tid; i < M_TOK; i += G * 512) ss1[i] = 0.f; }
    if ((w & 1) == 0) { for (int job = w; job < 256; job += G) weff_job(L, P, (bf16_t*)(ws + OFF_WIN1), job); __syncthreads(); }
    { float* scr = L + wid * (64 * 33);
      for (int t = w * 8 + wid; t < 512; t += G * 8) transpose_item(scr, P.a_w_in + 1024, 2048, 1024, 32, P.a_norm, (bf16_t*)(ws + OFF_WIN1) + (size_t)1024 * 1024, 0, false, t, lane); }
    { bf16_t* xb = (bf16_t*)(ws + OFF_R1); float* rstd0 = (float*)(ws + OFF_RSTD0);
      for (int row = (xcd_affine_id() * 8 + wid) * 8; row < M_TOK; row += G * 64) {
          float4 v[8][4];
#pragma unroll
          for (int q = 0; q < 8; ++q)
#pragma unroll
              for (int j = 0; j < 4; ++j) v[q][j] = ((const float4*)(P.x + (size_t)(row + q) * DM) + lane)[64 * j];
#pragma unroll
          for (int q = 0; q < 8; ++q) { float s = 0.f;
#pragma unroll
              for (int j = 0; j < 4; ++j) s += (v[q][j].x * v[q][j].x + v[q][j].y * v[q][j].y) + (v[q][j].z * v[q][j].z + v[q][j].w * v[q][j].w);
              s = wave_sum(s);
              uint2* o = (uint2*)(xb + (size_t)(row + q) * DM) + lane;
#pragma unroll
              for (int j = 0; j < 4; ++j) { uint2 u; u.x = pk2(v[q][j].x, v[q][j].y); u.y = pk2(v[q][j].z, v[q][j].w); o[64 * j] = u; }
              if (lane == 0) rstd0[row + q] = rsqrtf(s * (1.f / DM) + EPS); } } }
    if ((w & 1) != 0) { __syncthreads(); for (int job = w; job < 256; job += G) weff_job(L, P, (bf16_t*)(ws + OFF_WIN1), job); }
}
DI void unpack8(const u32x4 q, float (&f)[8]) { f[0] = bflo(q.x); f[1] = bfhi(q.x); f[2] = bflo(q.y); f[3] = bfhi(q.y); f[4] = bflo(q.z); f[5] = bfhi(q.z); f[6] = bflo(q.w); f[7] = bfhi(q.w); }
DI void pool_phase(const Params& P) {
    const bf16_t* ug = (const bf16_t*)(P.ws + OFF_R2); const bf16_t* sz = (const bf16_t*)(P.ws + OFF_R3); bf16_t* Gd = (bf16_t*)(P.ws + OFF_R1);
    const int nth = gridDim.x * 512;
    for (int idx = xcd_affine_id() * 512 + threadIdx.x; idx < 131072; idx += nth) {
        const int chunk = idx & 127, run = idx >> 7, row0 = run * 16, t0 = row0 & (SEQ - 1), c0 = chunk * 8, wlen = 2 << (chunk >> 5);
        const u32x4* up = (const u32x4*)(ug + (size_t)row0 * DM + c0); const u32x4* zp = (const u32x4*)(sz + (size_t)row0 * DM + c0); u32x4* gp = (u32x4*)(Gd + (size_t)row0 * DM + c0);
        float s[8], c[8], z[8];
#pragma unroll
        for (int j = 0; j < 8; ++j) s[j] = 0.f;
        { const bool hist = t0 > 0;
#pragma unroll
          for (int j = 1; j <= 16; ++j) {
              const int jj = hist ? (j <= wlen ? j : wlen) : 0; const float mk = (hist && j <= wlen) ? 1.f : 0.f;
              unpack8(up[-(jj * 128)], c);
#pragma unroll
              for (int q = 0; q < 8; ++q) s[q] += mk * c[q]; } }
        const float inv_full = 1.f / (float)wlen;
#pragma unroll 4
        for (int rr = 0; rr < 16; ++rr) {
            const int t = t0 + rr;
            if (t >= wlen) { unpack8(up[(rr - wlen) * 128], c);
#pragma unroll
                for (int q = 0; q < 8; ++q) s[q] -= c[q]; }
            unpack8(up[rr * 128], c); unpack8(zp[rr * 128], z);
            const float inv = (t + 1 < wlen) ? 1.f / (float)(t + 1) : inv_full;
            float o[8];
#pragma unroll
            for (int q = 0; q < 8; ++q) { s[q] += c[q]; o[q] = (s[q] * inv - c[q]) * z[q]; }
            u32x4 w; w.x = pk2(o[0], o[1]); w.y = pk2(o[2], o[3]); w.z = pk2(o[4], o[5]); w.w = pk2(o[6], o[7]); gp[rr * 128] = w;
        }
    }
}
#define MFMA32(a, b, c) __builtin_amdgcn_mfma_f32_32x32x16_bf16((a), (b), (c), 0, 0, 0)
DI void attn_phase(const Params& P, PG8_LAS unsigned char* lds) {
    constexpr int HIST = 128, WIN = 384, KP = 144, VP = 776, NF = 6, VCH = 48;
    PG8_LAS unsigned char* Kl = lds; PG8_LAS unsigned char* Vl = lds + WIN * KP;
    const bf16_t* kk = (const bf16_t*)(P.ws + OFF_R1); const bf16_t* qq = (const bf16_t*)(P.ws + OFF_R2); const bf16_t* vt = (const bf16_t*)(P.ws + OFF_R4);
    const bf16_t* sz2 = (const bf16_t*)(P.ws + OFF_R4 + 32 * MiB); bf16_t* g2 = (bf16_t*)(P.ws + OFF_E1);
    const int tid = threadIdx.x, wid = tid >> 6, lane = tid & 63, r = lane & 31, hh = lane >> 5;
#define ATT_LOAD_FILL(IT, KV, VV) do { const int _bh = (IT) >> 3, _wlo = ((IT) & 7) * 256 - HIST; const bf16_t* _Kg = kk + (size_t)_bh * SEQ * 64; const bf16_t* _Vg = vt + (size_t)_bh * 64 * SEQ; \
        _Pragma("unroll") for (int i = 0; i < NF; ++i) { const int c = tid + 512 * i, row = c >> 3, part = c & 7, key = _wlo + row; if (key >= 0) KV[i] = *(const u32x4*)(_Kg + (size_t)key * 64 + part * 8); } \
        _Pragma("unroll") for (int i = 0; i < NF; ++i) { const int c = tid + 512 * i, d = c / VCH, part = c - d * VCH, key0 = _wlo + part * 8; if (key0 >= 0) VV[i] = *(const u32x4*)(_Vg + (size_t)d * SEQ + key0); } } while (0)
#define ATT_LOAD_Q(IT, QF) do { const bf16_t* _Qp = qq + ((size_t)((IT) >> 3) * SEQ + ((IT) & 7) * 256 + 32 * wid + r) * 64 + hh * 8; \
        _Pragma("unroll") for (int ks = 0; ks < 4; ++ks) QF[ks] = *(const s16x8*)(_Qp + ks * 16); } while (0)
    u32x4 kv[NF], vv[NF];
    const bool aff = (gridDim.x & 7) == 0; const int islot0 = aff ? (int)(blockIdx.x >> 3) : (int)blockIdx.x, istep = aff ? (int)(gridDim.x >> 3) : (int)gridDim.x, ibase = aff ? (int)(blockIdx.x & 7) * 128 : 0, ilim = aff ? 128 : 1024;
    if (islot0 < ilim) { ATT_LOAD_FILL(ibase + islot0, kv, vv); }
    for (int islot = islot0; islot < ilim; islot += istep) {
        const int item = ibase + islot;
        const int qc = item & 7, bh = item >> 3, t0 = qc * 256, wlo = t0 - HIST, tq = t0 + 32 * wid;
        const bf16_t* Kg = kk + (size_t)bh * SEQ * 64; const bf16_t* Vg = vt + (size_t)bh * 64 * SEQ;
        const int b = bh >> 4, h = bh & 15; const size_t rowo = ((size_t)b * SEQ + tq + r) * DM + h * 64 + 4 * hh;
        asm volatile("s_waitcnt lgkmcnt(0)" ::: "memory"); __builtin_amdgcn_s_barrier(); asm volatile("" ::: "memory");
#pragma unroll
        for (int i = 0; i < NF; ++i) { const int c = tid + 512 * i, row = c >> 3, part = c & 7, key = wlo + row;
            if (key >= 0) *(PG8_LAS u32x4*)(Kl + row * KP + part * 16) = kv[i]; }
#pragma unroll
        for (int i = 0; i < NF; ++i) { const int c = tid + 512 * i, d = c / VCH, part = c - d * VCH, key0 = wlo + part * 8;
            if (key0 >= 0) { PG8_LAS u32x2_t* w = (PG8_LAS u32x2_t*)(Vl + d * VP + part * 16); u32x2_t a = {vv[i].x, vv[i].y}, bb = {vv[i].z, vv[i].w}; w[0] = a; w[1] = bb; } }
        s16x8 qf[4]; ATT_LOAD_Q(item, qf);
        asm volatile("s_waitcnt lgkmcnt(0)" ::: "memory"); __builtin_amdgcn_s_barrier(); asm volatile("" ::: "memory");
        const size_t rowc = ((size_t)b * SEQ + tq + (lane >> 3)) * DM + h * 64 + (lane & 7) * 8;
        u32x4 zc[4];
#pragma unroll
        for (int i = 0; i < 4; ++i) zc[i] = *(const u32x4*)(sz2 + rowc + (size_t)(8 * i) * DM);
        const int nitem = (islot + istep < ilim) ? item + istep : 1024;
        u32x4 kvn[NF], vvn[NF];
        if (nitem < 1024) { ATT_LOAD_FILL(nitem, kvn, vvn); }
        f32x16 o0, o1;
#pragma unroll
        for (int i = 0; i < 16; ++i) { o0[i] = 0.f; o1[i] = 0.f; }
        float carry = 1.f;
        for (int s0 = tq; s0 >= 0; s0 -= 32) {
            s16x8 kf[4]; s16x4 vf[2][2][2];
            if (s0 >= wlo) {
                PG8_LAS const unsigned char* kp = Kl + (s0 - wlo + r) * KP + hh * 16; PG8_LAS const unsigned char* vp = Vl + r * VP + (s0 - wlo + 4 * hh) * 2;
#pragma unroll
                for (int ks = 0; ks < 4; ++ks) kf[ks] = *(PG8_LAS const s16x8*)(kp + ks * 32);
#pragma unroll
                for (int dt = 0; dt < 2; ++dt)
#pragma unroll
                    for (int s = 0; s < 2; ++s)
#pragma unroll
                        for (int pt = 0; pt < 2; ++pt) vf[dt][s][pt] = *(PG8_LAS const s16x4*)(vp + dt * 32 * VP + (16 * s + 8 * pt) * 2);
            } else {
                const bf16_t* kp = Kg + (size_t)(s0 + r) * 64 + hh * 8; const bf16_t* vp = Vg + (size_t)r * SEQ + s0 + 4 * hh;
#pragma unroll
                for (int ks = 0; ks < 4; ++ks) kf[ks] = *(const s16x8*)(kp + ks * 16);
#pragma unroll
                for (int dt = 0; dt < 2; ++dt)
#pragma unroll
                    for (int s = 0; s < 2; ++s)
#pragma unroll
                        for (int pt = 0; pt < 2; ++pt) vf[dt][s][pt] = *(const s16x4*)(vp + (size_t)dt * 32 * SEQ + 16 * s + 8 * pt);
            }
            f32x16 x;
#pragma unroll
            for (int i = 0; i < 16; ++i) x[i] = 0.f;
#pragma unroll
            for (int ks = 0; ks < 4; ++ks) x = MFMA32(kf[ks], qf[ks], x);
            float beta[16], keep[16];
            const bool diag = (s0 == tq);
#pragma unroll
            for (int i = 0; i < 16; ++i) {
                const float l = fmaxf(x[i], -120.f);
                const float e = __builtin_amdgcn_exp2f(-l);
                float bt = __builtin_amdgcn_rcpf(1.f + e), kp = e * bt;
                beta[i] = bt; keep[i] = kp;
            }
            if (diag) {
#pragma unroll
                for (int i = 0; i < 16; ++i) { const bool valid = ((i & 3) + 8 * (i >> 2) + 4 * hh) < r; beta[i] = valid ? beta[i] : 0.f; keep[i] = valid ? keep[i] : 1.f; }
            }
            float Gp[4], PG[4];
#pragma unroll
            for (int g = 0; g < 4; ++g) { Gp[g] = (keep[4 * g] * keep[4 * g + 1]) * (keep[4 * g + 2] * keep[4 * g + 3]); PG[g] = __shfl_xor(Gp[g], 32); }
            float base[4];
            { float so = 1.f, sp = 1.f;
#pragma unroll
              for (int g = 3; g >= 0; --g) { base[g] = carry * so * sp * (hh == 0 ? PG[g] : 1.f); so *= Gp[g]; sp *= PG[g]; }
              carry = carry * so * sp; }
            float a[16];
#pragma unroll
            for (int g = 0; g < 4; ++g) { float run = base[g];
                a[4 * g + 3] = beta[4 * g + 3] * run; run *= keep[4 * g + 3];
                a[4 * g + 2] = beta[4 * g + 2] * run; run *= keep[4 * g + 2];
                a[4 * g + 1] = beta[4 * g + 1] * run; run *= keep[4 * g + 1];
                a[4 * g] = beta[4 * g] * run; }
#pragma unroll
            for (int s = 0; s < 2; ++s) {
                u32x4 pw; pw.x = pk2(a[8 * s], a[8 * s + 1]); pw.y = pk2(a[8 * s + 2], a[8 * s + 3]); pw.z = pk2(a[8 * s + 4], a[8 * s + 5]); pw.w = pk2(a[8 * s + 6], a[8 * s + 7]);
                const s16x8 pf = __builtin_bit_cast(s16x8, pw);
                const s16x8 va = __builtin_shufflevector(vf[0][s][0], vf[0][s][1], 0, 1, 2, 3, 4, 5, 6, 7);
                const s16x8 vb = __builtin_shufflevector(vf[1][s][0], vf[1][s][1], 0, 1, 2, 3, 4, 5, 6, 7);
                o0 = MFMA32(va, pf, o0); o1 = MFMA32(vb, pf, o1);
            }
            if (__all(carry < 1e-12f)) break;
        }
        { PG8_LAS unsigned char* S = lds + WIN * KP + 64 * VP + wid * 4608;
#pragma unroll
          for (int i = 0; i < 4; ++i) *(PG8_LAS u32x4*)(S + ((lane >> 3) + 8 * i) * 144 + (lane & 7) * 16) = zc[i];
          asm volatile("s_waitcnt lgkmcnt(0)" ::: "memory");
          PG8_LAS unsigned char* Sr = S + r * 144 + 8 * hh;
#pragma unroll
          for (int g = 0; g < 4; ++g) {
              const u32x2_t z0 = *(PG8_LAS const u32x2_t*)(Sr + 16 * g), z1 = *(PG8_LAS const u32x2_t*)(Sr + 64 + 16 * g);
              u32x2_t w0, w1;
              w0.x = pk2(o0[4 * g] * bflo(z0.x), o0[4 * g + 1] * bfhi(z0.x)); w0.y = pk2(o0[4 * g + 2] * bflo(z0.y), o0[4 * g + 3] * bfhi(z0.y));
              w1.x = pk2(o1[4 * g] * bflo(z1.x), o1[4 * g + 1] * bfhi(z1.x)); w1.y = pk2(o1[4 * g + 2] * bflo(z1.y), o1[4 * g + 3] * bfhi(z1.y));
              *(PG8_LAS u32x2_t*)(Sr + 16 * g) = w0; *(PG8_LAS u32x2_t*)(Sr + 64 + 16 * g) = w1; }
          asm volatile("s_waitcnt lgkmcnt(0)" ::: "memory");
#pragma unroll
          for (int i = 0; i < 4; ++i) { const u32x4 v = *(PG8_LAS const u32x4*)(S + ((lane >> 3) + 8 * i) * 144 + (lane & 7) * 16); *(u32x4*)(g2 + rowc + (size_t)(8 * i) * DM) = v; }
          asm volatile("s_waitcnt lgkmcnt(0)" ::: "memory"); }
#pragma unroll
        for (int i = 0; i < NF; ++i) { kv[i] = kvn[i]; vv[i] = vvn[i]; }
    }
#undef ATT_LOAD_FILL
#undef ATT_LOAD_Q
}

__global__ __launch_bounds__(512, 2) void yoco_fwd(Params P) {
    extern __shared__ __attribute__((aligned(16))) unsigned char shm[];
    PG8_LAS unsigned char* lds = (PG8_LAS unsigned char*)shm;
    unsigned char* ws = P.ws;
    bf16_t* R1 = (bf16_t*)(ws + OFF_R1); bf16_t* R2 = (bf16_t*)(ws + OFF_R2); bf16_t* R3 = (bf16_t*)(ws + OFF_R3); bf16_t* R4 = (bf16_t*)(ws + OFF_R4);
    float* rstd0 = (float*)(ws + OFF_RSTD0); float* rstd1 = (float*)(ws + OFF_RSTD1); float* ssp = (float*)(ws + OFF_SSP);
    const bf16_t* pb = (const bf16_t*)(ws + OFF_PB); bf16_t* E1b = (bf16_t*)(ws + OFF_E1);
#define PH(k) if (P.ph_lo <= (k) && (k) < P.ph_hi)
#define SYNC(k) if (fused) { if ((k) < 2) xcd_barrier(xb, [&]() { deferred_items(P, (float*)shm, (k)); }); else if ((k) == 2) xcd_barrier(xb, [&]() { shadow_p_convert(P); }); else if (grp_ok) grp_barrier(gb); else xcd_barrier(xb, []() {}); }
    const bool fused = (P.ph_hi - P.ph_lo) > 1;
    volatile LAS unsigned* st = (volatile LAS unsigned*)(lds + LDS_ST);
    unsigned* bar = (unsigned*)(ws + OFF_BAR);
    if (fused) { if (threadIdx.x == 0) { st[0] = 0u; st[1] = 0u; } __syncthreads(); }
    XcdBarrier xb; xb.bar = bar; xb.x = 0u; xb.st = st;
    if (fused) xb = xcd_barrier_post(bar, st);
    unsigned* gtab = (unsigned*)(ws + OFF_BAR + 16384 + 8192);
    if (fused && threadIdx.x == 0) gtab[blockIdx.x] = xb.x;
    bool grp_ok = false;
    GrpBarrier gb;
    PH(0) phase0(P, (float*)shm);
    SYNC(0)
    gb.cnt = (unsigned*)(ws + OFF_BAR + 16384) + 64 * (blockIdx.x & 7); gb.gen = (unsigned*)(ws + OFF_BAR + 16384 + 4096) + 64 * (blockIdx.x & 7); gb.tmo = bar + XB_TMO; gb.nmem = gridDim.x >> 3;
    if (fused) { const int t = threadIdx.x; int pred = 1;
        if (gridDim.x == 256 && t < 256) pred = (gtab[t] == gtab[t & 7]);
        grp_ok = (gridDim.x == 256) && (__syncthreads_and(pred) != 0); }
    PH(1) { Epi1 E{R2, R3, rstd0}; run_gemm(lds, R1, (const bf16_t*)(ws + OFF_WIN1), M_TOK, 2048, 1024, E); }
    SYNC(1)
    PH(2) pool_phase(P);
    SYNC(2)
    PH(3) { EpiResB<true> E{P.x, nullptr, R2}; run_gemm(lds, R1, (const bf16_t*)(ws + OFF_WAOUT), M_TOK, 1024, 1024, E); }
    SYNC(3)
    PH(4) { SchedPG S{ws, 0, (int)gridDim.x, (int)blockIdx.x}; EpiPG<true> E{EpiE{E1b}, EpiGate<true>{R2, E1b, R3, rstd1, nullptr}}; pg8::gemm_stream(lds, S, E); }
    SYNC(4)
    PH(6) { SchedP6 S{ws, (int)gridDim.x, (int)blockIdx.x};
            EpiP6 E{EpiKQZ{R1, R2, R4 + (size_t)M_TOK * DM, rstd1, P.k_norm, P.b_q_norm}, EpiVT{R4, rstd1}}; pg8::gemm_stream(lds, S, E); }
    SYNC(6)
    PH(7) attn_phase(P, lds);
    SYNC(7)
    PH(8) { EpiResB<false> E{nullptr, R3, R2}; run_gemm(lds, E1b, (const bf16_t*)(ws + OFF_WBOUT), M_TOK, 1024, 1024, E); }
    SYNC(8)
    PH(9) { SchedPG S{ws, 1, (int)gridDim.x, (int)blockIdx.x}; EpiPG<false> E{EpiE{E1b}, EpiGate<false>{R2, E1b, nullptr, nullptr, P.out}}; pg8::gemm_stream(lds, S, E); }
}

extern "C" void kernel_launch(void* const* d_in, const int* in_sizes, int n_in, void* d_out, int out_size, void* d_ws, size_t ws_size, hipStream_t stream) {
    static int grid = 0;
    if (grid == 0) {
        int dev = 0, cus = 0, per_cu = 0;
        if (n_in != 16 || out_size != M_TOK * DM || ws_size < WS_END) { fprintf(stderr, "kernel_launch: unexpected shapes (n_in %d out %d ws %zu)\n", n_in, out_size, ws_size); grid = -1; return; }
        (void)hipGetDevice(&dev); (void)hipDeviceGetAttribute(&cus, hipDeviceAttributeMultiprocessorCount, dev);
        if (hipFuncSetAttribute((const void*)yoco_fwd, hipFuncAttributeMaxDynamicSharedMemorySize, LDS_BYTES) != hipSuccess) { fprintf(stderr, "kernel_launch: hipFuncSetAttribute failed\n"); grid = -1; return; }
        (void)hipOccupancyMaxActiveBlocksPerMultiprocessor(&per_cu, (const void*)yoco_fwd, 512, LDS_BYTES);
        if (per_cu < 1) { fprintf(stderr, "kernel_launch: occupancy query says %d blocks per CU\n", per_cu); (void)hipGetLastError(); per_cu = 1; }
        grid = cus;
    }
    if (grid < 0) return;
    Params p{};
    const float** pp = (const float**)&p;
    for (int i = 0; i < 16; ++i) pp[i] = (const float*)d_in[i];
    p.out = (float*)d_out; p.ws = (unsigned char*)d_ws;
    p.ph_lo = 0; p.ph_hi = NPHASE;
    if (hipMemsetAsync((unsigned char*)d_ws + OFF_BAR, 0, 32768, stream) != hipSuccess) { fprintf(stderr, "kernel_launch: memset of the barrier words failed\n"); return; }
    void* args[] = {&p};
    hipError_t e = hipLaunchCooperativeKernel((const void*)yoco_fwd, dim3(grid), dim3(512), args, LDS_BYTES, stream);
    if (e != hipSuccess) fprintf(stderr, "kernel_launch: cooperative launch failed: %s (grid %d)\n", hipGetErrorString(e), grid);
}
```

```cpp
#include <hip/hip_runtime.h>
#include <cstdio>
namespace pg8 {
#define PG8_LAS __attribute__((address_space(3)))
typedef unsigned short bf16_t;
typedef short bf16x8 __attribute__((ext_vector_type(8)));
typedef float f32x4 __attribute__((ext_vector_type(4)));
typedef unsigned u32x4 __attribute__((ext_vector_type(4)));
constexpr int BM = 256, BK = 64, HALF = 128, HTB = HALF * BK * 2  , STAGE_BYTES = 8 * HTB, NXCD = 8, WGM = 8;

__host__ __device__ __forceinline__ int lds_byte(int r, int c) { const int st = (r >> 4) * 2 + (c >> 5), rr = r & 15, cc = c & 31, ob = rr * 64 + cc * 2; return st * 1024 + (ob ^ (((ob >> 9) & 1) << 5)); }
__host__ __device__ __forceinline__ void stage_rc(int b, int& R, int& C) { const int st = b / 1024, sb = b % 1024, swz = sb ^ (((sb >> 9) & 1) << 5); R = (st >> 1) * 16 + swz / 64; C = (st & 1) * 32 + (swz % 64) / 2; }
__host__ __device__ __forceinline__ int perm32(int rho) { const int n = rho >> 4, i = rho & 15; return 8 * (i >> 2) + 4 * n + (i & 3); }

struct Unit { int pm, pn; };
struct Gemm { const bf16_t* A; const bf16_t* Bt; int M, N, K; };
struct StaticOrder {
    int nM, nN, nwg, G, c;
    __host__ __device__ void init(int M, int N, int G_, int c_) { nM = M / BM; nN = N / BM; nwg = nM * nN; G = G_; c = c_; }
    __host__ __device__ bool next(int i, Unit& u) const {
        const long L = (long)i * G + c; if (L >= nwg) return false;
        int wgid = (int)L; { const int q = nwg / NXCD, r = nwg % NXCD, xcd = wgid % NXCD, off = wgid / NXCD; wgid = (xcd < r ? xcd * (q + 1) : r * (q + 1) + (xcd - r) * q) + off; }
        const int nig = WGM * nN, gid = wgid / nig, fm = gid * WGM, gsz = (nM - fm) < WGM ? (nM - fm) : WGM;
        u.pm = fm + ((wgid % nig) % gsz); u.pn = (wgid % nig) / gsz; return true;
    }
    __device__ __forceinline__ void a_ready(const Unit&) const {}
    __device__ __forceinline__ void done(const Unit&) const {}
};
template <class Epi, class Sched, bool STAMP = false>
__device__ __forceinline__ void gemm_phase(PG8_LAS unsigned char* lds, const Gemm g, const Sched& S, const Epi& E, unsigned long long* stamps) {
    const int tid = threadIdx.x, wid = __builtin_amdgcn_readfirstlane(tid >> 6), lane = tid & 63, wr = wid >> 2, wc = wid & 3, fr = lane & 15, fq = lane >> 4;
    const int K = g.K, nt = K / BK;
    int ts_lo = 0, ts_hi = 0, nts = 0; const unsigned long long rt_entry = STAMP ? (unsigned long long)wall_clock64() : 0ull;
#define PG8_STAMP() do { if (STAMP && wid == 0 && nts < 64) { const unsigned long long _c = (unsigned long long)clock64(); \
        ts_lo = (lane == nts) ? (int)(unsigned)_c : ts_lo; ts_hi = (lane == nts) ? (int)(unsigned)(_c >> 32) : ts_hi; ++nts; } } while (0)
    PG8_STAMP();
    unsigned voffA[2], voffB[2];
#pragma unroll
    for (int i = 0; i < 2; ++i) { int R, C; stage_rc(tid * 16 + i * 8192, R, C); const int Rb = Epi::PERM ? ((R & ~31) + perm32(R & 31)) : R;
        voffA[i] = (unsigned)(R * K + C) * 2u; voffB[i] = (unsigned)(Rb * K + C) * 2u; }
    const size_t kstep = (size_t)(BK * 2);
    const size_t hstep = (size_t)HALF * K * 2;
    const size_t tstep = 2 * hstep;
    const unsigned ldsw = (unsigned)wid * 1024u;
    const int aoff = lds_byte(wr * 64 + fr, fq * 8), boff = lds_byte(wc * 32 + fr, fq * 8);
#define PG8_SA(b, h) (((b) * 2 + (h)) * HTB)
#define PG8_SB(b, h) ((4 + (b) * 2 + (h)) * HTB)
#define PG8_STAGE(bufoff, gbase, voff) do { _Pragma("unroll") for (int _i = 0; _i < 2; ++_i) \
        __builtin_amdgcn_global_load_lds((const unsigned*)((const char*)(gbase) + (voff)[_i]), (PG8_LAS unsigned*)(lds + (bufoff) + ldsw + _i * 8192), 16, 0, 0); } while (0)
#define PG8_LDA(dst, b, h) do { _Pragma("unroll") for (int m = 0; m < 4; ++m) _Pragma("unroll") for (int k = 0; k < 2; ++k) dst[m][k] = *(const PG8_LAS bf16x8*)(lds + PG8_SA(b, h) + aoff + m * 2048 + k * 1024); } while (0)
#define PG8_LDB(dst, b, h) do { _Pragma("unroll") for (int n = 0; n < 2; ++n) _Pragma("unroll") for (int k = 0; k < 2; ++k) dst[n][k] = *(const PG8_LAS bf16x8*)(lds + PG8_SB(b, h) + boff + n * 2048 + k * 1024); } while (0)
#define PG8_MMA(ai, bj, At, Bt) do { __builtin_amdgcn_s_setprio(1); _Pragma("unroll") for (int m = 0; m < 4; ++m) _Pragma("unroll") for (int n = 0; n < 2; ++n) _Pragma("unroll") for (int k = 0; k < 2; ++k) \
        acc[ai][bj][m][n] = __builtin_amdgcn_mfma_f32_16x16x32_bf16(Bt[n][k], At[m][k], acc[ai][bj][m][n], 0, 0, 0); __builtin_amdgcn_s_setprio(0); } while (0)
#define PG8_WAIT_V(n) asm volatile("s_waitcnt vmcnt(" #n ")" ::: "memory")
#define PG8_WAIT_L(n) asm volatile("s_waitcnt lgkmcnt(" #n ")" ::: "memory")
#define PG8_BAR __builtin_amdgcn_s_barrier()
#define PG8_SCHED __builtin_amdgcn_sched_barrier(0)
    Unit cur, nxt; int ui = 0;
    if (!S.next(0, cur)) return;
    f32x4 acc[2][2][4][2];
#pragma unroll
    for (int a = 0; a < 2; ++a)
#pragma unroll
        for (int b = 0; b < 2; ++b)
#pragma unroll
            for (int m = 0; m < 4; ++m)
#pragma unroll
                for (int n = 0; n < 2; ++n) acc[a][b][m][n] = (f32x4){0.f, 0.f, 0.f, 0.f};
    bf16x8 At[4][2], B0[2][2], B1[2][2];
    const char* cA = (const char*)g.A + (size_t)cur.pm * tstep; const char* cB = (const char*)g.Bt + (size_t)cur.pn * tstep;
    S.a_ready(cur);
    PG8_STAGE(PG8_SB(0, 0), cB, voffB); PG8_STAGE(PG8_SA(0, 0), cA, voffA); PG8_STAGE(PG8_SB(0, 1), cB + hstep, voffB); PG8_STAGE(PG8_SA(0, 1), cA + hstep, voffA);
    if (wr == 1) PG8_BAR;
    PG8_WAIT_V(4); PG8_BAR;
    PG8_STAGE(PG8_SB(1, 0), cB + kstep, voffB); PG8_STAGE(PG8_SA(1, 0), cA + kstep, voffA); PG8_STAGE(PG8_SB(1, 1), cB + hstep + kstep, voffB);
    PG8_WAIT_V(6); PG8_BAR;
    PG8_STAMP();
    for (;;) {
        const bool has_next = S.next(ui + 1, nxt);
        const char* nA = has_next ? (const char*)g.A + (size_t)nxt.pm * tstep : cA; const char* nB = has_next ? (const char*)g.Bt + (size_t)nxt.pn * tstep : cB;
        for (int t = 0; t < nt; t += 2) {
            const bool last = (t == nt - 2);
            const char* a1 = cA + (size_t)(t + 1) * kstep;
            const char* a2 = last ? nA : cA + (size_t)(t + 2) * kstep; const char* b2 = last ? nB : cB + (size_t)(t + 2) * kstep;
            const char* a3 = a2 + kstep; const char* b3 = b2 + kstep;
            if (last && has_next) S.a_ready(nxt);
            PG8_LDB(B0, 0, 0); PG8_SCHED; PG8_LDA(At, 0, 0); PG8_STAGE(PG8_SA(1, 1), a1 + hstep, voffA);
            PG8_WAIT_L(8); PG8_BAR; PG8_WAIT_L(0); PG8_MMA(0, 0, At, B0); PG8_BAR; PG8_SCHED;
            PG8_LDB(B1, 0, 1); PG8_STAGE(PG8_SB(0, 0), b2, voffB);
            PG8_BAR; PG8_WAIT_L(0); PG8_MMA(0, 1, At, B1); PG8_BAR;
            PG8_LDA(At, 0, 1); PG8_STAGE(PG8_SA(0, 0), a2, voffA);
            PG8_BAR; PG8_WAIT_L(0); PG8_MMA(1, 0, At, B0); PG8_BAR; PG8_SCHED;
            PG8_STAGE(PG8_SB(0, 1), b2 + hstep, voffB);
            PG8_WAIT_V(6); PG8_BAR; PG8_MMA(1, 1, At, B1); PG8_BAR;
            PG8_LDB(B0, 1, 0); PG8_SCHED; PG8_LDA(At, 1, 0); PG8_STAGE(PG8_SA(0, 1), a2 + hstep, voffA);
            PG8_WAIT_L(8); PG8_BAR; PG8_WAIT_L(0); PG8_MMA(0, 0, At, B0); PG8_BAR; PG8_SCHED;
            PG8_LDB(B1, 1, 1); PG8_STAGE(PG8_SB(1, 0), b3, voffB);
            PG8_BAR; PG8_WAIT_L(0); PG8_MMA(0, 1, At, B1); PG8_BAR;
            PG8_LDA(At, 1, 1); PG8_STAGE(PG8_SA(1, 0), a3, voffA);
            PG8_BAR; PG8_WAIT_L(0); PG8_MMA(1, 0, At, B0); PG8_BAR; PG8_SCHED;
            PG8_STAGE(PG8_SB(1, 1), b3 + hstep, voffB);
            PG8_WAIT_V(6); PG8_BAR; PG8_MMA(1, 1, At, B1); PG8_BAR;
        }
        PG8_STAMP();
        if constexpr (!Epi::AFTER_DRAIN) { E(acc, cur, wr, wc, fr, fq); S.done(cur); }
        PG8_STAMP();
        if (!has_next) break;
#pragma unroll
        for (int a = 0; a < 2; ++a)
#pragma unroll
            for (int b = 0; b < 2; ++b)
#pragma unroll
                for (int m = 0; m < 4; ++m)
#pragma unroll
                    for (int n = 0; n < 2; ++n) acc[a][b][m][n] = (f32x4){0.f, 0.f, 0.f, 0.f};
        cur = nxt; cA = nA; cB = nB; ++ui;
    }
    PG8_WAIT_V(0);
    if (wr == 0) PG8_BAR;
    PG8_BAR;
    if constexpr (Epi::AFTER_DRAIN) { E.fused(acc, cur, wr, wc, fr, fq, lds, wid, lane); S.done(cur); }
    PG8_STAMP();
    if (STAMP && wid == 0) { stamps[lane] = lane < nts ? (((unsigned long long)(unsigned)ts_hi << 32) | (unsigned)ts_lo) : 0ull;
        if (lane == 62) stamps[62] = rt_entry; if (lane == 63) stamps[63] = (unsigned long long)wall_clock64(); }
#undef PG8_STAMP
#undef PG8_SA
#undef PG8_SB
#undef PG8_STAGE
#undef PG8_LDA
#undef PG8_LDB
#undef PG8_MMA
#undef PG8_WAIT_V
#undef PG8_WAIT_L
#undef PG8_BAR
#undef PG8_SCHED
}
}
namespace pg8 {
struct UnitX { int pm, pn, kind; };
struct GDesc { const bf16_t* A; const bf16_t* Bt; int ks; };
__device__ __forceinline__ void map_unit(int L, int nM, int nN, int& pm, int& pn) {
    const int nwg = nM * nN; int wgid = L; { const int q = nwg / NXCD, r = nwg % NXCD, xcd = wgid % NXCD, off = wgid / NXCD; wgid = (xcd < r ? xcd * (q + 1) : r * (q + 1) + (xcd - r) * q) + off; }
    const int nig = WGM * nN, gid = wgid / nig, fm = gid * WGM, gsz = (nM - fm) < WGM ? (nM - fm) : WGM;
    pm = fm + ((wgid % nig) % gsz); pn = (wgid % nig) / gsz;
}
template <class Epi, class Sched>
__device__ __forceinline__ void gemm_stream(PG8_LAS unsigned char* lds, const Sched& S, const Epi& E) {
    const int tid = threadIdx.x, wid = __builtin_amdgcn_readfirstlane(tid >> 6), lane = tid & 63, wr = wid >> 2, wc = wid & 3, fr = lane & 15, fq = lane >> 4;
    const size_t kstep = (size_t)(BK * 2);
    const unsigned ldsw = (unsigned)wid * 1024u;
    const int aoff = lds_byte(wr * 64 + fr, fq * 8), boff = lds_byte(wc * 32 + fr, fq * 8);
#define PG8_SA(b, h) (((b) * 2 + (h)) * HTB)
#define PG8_SB(b, h) ((4 + (b) * 2 + (h)) * HTB)
#define PG8_STAGE(bufoff, gbase, voff) do { _Pragma("unroll") for (int _i = 0; _i < 2; ++_i) \
        __builtin_amdgcn_global_load_lds((const unsigned*)((const char*)(gbase) + (voff)[_i]), (PG8_LAS unsigned*)(lds + (bufoff) + ldsw + _i * 8192), 16, 0, 0); } while (0)
#define PG8_LDA(dst, b, h) do { _Pragma("unroll") for (int m = 0; m < 4; ++m) _Pragma("unroll") for (int k = 0; k < 2; ++k) dst[m][k] = *(const PG8_LAS bf16x8*)(lds + PG8_SA(b, h) + aoff + m * 2048 + k * 1024); } while (0)
#define PG8_LDB(dst, b, h) do { _Pragma("unroll") for (int n = 0; n < 2; ++n) _Pragma("unroll") for (int k = 0; k < 2; ++k) dst[n][k] = *(const PG8_LAS bf16x8*)(lds + PG8_SB(b, h) + boff + n * 2048 + k * 1024); } while (0)
#define PG8_MMA(ai, bj, At, Bt) do { __builtin_amdgcn_s_setprio(1); _Pragma("unroll") for (int m = 0; m < 4; ++m) _Pragma("unroll") for (int n = 0; n < 2; ++n) _Pragma("unroll") for (int k = 0; k < 2; ++k) \
        acc[ai][bj][m][n] = __builtin_amdgcn_mfma_f32_16x16x32_bf16(Bt[n][k], At[m][k], acc[ai][bj][m][n], 0, 0, 0); __builtin_amdgcn_s_setprio(0); } while (0)
#define PG8_WAIT_V(n) asm volatile("s_waitcnt vmcnt(" #n ")" ::: "memory")
#define PG8_WAIT_L(n) asm volatile("s_waitcnt lgkmcnt(" #n ")" ::: "memory")
#define PG8_BAR __builtin_amdgcn_s_barrier()
#define PG8_SCHED __builtin_amdgcn_sched_barrier(0)
    UnitX cur, nxt; int ui = 0;
    if (!S.next(0, cur)) return;
    f32x4 acc[2][2][4][2];
#pragma unroll
    for (int a = 0; a < 2; ++a)
#pragma unroll
        for (int b = 0; b < 2; ++b)
#pragma unroll
            for (int m = 0; m < 4; ++m)
#pragma unroll
                for (int n = 0; n < 2; ++n) acc[a][b][m][n] = (f32x4){0.f, 0.f, 0.f, 0.f};
    bf16x8 At[4][2], B0[2][2], B1[2][2];
    GDesc dc = S.desc(cur.kind);
    int ksC = dc.ks; size_t hsC = (size_t)HALF * ksC * 2;
    unsigned vAc[2], vBc[2];
#pragma unroll
    for (int i = 0; i < 2; ++i) { int R, C; stage_rc(tid * 16 + i * 8192, R, C); const int Rb = (R & ~31) + perm32(R & 31);
        vAc[i] = (unsigned)(R * ksC + C) * 2u; vBc[i] = (unsigned)(Rb * ksC + C) * 2u; }
    int shC = 31 - __builtin_clz((unsigned)ksC * 2u);
    const char* cA = (const char*)dc.A + (size_t)cur.pm * 2 * hsC; const char* cB = (const char*)dc.Bt + (size_t)cur.pn * 2 * hsC;
    PG8_STAGE(PG8_SB(0, 0), cB, vBc); PG8_STAGE(PG8_SA(0, 0), cA, vAc); PG8_STAGE(PG8_SB(0, 1), cB + hsC, vBc); PG8_STAGE(PG8_SA(0, 1), cA + hsC, vAc);
    if (wr == 1) PG8_BAR;
    PG8_WAIT_V(4); PG8_BAR;
    PG8_STAGE(PG8_SB(1, 0), cB + kstep, vBc); PG8_STAGE(PG8_SA(1, 0), cA + kstep, vAc); PG8_STAGE(PG8_SB(1, 1), cB + hsC + kstep, vBc);
    PG8_WAIT_V(6); PG8_BAR;
    for (;;) {
        const bool has_next = S.next(ui + 1, nxt);
        const char* nA = cA; const char* nB = cB; int ksN = ksC; size_t hsN = hsC;
        if (has_next) { const GDesc dn = S.desc(nxt.kind); ksN = dn.ks; hsN = (size_t)HALF * ksN * 2;
            nA = (const char*)dn.A + (size_t)nxt.pm * 2 * hsN; nB = (const char*)dn.Bt + (size_t)nxt.pn * 2 * hsN; }
        const int shN = 31 - __builtin_clz((unsigned)ksN * 2u); const unsigned cmask = (unsigned)ksC * 2u - 1u;
        const int nt = ksC / BK;
        for (int t = 0; t < nt; t += 2) {
            const bool last = (t == nt - 2);
            const char* a1 = cA + (size_t)(t + 1) * kstep;
            const char* a2 = last ? nA : cA + (size_t)(t + 2) * kstep; const char* b2 = last ? nB : cB + (size_t)(t + 2) * kstep;
            const char* a3 = a2 + kstep; const char* b3 = b2 + kstep;
            const size_t hs2 = last ? hsN : hsC;
            unsigned vA2[2], vB2[2];
#pragma unroll
            for (int i = 0; i < 2; ++i) { vA2[i] = last ? (((vAc[i] >> shC) << shN) | (vAc[i] & cmask)) : vAc[i]; vB2[i] = last ? (((vBc[i] >> shC) << shN) | (vBc[i] & cmask)) : vBc[i]; }
            PG8_LDB(B0, 0, 0); PG8_SCHED; PG8_LDA(At, 0, 0); PG8_STAGE(PG8_SA(1, 1), a1 + hsC, vAc);
            PG8_WAIT_L(8); PG8_BAR; PG8_WAIT_L(0); PG8_MMA(0, 0, At, B0); PG8_BAR; PG8_SCHED;
            PG8_LDB(B1, 0, 1); PG8_STAGE(PG8_SB(0, 0), b2, vB2);
            PG8_BAR; PG8_WAIT_L(0); PG8_MMA(0, 1, At, B1); PG8_BAR;
            PG8_LDA(At, 0, 1); PG8_STAGE(PG8_SA(0, 0), a2, vA2);
            PG8_BAR; PG8_WAIT_L(0); PG8_MMA(1, 0, At, B0); PG8_BAR; PG8_SCHED;
            PG8_STAGE(PG8_SB(0, 1), b2 + hs2, vB2);
            PG8_WAIT_V(6); PG8_BAR; PG8_MMA(1, 1, At, B1); PG8_BAR;
            PG8_LDB(B0, 1, 0); PG8_SCHED; PG8_LDA(At, 1, 0); PG8_STAGE(PG8_SA(0, 1), a2 + hs2, vA2);
            PG8_WAIT_L(8); PG8_BAR; PG8_WAIT_L(0); PG8_MMA(0, 0, At, B0); PG8_BAR; PG8_SCHED;
            PG8_LDB(B1, 1, 1); PG8_STAGE(PG8_SB(1, 0), b3, vB2);
            PG8_BAR; PG8_WAIT_L(0); PG8_MMA(0, 1, At, B1); PG8_BAR;
            PG8_LDA(At, 1, 1); PG8_STAGE(PG8_SA(1, 0), a3, vA2);
            PG8_BAR; PG8_WAIT_L(0); PG8_MMA(1, 0, At, B0); PG8_BAR; PG8_SCHED;
            PG8_STAGE(PG8_SB(1, 1), b3 + hs2, vB2);
            PG8_WAIT_V(6); PG8_BAR; PG8_MMA(1, 1, At, B1); PG8_BAR;
        }
        E(acc, cur, wr, wc, fr, fq);
        if (!has_next) break;
#pragma unroll
        for (int a = 0; a < 2; ++a)
#pragma unroll
            for (int b = 0; b < 2; ++b)
#pragma unroll
                for (int m = 0; m < 4; ++m)
#pragma unroll
                    for (int n = 0; n < 2; ++n) acc[a][b][m][n] = (f32x4){0.f, 0.f, 0.f, 0.f};
#pragma unroll
        for (int i = 0; i < 2; ++i) { vAc[i] = ((vAc[i] >> shC) << shN) | (vAc[i] & cmask); vBc[i] = ((vBc[i] >> shC) << shN) | (vBc[i] & cmask); }
        cur = nxt; cA = nA; cB = nB; ksC = ksN; hsC = hsN; shC = shN; ++ui;
    }
    PG8_WAIT_V(0);
    if (wr == 0) PG8_BAR;
    PG8_BAR;
#undef PG8_SA
#undef PG8_SB
#undef PG8_STAGE
#undef PG8_LDA
#undef PG8_LDB
#undef PG8_MMA
#undef PG8_WAIT_V
#undef PG8_WAIT_L
#undef PG8_BAR
#undef PG8_SCHED
}
}
#define XB_TMO      128
#define XB_XCNT(j)  (256  + 64 * (j))
#define XB_XSUB(j)  (1280 + 64 * (j))
#define XB_XGEN(j)  (2304 + 64 * (j))
#define XB_TOP      3328
#define XB_TOPGEN   3392
#define XCD_BAR_WORDS 3456
#define XB_SPIN_CAP (1u << 18)
#define LAS __attribute__((address_space(3)))
__device__ __forceinline__ unsigned xb_ld(unsigned* p)              { return __hip_atomic_load(p, __ATOMIC_RELAXED, __HIP_MEMORY_SCOPE_AGENT); }
__device__ __forceinline__ unsigned xb_add(unsigned* p, unsigned v) { return __hip_atomic_fetch_add(p, v, __ATOMIC_RELAXED, __HIP_MEMORY_SCOPE_AGENT); }
__device__ __forceinline__ unsigned xb_xcc_id() { return (unsigned)__builtin_amdgcn_s_getreg((3 << 11) | 20) & 0xFu; }
#define XB_SPIN(cond, bar) do { unsigned _sp = 0; while (cond) { __builtin_amdgcn_s_sleep(1); \
    if ((++_sp & 255u) == 0u) { if (xb_ld(&(bar)[XB_TMO])) break; if (_sp > XB_SPIN_CAP) { atomicAdd(&(bar)[XB_TMO], 1u); break; } } } } while (0)

struct XcdBarrier {
    unsigned* bar; unsigned x;
    volatile LAS unsigned* st;
};

__device__ __forceinline__ XcdBarrier xcd_barrier_post(unsigned* bar, volatile LAS unsigned* st) {
    XcdBarrier b; b.bar = bar; b.x = xb_xcc_id(); b.st = st;
    if (threadIdx.x == 0) (void)xb_add(&bar[XB_XCNT(b.x)], 1u);
    return b;
}
__device__ __forceinline__ void xcd_barrier_complete(unsigned* bar, unsigned x, unsigned& nloc, unsigned& nx) {
    const unsigned G = gridDim.x * gridDim.y * gridDim.z;
    unsigned sum, cnt, mine, sp = 0u;
    for (;;) {
        sum = 0u; cnt = 0u; mine = 0u;
#pragma unroll
        for (unsigned j = 0; j < 16; ++j) { const unsigned c = xb_ld(&bar[XB_XCNT(j)]); sum += c; cnt += (c > 0u) ? 1u : 0u; mine = (j == x) ? c : mine; }
        if (sum == G) break;
        __builtin_amdgcn_s_sleep(1);
        if ((++sp & 255u) == 0u) { if (xb_ld(&bar[XB_TMO])) break; if (sp > XB_SPIN_CAP) { atomicAdd(&bar[XB_TMO], 1u); break; } }
    }
    nloc = mine > 0u ? mine : 1u; nx = cnt > 0u ? cnt : 1u;
}

template <class F> __device__ __forceinline__ void xcd_barrier(const XcdBarrier& b, F&& shadow) {
    asm volatile("s_waitcnt vmcnt(0)" ::: "memory");
    __syncthreads();
    if (threadIdx.x == 0) {
        unsigned* bar = b.bar;
        __builtin_amdgcn_s_waitcnt(0);
        unsigned nloc = b.st[0], nx = b.st[1];
        if (nloc == 0u) { xcd_barrier_complete(bar, b.x, nloc, nx); b.st[0] = nloc; b.st[1] = nx; }
        const unsigned old = xb_add(&bar[XB_XSUB(b.x)], 1u);
        const unsigned gen = old / nloc;
        if (old + 1u == (gen + 1u) * nloc) {
            __builtin_amdgcn_fence(__ATOMIC_RELEASE, "agent");
            asm volatile("s_waitcnt vmcnt(0)" ::: "memory");
            const unsigned og = xb_add(&bar[XB_TOP], 1u);
            const unsigned tg = og / nx;
            if (og + 1u == (tg + 1u) * nx) xb_add(&bar[XB_TOPGEN], 1u);
            else XB_SPIN(xb_ld(&bar[XB_TOPGEN]) == tg, bar);
            __builtin_amdgcn_fence(__ATOMIC_ACQUIRE, "agent");
            xb_add(&bar[XB_XGEN(b.x)], 1u);
            asm volatile("s_waitcnt vmcnt(0)" ::: "memory");
        } else {
            XB_SPIN(xb_ld(&bar[XB_XGEN(b.x)]) == gen, bar);
            __builtin_amdgcn_fence(__ATOMIC_ACQUIRE, "agent");
            asm volatile("s_waitcnt vmcnt(0)" ::: "memory");
        }
    } else if (threadIdx.x >= 64) shadow();
    __syncthreads();
}
using pg8::f32x4; using pg8::u32x4; using pg8::bf16_t; using pg8::Unit;
#define DI __device__ __forceinline__
constexpr int M_TOK = 16384, DM = 1024, SEQ = 2048, NPHASE = 10;
constexpr float EPS = 1e-6f;
constexpr int LDS_ST = 147456, LDS_BYTES = LDS_ST + 16;
constexpr size_t MiB = 1024 * 1024;
constexpr size_t OFF_WIN1 = 0, OFF_WAOUT = 4 * MiB, OFF_WPLE0 = 6 * MiB, OFF_WPLE1 = 6 * MiB + 512 * 1024, OFF_WG0 = 7 * MiB, OFF_WG1 = 9 * MiB,
                 OFF_WKQZ = 11 * MiB, OFF_WV = 17 * MiB, OFF_WBOUT = 19 * MiB, OFF_PB = 21 * MiB, OFF_R1 = 37 * MiB, OFF_R2 = 69 * MiB, OFF_R3 = 101 * MiB,
                 OFF_R4 = 133 * MiB, OFF_RSTD0 = 197 * MiB, OFF_RSTD1 = 197 * MiB + 65536, OFF_SSP = 197 * MiB + 131072, OFF_BAR = 199 * MiB, OFF_E1 = 200 * MiB, WS_END = 232 * MiB;

struct Params {
    const float *x, *p, *a_norm, *a_w_in, *a_w_group, *a_scale, *a_w_out, *kv_norm, *w_kv, *k_norm, *b_norm, *b_w_in, *b_q_norm, *b_w_out, *ple_w, *ple_gate_w;
    float* out; unsigned char* ws; int ph_lo, ph_hi;
};

typedef __bf16 bf16x2_t __attribute__((ext_vector_type(2)));
typedef float f32x2_t __attribute__((ext_vector_type(2)));
typedef unsigned u32x2_t __attribute__((ext_vector_type(2)));
typedef short s16x8 __attribute__((ext_vector_type(8)));
typedef short s16x4 __attribute__((ext_vector_type(4)));
typedef float f32x16 __attribute__((ext_vector_type(16)));
DI unsigned pk2(float lo, float hi) { f32x2_t v = {lo, hi}; bf16x2_t r = __builtin_convertvector(v, bf16x2_t); return __builtin_bit_cast(unsigned, r); }
DI float bflo(unsigned u) { return __uint_as_float(u << 16); }
DI float bfhi(unsigned u) { return __uint_as_float(u & 0xffff0000u); }
DI u32x4 pk8(f32x4 a, f32x4 b) { u32x4 w; w.x = pk2(a[0], a[1]); w.y = pk2(a[2], a[3]); w.z = pk2(b[0], b[1]); w.w = pk2(b[2], b[3]); return w; }
DI int xcd_affine_id() { const int G = (int)gridDim.x, w = (int)blockIdx.x; return (G & 7) ? w : (w & 7) * (G >> 3) + (w >> 3); }
DI float wave_sum(float v) {
#pragma unroll
    for (int o = 1; o < 64; o <<= 1) v += __shfl_xor(v, o);
    return v;
}
DI float sigm(float v) { return __builtin_amdgcn_rcpf(1.f + __expf(-v)); }
DI f32x4 silu4(f32x4 v) { f32x4 r; r[0] = v[0] * sigm(v[0]); r[1] = v[1] * sigm(v[1]); r[2] = v[2] * sigm(v[2]); r[3] = v[3] * sigm(v[3]); return r; }
DI f32x4 sigm4(f32x4 v) { f32x4 r; r[0] = sigm(v[0]); r[1] = sigm(v[1]); r[2] = sigm(v[2]); r[3] = sigm(v[3]); return r; }

typedef const f32x4 (&AccRef)[2][2][4][2];

struct Epi1 {
    static constexpr bool PERM = true, AFTER_DRAIN = false;
    bf16_t* ug; bf16_t* sz; const float* rstd0;
    DI void operator()(AccRef acc, const Unit& u, int wr, int wc, int fr, int fq) const {
        const int row0 = u.pm * 256 + wr * 64 + fr; const bool isz = u.pn >= 4;
        bf16_t* base = (isz ? sz : ug) + (u.pn & 3) * 256 + wc * 32 + 8 * fq;
        float rsv[2][4];
#pragma unroll
        for (int ai = 0; ai < 2; ++ai)
#pragma unroll
            for (int m = 0; m < 4; ++m) rsv[ai][m] = rstd0[row0 + ai * 128 + m * 16];
#pragma unroll
        for (int ai = 0; ai < 2; ++ai)
#pragma unroll
            for (int m = 0; m < 4; ++m) { const int row = row0 + ai * 128 + m * 16; const float rs = rsv[ai][m]; bf16_t* rowp = base + (size_t)row * DM;
#pragma unroll
                for (int bj = 0; bj < 2; ++bj) { f32x4 v0 = acc[ai][bj][m][0] * rs, v1 = acc[ai][bj][m][1] * rs;
                    if (isz) { v0 = silu4(v0); v1 = silu4(v1); }
                    *(u32x4*)(rowp + bj * 128) = pk8(v0, v1); } }
    }
};
struct EpiE {
    static constexpr bool PERM = true, AFTER_DRAIN = false;
    bf16_t* e;
    DI void operator()(AccRef acc, const Unit& u, int wr, int wc, int fr, int fq) const {
        const int row0 = u.pm * 256 + wr * 64 + fr; bf16_t* base = e + u.pn * 256 + wc * 32 + 8 * fq;
#pragma unroll
        for (int ai = 0; ai < 2; ++ai)
#pragma unroll
            for (int m = 0; m < 4; ++m) { bf16_t* rowp = base + (size_t)(row0 + ai * 128 + m * 16) * DM;
#pragma unroll
                for (int bj = 0; bj < 2; ++bj) *(u32x4*)(rowp + bj * 128) = pk8(acc[ai][bj][m][0], acc[ai][bj][m][1]); }
    }
};
DI void unpk8(const u32x4 q, f32x4& lo, f32x4& hi) { lo = (f32x4){bflo(q.x), bfhi(q.x), bflo(q.y), bfhi(q.y)}; hi = (f32x4){bflo(q.z), bfhi(q.z), bflo(q.w), bfhi(q.w)}; }
template <bool SRCF32> struct EpiResB {
    static constexpr bool PERM = true, AFTER_DRAIN = false;
    const float* srcf; const bf16_t* srcb; bf16_t* xb;
    DI void operator()(AccRef acc, const Unit& u, int wr, int wc, int fr, int fq) const {
        const int row0 = u.pm * 256 + wr * 64 + fr, col0 = u.pn * 256 + wc * 32 + 8 * fq;
#pragma unroll
        for (int ai = 0; ai < 2; ++ai) {
            f32x4 a[4][2][2];
#pragma unroll
            for (int m = 0; m < 4; ++m) { const size_t o = (size_t)(row0 + ai * 128 + m * 16) * DM + col0;
#pragma unroll
                for (int bj = 0; bj < 2; ++bj) {
                    if (SRCF32) { a[m][bj][0] = __builtin_nontemporal_load((const f32x4*)(srcf + o + bj * 128)); a[m][bj][1] = __builtin_nontemporal_load((const f32x4*)(srcf + o + bj * 128 + 4)); }
                    else { const u32x4 q = *(const u32x4*)(srcb + o + bj * 128); unpk8(q, a[m][bj][0], a[m][bj][1]); } } }
#pragma unroll
            for (int m = 0; m < 4; ++m) { const size_t o = (size_t)(row0 + ai * 128 + m * 16) * DM + col0;
#pragma unroll
                for (int bj = 0; bj < 2; ++bj) *(u32x4*)(xb + o + bj * 128) = pk8(a[m][bj][0] + acc[ai][bj][m][0], a[m][bj][1] + acc[ai][bj][m][1]); }
        }
    }
};
template <bool NEXT> struct EpiGate {
    static constexpr bool PERM = true, AFTER_DRAIN = false;
    const bf16_t* xin; const bf16_t* e; bf16_t* xb; float* ssp; float* outf;
    DI void operator()(AccRef acc, const Unit& u, int wr, int wc, int fr, int fq) const {
        const int row0 = u.pm * 256 + wr * 64 + fr, col0 = u.pn * 256 + wc * 32 + 8 * fq;
#pragma unroll
        for (int ai = 0; ai < 2; ++ai) {
            u32x4 xv[4][2], ev[4][2];
#pragma unroll
            for (int m = 0; m < 4; ++m) { const size_t o = (size_t)(row0 + ai * 128 + m * 16) * DM + col0;
#pragma unroll
                for (int bj = 0; bj < 2; ++bj) { xv[m][bj] = *(const u32x4*)(xin + o + bj * 128); ev[m][bj] = *(const u32x4*)(e + o + bj * 128); } }
#pragma unroll
            for (int m = 0; m < 4; ++m) { const int row = row0 + ai * 128 + m * 16; const size_t o = (size_t)row * DM + col0; float ss = 0.f;
#pragma unroll
                for (int bj = 0; bj < 2; ++bj) { f32x4 a0, a1, e0, e1; unpk8(xv[m][bj], a0, a1); unpk8(ev[m][bj], e0, e1);
                    const f32x4 v0 = a0 + e0 * sigm4(acc[ai][bj][m][0]), v1 = a1 + e1 * sigm4(acc[ai][bj][m][1]);
                    if (NEXT) { *(u32x4*)(xb + o + bj * 128) = pk8(v0, v1);
                        ss += (v0[0] * v0[0] + v0[1] * v0[1]) + (v0[2] * v0[2] + v0[3] * v0[3]) + (v1[0] * v1[0] + v1[1] * v1[1]) + (v1[2] * v1[2] + v1[3] * v1[3]); }
                    else { __builtin_nontemporal_store(v0, (f32x4*)(outf + o + bj * 128)); __builtin_nontemporal_store(v1, (f32x4*)(outf + o + bj * 128 + 4)); } }
                if (NEXT) { ss += __shfl_xor(ss, 16); ss += __shfl_xor(ss, 32); if (fq == 0) atomicAdd(ssp + row, ss); } }
        }
    }
};
struct EpiKQZ {
    static constexpr bool PERM = true, AFTER_DRAIN = false;
    bf16_t *kk, *qq, *sz2; const float *rstd1, *k_norm, *q_norm;
    DI void operator()(AccRef acc, const Unit& u, int wr, int wc, int fr, int fq) const {
        const int row0 = u.pm * 256 + wr * 64 + fr, kind = u.pn >> 2, pq = u.pn & 3;
        float rsv[2][4];
#pragma unroll
        for (int ai = 0; ai < 2; ++ai)
#pragma unroll
            for (int m = 0; m < 4; ++m) rsv[ai][m] = rstd1[row0 + ai * 128 + m * 16];
        if (kind == 2) {
            bf16_t* base = sz2 + pq * 256 + 64 * wc + 8 * fq;
#pragma unroll
            for (int ai = 0; ai < 2; ++ai)
#pragma unroll
                for (int m = 0; m < 4; ++m) { const int row = row0 + ai * 128 + m * 16; const float rs = rsqrtf(rsv[ai][m] * (1.f / DM) + EPS); bf16_t* rowp = base + (size_t)row * DM;
#pragma unroll
                    for (int bj = 0; bj < 2; ++bj) *(u32x4*)(rowp + bj * 32) = pk8(silu4(acc[ai][bj][m][0] * rs), silu4(acc[ai][bj][m][1] * rs)); }
        } else {
            const float* gn = kind ? q_norm : k_norm; const float mul = kind ? 0.125f * 1.4426950408889634f : 1.f;
            bf16_t* dst = kind ? qq : kk; const int head = pq * 4 + wc;
            f32x4 g[2][2];
#pragma unroll
            for (int bj = 0; bj < 2; ++bj)
#pragma unroll
                for (int n = 0; n < 2; ++n) g[bj][n] = *(const f32x4*)(gn + 32 * bj + 8 * fq + 4 * n) * mul;
#pragma unroll
            for (int ai = 0; ai < 2; ++ai)
#pragma unroll
                for (int m = 0; m < 4; ++m) { const int row = row0 + ai * 128 + m * 16; const float rs = rsqrtf(rsv[ai][m] * (1.f / DM) + EPS); const int b = row >> 11, s = row & 2047;
                    f32x4 v[2][2]; float ss = 0.f;
#pragma unroll
                    for (int bj = 0; bj < 2; ++bj)
#pragma unroll
                        for (int n = 0; n < 2; ++n) { v[bj][n] = acc[ai][bj][m][n] * rs; ss += (v[bj][n][0] * v[bj][n][0] + v[bj][n][1] * v[bj][n][1]) + (v[bj][n][2] * v[bj][n][2] + v[bj][n][3] * v[bj][n][3]); }
                    ss += __shfl_xor(ss, 16); ss += __shfl_xor(ss, 32);
                    const float hr = rsqrtf(ss * (1.f / 64.f) + EPS);
                    bf16_t* rowp = dst + ((size_t)(b * 16 + head) * SEQ + s) * 64 + 8 * fq;
#pragma unroll
                    for (int bj = 0; bj < 2; ++bj) *(u32x4*)(rowp + 32 * bj) = pk8(v[bj][0] * hr * g[bj][0], v[bj][1] * hr * g[bj][1]); }
        }
    }
};
struct EpiVT {
    static constexpr bool PERM = true, AFTER_DRAIN = false;
    bf16_t* vt; const float* rstd1;
    DI void operator()(AccRef acc, const Unit& u, int wr, int wc, int fr, int fq) const {
        const int c0 = u.pm * 256 + wr * 64 + fr, tok0 = u.pn * 256 + wc * 32 + 8 * fq;
        f32x4 rs[2][2];
#pragma unroll
        for (int bj = 0; bj < 2; ++bj)
#pragma unroll
            for (int n = 0; n < 2; ++n) { const f32x4 q = *(const f32x4*)(rstd1 + tok0 + 128 * bj + 4 * n);
#pragma unroll
                for (int j = 0; j < 4; ++j) rs[bj][n][j] = rsqrtf(q[j] * (1.f / DM) + EPS); }
#pragma unroll
        for (int ai = 0; ai < 2; ++ai)
#pragma unroll
            for (int m = 0; m < 4; ++m) { const int c = c0 + ai * 128 + m * 16;
#pragma unroll
                for (int bj = 0; bj < 2; ++bj) { const int tok = tok0 + 128 * bj, b = tok >> 11, s = tok & 2047;
                    *(u32x4*)(vt + ((size_t)b * DM + c) * SEQ + s) = pk8(acc[ai][bj][m][0] * rs[bj][0], acc[ai][bj][m][1] * rs[bj][1]); } }
    }
};
template <class Epi> DI void run_gemm(PG8_LAS unsigned char* lds, const bf16_t* A, const bf16_t* Bt, int M, int N, int K, const Epi& E) {
    pg8::Gemm g{A, Bt, M, N, K}; pg8::StaticOrder S; S.init(M, N, (int)gridDim.x, (int)blockIdx.x);
    pg8::gemm_phase<Epi, pg8::StaticOrder, false>(lds, g, S, E, nullptr);
}

struct SchedPG {
    const unsigned char* ws; int layer, G, c;
    DI bool next(int i, pg8::UnitX& u) const { const int L = i * G + c; if (L >= 512) return false;
        pg8::map_unit(L & 255, 64, 4, u.pm, u.pn); u.kind = L >> 8; return true; }
    DI pg8::GDesc desc(int k) const { pg8::GDesc d;
        const size_t oa = k == 0 ? OFF_PB + (size_t)layer * M_TOK * 256 * 2 : OFF_R2, ob = k == 0 ? (layer ? OFF_WPLE1 : OFF_WPLE0) : (layer ? OFF_WG1 : OFF_WG0);
        d.A = (const bf16_t*)(ws + oa); d.Bt = (const bf16_t*)(ws + ob); d.ks = k == 0 ? 256 : 1024; return d; }
    DI void a_ready(const pg8::UnitX&) const {}
    DI void done(const pg8::UnitX&) const {}
};
template <bool NEXT> struct EpiPG {
    static constexpr bool PERM = true;
    EpiE e; EpiGate<NEXT> g;
    DI void operator()(AccRef acc, const pg8::UnitX& u, int wr, int wc, int fr, int fq) const { const Unit uu{u.pm, u.pn};
        if (u.kind == 0) e(acc, uu, wr, wc, fr, fq); else g(acc, uu, wr, wc, fr, fq); }
};
struct SchedP6 {
    const unsigned char* ws; int G, c;
    DI bool next(int i, pg8::UnitX& u) const { const int L = i * G + c; if (L >= 1024) return false;
        if (L < 768) { pg8::map_unit(L, 64, 12, u.pm, u.pn); u.kind = 0; } else { pg8::map_unit(L - 768, 4, 64, u.pm, u.pn); u.kind = 1; }
        return true; }
    DI pg8::GDesc desc(int k) const { pg8::GDesc d; d.A = (const bf16_t*)(ws + (k == 0 ? OFF_R3 : OFF_WV)); d.Bt = (const bf16_t*)(ws + (k == 0 ? OFF_WKQZ : OFF_R3)); d.ks = 1024; return d; }
};
struct EpiP6 {
    static constexpr bool PERM = true;
    EpiKQZ a; EpiVT b;
    DI void operator()(AccRef acc, const pg8::UnitX& u, int wr, int wc, int fr, int fq) const { const Unit uu{u.pm, u.pn};
        if (u.kind == 0) a(acc, uu, wr, wc, fr, fq); else b(acc, uu, wr, wc, fr, fq); }
};

DI int headperm(int cl) { const int o = cl & 255, wc = o >> 6, bj = (o >> 5) & 1, r = o & 31; return (cl & ~255) + 128 * bj + 32 * wc + r; }
DI void transpose_item(float* scr, const float* src, int ld, int K, int nT, const float* gain, bf16_t* dst, int rowoff, bool perm, int item, int lane) {
    const int kt = item / nT, nt = item - kt * nT, k0 = kt * 64, n0 = nt * 32, lr = lane >> 3, lc = lane & 7;
    float4 v[8];
#pragma unroll
    for (int i = 0; i < 8; ++i) v[i] = *(const float4*)(src + (size_t)(k0 + i * 8 + lr) * ld + n0 + lc * 4);
    float gk[8];
#pragma unroll
    for (int i = 0; i < 8; ++i) gk[i] = gain ? gain[k0 + 8 * lc + i] : 1.f;
#pragma unroll
    for (int i = 0; i < 8; ++i) { float* t = scr + (i * 8 + lr) * 33 + lc * 4; t[0] = v[i].x; t[1] = v[i].y; t[2] = v[i].z; t[3] = v[i].w; }
    asm volatile("s_waitcnt lgkmcnt(0)" ::: "memory");
#pragma unroll
    for (int j = 0; j < 4; ++j) { const int n = lr + 8 * j; const float* t = scr + (8 * lc) * 33 + n;
        int row = rowoff + n0 + n; if (perm) row = headperm(row);
        u32x4 w; w.x = pk2(t[0] * gk[0], t[33] * gk[1]); w.y = pk2(t[66] * gk[2], t[99] * gk[3]); w.z = pk2(t[132] * gk[4], t[165] * gk[5]); w.w = pk2(t[198] * gk[6], t[231] * gk[7]);
        *(u32x4*)(dst + (size_t)row * K + k0 + 8 * lc) = w; }
    asm volatile("s_waitcnt lgkmcnt(0)" ::: "memory");
}
DI void weff_job(float* L, const Params& P, bf16_t* dst, int job) {
    float* As = L; float* Bs = L + 64 * 129;
    const int tid = threadIdx.x, k0 = (job >> 4) * 64, n0 = (job & 15) * 64, g = n0 >> 8, d0 = n0 & 255, kk = tid >> 3, dg = tid & 7;
    float acc[8];
#pragma unroll
    for (int j = 0; j < 8; ++j) acc[j] = 0.f;
    for (int c0 = 0; c0 < 256; c0 += 128) {
        __syncthreads();
#pragma unroll
        for (int i = 0; i < 4; ++i) { const int idx = tid + 512 * i;
            { const int r = idx >> 5, c4 = idx & 31; const float4 v = *(const float4*)(P.a_w_in + (size_t)(k0 + r) * 2048 + g * 256 + c0 + c4 * 4);
              float* t = As + r * 129 + c4 * 4; t[0] = v.x; t[1] = v.y; t[2] = v.z; t[3] = v.w; }
            { const int cc = idx >> 4, d4 = idx & 15; *(float4*)(Bs + cc * 64 + d4 * 4) = *(const float4*)(P.a_w_group + (size_t)(g * 256 + c0 + cc) * 256 + d0 + d4 * 4); } }
        __syncthreads();
#pragma unroll 4
        for (int c = 0; c < 128; ++c) { const float a = As[kk * 129 + c]; const float4 b0 = *(const float4*)(Bs + c * 64 + dg * 8), b1 = *(const float4*)(Bs + c * 64 + dg * 8 + 4);
            acc[0] += a * b0.x; acc[1] += a * b0.y; acc[2] += a * b0.z; acc[3] += a * b0.w; acc[4] += a * b1.x; acc[5] += a * b1.y; acc[6] += a * b1.z; acc[7] += a * b1.w; }
    }
    const float an = P.a_norm[k0 + kk];
#pragma unroll
    for (int j = 0; j < 8; ++j) { const int n = n0 + dg * 8 + j; const float v = acc[j] * an * P.a_scale[n];
        dst[(size_t)n * DM + k0 + kk] = (bf16_t)(pk2(v, v) & 0xffffu); }
}
DI void shadow_p_convert(const Params& P) {
    const float4* pp = (const float4*)P.p; u32x4* pb = (u32x4*)(P.ws + OFF_PB);
    for (int L = (int)blockIdx.x; L < 256; L += (int)gridDim.x) { int pm, pn; pg8::map_unit(L, 64, 4, pm, pn); const int v = 4 * pm + pn;
        for (int j0 = (int)threadIdx.x - 64; j0 < 4096; j0 += 5 * 448) { float4 a[5], b[5];
#pragma unroll
            for (int q = 0; q < 5; ++q) { const int j = j0 + q * 448; if (j < 4096) { const size_t row = (size_t)(j >> 11) * M_TOK + 64 * v + ((j >> 5) & 63); const int c = j & 31;
                a[q] = pp[row * 64 + 2 * c]; b[q] = pp[row * 64 + 2 * c + 1]; } }
#pragma unroll
            for (int q = 0; q < 5; ++q) { const int j = j0 + q * 448; if (j < 4096) { const size_t row = (size_t)(j >> 11) * M_TOK + 64 * v + ((j >> 5) & 63); const int c = j & 31;
                u32x4 u; u.x = pk2(a[q].x, a[q].y); u.y = pk2(a[q].z, a[q].w); u.z = pk2(b[q].x, b[q].y); u.w = pk2(b[q].z, b[q].w); pb[row * 32 + c] = u; } } }
    }
}
DI void deferred_items(const Params& P, float* L, int seam) {
    const int wid = threadIdx.x >> 6, lane = threadIdx.x & 63; unsigned char* ws = P.ws; float* scr = L + wid * (64 * 33);
    const int nitems = (seam == 0) ? 1792 : 2560;
    for (int t = blockIdx.x * 7 + (wid - 1); t < nitems; t += gridDim.x * 7) {
        if (seam == 0) {
            if (t < 512) transpose_item(scr, P.a_w_out, 1024, 1024, 32, nullptr, (bf16_t*)(ws + OFF_WAOUT), 0, false, t, lane);
            else if (t < 640) transpose_item(scr, P.ple_w, 1024, 256, 32, nullptr, (bf16_t*)(ws + OFF_WPLE0), 0, false, t - 512, lane);
            else if (t < 768) transpose_item(scr, P.ple_w + 256 * 1024, 1024, 256, 32, nullptr, (bf16_t*)(ws + OFF_WPLE1), 0, false, t - 640, lane);
            else if (t < 1280) transpose_item(scr, P.w_kv, 2048, 1024, 32, P.kv_norm, (bf16_t*)(ws + OFF_WKQZ), 0, true, t - 768, lane);
            else transpose_item(scr, P.w_kv + 1024, 2048, 1024, 32, P.kv_norm, (bf16_t*)(ws + OFF_WV), 0, false, t - 1280, lane);
        } else {
            if (t < 512) transpose_item(scr, P.ple_gate_w, 1024, 1024, 32, nullptr, (bf16_t*)(ws + OFF_WG0), 0, false, t, lane);
            else if (t < 1536) transpose_item(scr, P.b_w_in, 2048, 1024, 64, P.b_norm, (bf16_t*)(ws + OFF_WKQZ), 1024, true, t - 512, lane);
            else if (t < 2048) transpose_item(scr, P.b_w_out, 1024, 1024, 32, nullptr, (bf16_t*)(ws + OFF_WBOUT), 0, false, t - 1536, lane);
            else transpose_item(scr, P.ple_gate_w + 1024 * 1024, 1024, 1024, 32, nullptr, (bf16_t*)(ws + OFF_WG1), 0, false, t - 2048, lane);
        }
    }
}
DI void pan_barrier(unsigned* cnt, unsigned* tmo) {
    asm volatile("s_waitcnt vmcnt(0)" ::: "memory");
    __syncthreads();
    if (threadIdx.x == 0) {
        const unsigned old = xb_add(cnt, 1u), target = (old / 4u + 1u) * 4u;
        if (old + 1u != target) XB_SPIN(xb_ld(cnt) < target, tmo - XB_TMO);
        __builtin_amdgcn_fence(__ATOMIC_ACQUIRE, "agent");
        asm volatile("s_waitcnt vmcnt(0)" ::: "memory");
    }
    __syncthreads();
}
struct GrpBarrier { unsigned* cnt; unsigned* gen; unsigned* tmo; unsigned nmem; };
DI void grp_barrier(const GrpBarrier& gb) {
    asm volatile("s_waitcnt vmcnt(0)" ::: "memory");
    __syncthreads();
    if (threadIdx.x == 0) {
        const unsigned old = xb_add(gb.cnt, 1u), g = old / gb.nmem;
        if (old + 1u == (g + 1u) * gb.nmem) xb_add(gb.gen, 1u);
        else XB_SPIN(xb_ld(gb.gen) == g, gb.tmo - XB_TMO);
        __builtin_amdgcn_fence(__ATOMIC_ACQUIRE, "agent");
        asm volatile("s_waitcnt vmcnt(0)" ::: "memory");
    }
    __syncthreads();
}
DI void phase0(const Params& P, float* L) {
    const int tid = threadIdx.x, wid = tid >> 6, lane = tid & 63, w = blockIdx.x, G = gridDim.x;
    unsigned char* ws = P.ws;
    { float* ss1 = (float*)(ws + OFF_RSTD1); for (int i = w * 512 + tid; i < M_TOK; i += G * 512) ss1[i] = 0.f; }
    if ((w & 1) == 0) { for (int job = w; job < 256; job += G) weff_job(L, P, (bf16_t*)(ws + OFF_WIN1), job); __syncthreads(); }
    { float* scr = L + wid * (64 * 33);
      for (int t = w * 8 + wid; t < 512; t += G * 8) transpose_item(scr, P.a_w_in + 1024, 2048, 1024, 32, P.a_norm, (bf16_t*)(ws + OFF_WIN1) + (size_t)1024 * 1024, 0, false, t, lane); }
    { bf16_t* xb = (bf16_t*)(ws + OFF_R1); float* rstd0 = (float*)(ws + OFF_RSTD0);
      for (int row = (xcd_affine_id() * 8 + wid) * 8; row < M_TOK; row += G * 64) {
          float4 v[8][4];
#pragma unroll
          for (int q = 0; q < 8; ++q)
#pragma unroll
              for (int j = 0; j < 4; ++j) v[q][j] = ((const float4*)(P.x + (size_t)(row + q) * DM) + lane)[64 * j];
#pragma unroll
          for (int q = 0; q < 8; ++q) { float s = 0.f;
#pragma unroll
              for (int j = 0; j < 4; ++j) s += (v[q][j].x * v[q][j].x + v[q][j].y * v[q][j].y) + (v[q][j].z * v[q][j].z + v[q][j].w * v[q][j].w);
              s = wave_sum(s);
              uint2* o = (uint2*)(xb + (size_t)(row + q) * DM) + lane;
#pragma unroll
              for (int j = 0; j < 4; ++j) { uint2 u; u.x = pk2(v[q][j].x, v[q][j].y); u.y = pk2(v[q][j].z, v[q][j].w); o[64 * j] = u; }
              if (lane == 0) rstd0[row + q] = rsqrtf(s * (1.f / DM) + EPS); } } }
    if ((w & 1) != 0) { __syncthreads(); for (int job = w; job < 256; job += G) weff_job(L, P, (bf16_t*)(ws + OFF_WIN1), job); }
}
DI void unpack8(const u32x4 q, float (&f)[8]) { f[0] = bflo(q.x); f[1] = bfhi(q.x); f[2] = bflo(q.y); f[3] = bfhi(q.y); f[4] = bflo(q.z); f[5] = bfhi(q.z); f[6] = bflo(q.w); f[7] = bfhi(q.w); }
DI void pool_phase(const Params& P) {
    const bf16_t* ug = (const bf16_t*)(P.ws + OFF_R2); const bf16_t* sz = (const bf16_t*)(P.ws + OFF_R3); bf16_t* Gd = (bf16_t*)(P.ws + OFF_R1);
    const int nth = gridDim.x * 512;
    for (int idx = xcd_affine_id() * 512 + threadIdx.x; idx < 131072; idx += nth) {
        const int chunk = idx & 127, run = idx >> 7, row0 = run * 16, t0 = row0 & (SEQ - 1), c0 = chunk * 8, wlen = 2 << (chunk >> 5);
        const u32x4* up = (const u32x4*)(ug + (size_t)row0 * DM + c0); const u32x4* zp = (const u32x4*)(sz + (size_t)row0 * DM + c0); u32x4* gp = (u32x4*)(Gd + (size_t)row0 * DM + c0);
        float s[8], c[8], z[8];
#pragma unroll
        for (int j = 0; j < 8; ++j) s[j] = 0.f;
        { const bool hist = t0 > 0;
#pragma unroll
          for (int j = 1; j <= 16; ++j) {
              const int jj = hist ? (j <= wlen ? j : wlen) : 0; const float mk = (hist && j <= wlen) ? 1.f : 0.f;
              unpack8(up[-(jj * 128)], c);
#pragma unroll
              for (int q = 0; q < 8; ++q) s[q] += mk * c[q]; } }
        const float inv_full = 1.f / (float)wlen;
#pragma unroll 4
        for (int rr = 0; rr < 16; ++rr) {
            const int t = t0 + rr;
            if (t >= wlen) { unpack8(up[(rr - wlen) * 128], c);
#pragma unroll
                for (int q = 0; q < 8; ++q) s[q] -= c[q]; }
            unpack8(up[rr * 128], c); unpack8(zp[rr * 128], z);
            const float inv = (t + 1 < wlen) ? 1.f / (float)(t + 1) : inv_full;
            float o[8];
#pragma unroll
            for (int q = 0; q < 8; ++q) { s[q] += c[q]; o[q] = (s[q] * inv - c[q]) * z[q]; }
            u32x4 w; w.x = pk2(o[0], o[1]); w.y = pk2(o[2], o[3]); w.z = pk2(o[4], o[5]); w.w = pk2(o[6], o[7]); gp[rr * 128] = w;
        }
    }
}
#define MFMA32(a, b, c) __builtin_amdgcn_mfma_f32_32x32x16_bf16((a), (b), (c), 0, 0, 0)
DI void attn_phase(const Params& P, PG8_LAS unsigned char* lds) {
    constexpr int HIST = 128, WIN = 384, KP = 144, VP = 776, NF = 6, VCH = 48;
    PG8_LAS unsigned char* Kl = lds; PG8_LAS unsigned char* Vl = lds + WIN * KP;
    const bf16_t* kk = (const bf16_t*)(P.ws + OFF_R1); const bf16_t* qq = (const bf16_t*)(P.ws + OFF_R2); const bf16_t* vt = (const bf16_t*)(P.ws + OFF_R4);
    const bf16_t* sz2 = (const bf16_t*)(P.ws + OFF_R4 + 32 * MiB); bf16_t* g2 = (bf16_t*)(P.ws + OFF_E1);
    const int tid = threadIdx.x, wid = tid >> 6, lane = tid & 63, r = lane & 31, hh = lane >> 5;
#define ATT_LOAD_FILL(IT, KV, VV) do { const int _bh = (IT) >> 3, _wlo = ((IT) & 7) * 256 - HIST; const bf16_t* _Kg = kk + (size_t)_bh * SEQ * 64; const bf16_t* _Vg = vt + (size_t)_bh * 64 * SEQ; \
        _Pragma("unroll") for (int i = 0; i < NF; ++i) { const int c = tid + 512 * i, row = c >> 3, part = c & 7, key = _wlo + row; if (key >= 0) KV[i] = *(const u32x4*)(_Kg + (size_t)key * 64 + part * 8); } \
        _Pragma("unroll") for (int i = 0; i < NF; ++i) { const int c = tid + 512 * i, d = c / VCH, part = c - d * VCH, key0 = _wlo + part * 8; if (key0 >= 0) VV[i] = *(const u32x4*)(_Vg + (size_t)d * SEQ + key0); } } while (0)
#define ATT_LOAD_Q(IT, QF) do { const bf16_t* _Qp = qq + ((size_t)((IT) >> 3) * SEQ + ((IT) & 7) * 256 + 32 * wid + r) * 64 + hh * 8; \
        _Pragma("unroll") for (int ks = 0; ks < 4; ++ks) QF[ks] = *(const s16x8*)(_Qp + ks * 16); } while (0)
    u32x4 kv[NF], vv[NF];
    const bool aff = (gridDim.x & 7) == 0; const int islot0 = aff ? (int)(blockIdx.x >> 3) : (int)blockIdx.x, istep = aff ? (int)(gridDim.x >> 3) : (int)gridDim.x, ibase = aff ? (int)(blockIdx.x & 7) * 128 : 0, ilim = aff ? 128 : 1024;
    if (islot0 < ilim) { ATT_LOAD_FILL(ibase + islot0, kv, vv); }
    for (int islot = islot0; islot < ilim; islot += istep) {
        const int item = ibase + islot;
        const int qc = item & 7, bh = item >> 3, t0 = qc * 256, wlo = t0 - HIST, tq = t0 + 32 * wid;
        const bf16_t* Kg = kk + (size_t)bh * SEQ * 64; const bf16_t* Vg = vt + (size_t)bh * 64 * SEQ;
        const int b = bh >> 4, h = bh & 15; const size_t rowo = ((size_t)b * SEQ + tq + r) * DM + h * 64 + 4 * hh;
        asm volatile("s_waitcnt lgkmcnt(0)" ::: "memory"); __builtin_amdgcn_s_barrier(); asm volatile("" ::: "memory");
#pragma unroll
        for (int i = 0; i < NF; ++i) { const int c = tid + 512 * i, row = c >> 3, part = c & 7, key = wlo + row;
            if (key >= 0) *(PG8_LAS u32x4*)(Kl + row * KP + part * 16) = kv[i]; }
#pragma unroll
        for (int i = 0; i < NF; ++i) { const int c = tid + 512 * i, d = c / VCH, part = c - d * VCH, key0 = wlo + part * 8;
            if (key0 >= 0) { PG8_LAS u32x2_t* w = (PG8_LAS u32x2_t*)(Vl + d * VP + part * 16); u32x2_t a = {vv[i].x, vv[i].y}, bb = {vv[i].z, vv[i].w}; w[0] = a; w[1] = bb; } }
        s16x8 qf[4]; ATT_LOAD_Q(item, qf);
        asm volatile("s_waitcnt lgkmcnt(0)" ::: "memory"); __builtin_amdgcn_s_barrier(); asm volatile("" ::: "memory");
        const size_t rowc = ((size_t)b * SEQ + tq + (lane >> 3)) * DM + h * 64 + (lane & 7) * 8;
        u32x4 zc[4];
#pragma unroll
        for (int i = 0; i < 4; ++i) zc[i] = *(const u32x4*)(sz2 + rowc + (size_t)(8 * i) * DM);
        const int nitem = (islot + istep < ilim) ? item + istep : 1024;
        u32x4 kvn[NF], vvn[NF];
        if (nitem < 1024) { ATT_LOAD_FILL(nitem, kvn, vvn); }
        f32x16 o0, o1;
#pragma unroll
        for (int i = 0; i < 16; ++i) { o0[i] = 0.f; o1[i] = 0.f; }
        float carry = 1.f;
        for (int s0 = tq; s0 >= 0; s0 -= 32) {
            s16x8 kf[4]; s16x4 vf[2][2][2];
            if (s0 >= wlo) {
                PG8_LAS const unsigned char* kp = Kl + (s0 - wlo + r) * KP + hh * 16; PG8_LAS const unsigned char* vp = Vl + r * VP + (s0 - wlo + 4 * hh) * 2;
#pragma unroll
                for (int ks = 0; ks < 4; ++ks) kf[ks] = *(PG8_LAS const s16x8*)(kp + ks * 32);
#pragma unroll
                for (int dt = 0; dt < 2; ++dt)
#pragma unroll
                    for (int s = 0; s < 2; ++s)
#pragma unroll
                        for (int pt = 0; pt < 2; ++pt) vf[dt][s][pt] = *(PG8_LAS const s16x4*)(vp + dt * 32 * VP + (16 * s + 8 * pt) * 2);
            } else {
                const bf16_t* kp = Kg + (size_t)(s0 + r) * 64 + hh * 8; const bf16_t* vp = Vg + (size_t)r * SEQ + s0 + 4 * hh;
#pragma unroll
                for (int ks = 0; ks < 4; ++ks) kf[ks] = *(const s16x8*)(kp + ks * 16);
#pragma unroll
                for (int dt = 0; dt < 2; ++dt)
#pragma unroll
                    for (int s = 0; s < 2; ++s)
#pragma unroll
                        for (int pt = 0; pt < 2; ++pt) vf[dt][s][pt] = *(const s16x4*)(vp + (size_t)dt * 32 * SEQ + 16 * s + 8 * pt);
            }
            f32x16 x;
#pragma unroll
            for (int i = 0; i < 16; ++i) x[i] = 0.f;
#pragma unroll
            for (int ks = 0; ks < 4; ++ks) x = MFMA32(kf[ks], qf[ks], x);
            float beta[16], keep[16];
            const bool diag = (s0 == tq);
#pragma unroll
            for (int i = 0; i < 16; ++i) {
                const float l = fmaxf(x[i], -120.f);
                const float e = __builtin_amdgcn_exp2f(-l);
                float bt = __builtin_amdgcn_rcpf(1.f + e), kp = e * bt;
                beta[i] = bt; keep[i] = kp;
            }
            if (diag) {
#pragma unroll
                for (int i = 0; i < 16; ++i) { const bool valid = ((i & 3) + 8 * (i >> 2) + 4 * hh) < r; beta[i] = valid ? beta[i] : 0.f; keep[i] = valid ? keep[i] : 1.f; }
            }
            float Gp[4], PG[4];
#pragma unroll
            for (int g = 0; g < 4; ++g) { Gp[g] = (keep[4 * g] * keep[4 * g + 1]) * (keep[4 * g + 2] * keep[4 * g + 3]); PG[g] = __shfl_xor(Gp[g], 32); }
            float base[4];
            { float so = 1.f, sp = 1.f;
#pragma unroll
              for (int g = 3; g >= 0; --g) { base[g] = carry * so * sp * (hh == 0 ? PG[g] : 1.f); so *= Gp[g]; sp *= PG[g]; }
              carry = carry * so * sp; }
            float a[16];
#pragma unroll
            for (int g = 0; g < 4; ++g) { float run = base[g];
                a[4 * g + 3] = beta[4 * g + 3] * run; run *= keep[4 * g + 3];
                a[4 * g + 2] = beta[4 * g + 2] * run; run *= keep[4 * g + 2];
                a[4 * g + 1] = beta[4 * g + 1] * run; run *= keep[4 * g + 1];
                a[4 * g] = beta[4 * g] * run; }
#pragma unroll
            for (int s = 0; s < 2; ++s) {
                u32x4 pw; pw.x = pk2(a[8 * s], a[8 * s + 1]); pw.y = pk2(a[8 * s + 2], a[8 * s + 3]); pw.z = pk2(a[8 * s + 4], a[8 * s + 5]); pw.w = pk2(a[8 * s + 6], a[8 * s + 7]);
                const s16x8 pf = __builtin_bit_cast(s16x8, pw);
                const s16x8 va = __builtin_shufflevector(vf[0][s][0], vf[0][s][1], 0, 1, 2, 3, 4, 5, 6, 7);
                const s16x8 vb = __builtin_shufflevector(vf[1][s][0], vf[1][s][1], 0, 1, 2, 3, 4, 5, 6, 7);
                o0 = MFMA32(va, pf, o0); o1 = MFMA32(vb, pf, o1);
            }
            if (__all(carry < 1e-12f)) break;
        }
        { PG8_LAS unsigned char* S = lds + WIN * KP + 64 * VP + wid * 4608;
#pragma unroll
          for (int i = 0; i < 4; ++i) *(PG8_LAS u32x4*)(S + ((lane >> 3) + 8 * i) * 144 + (lane & 7) * 16) = zc[i];
          asm volatile("s_waitcnt lgkmcnt(0)" ::: "memory");
          PG8_LAS unsigned char* Sr = S + r * 144 + 8 * hh;
#pragma unroll
          for (int g = 0; g < 4; ++g) {
              const u32x2_t z0 = *(PG8_LAS const u32x2_t*)(Sr + 16 * g), z1 = *(PG8_LAS const u32x2_t*)(Sr + 64 + 16 * g);
              u32x2_t w0, w1;
              w0.x = pk2(o0[4 * g] * bflo(z0.x), o0[4 * g + 1] * bfhi(z0.x)); w0.y = pk2(o0[4 * g + 2] * bflo(z0.y), o0[4 * g + 3] * bfhi(z0.y));
              w1.x = pk2(o1[4 * g] * bflo(z1.x), o1[4 * g + 1] * bfhi(z1.x)); w1.y = pk2(o1[4 * g + 2] * bflo(z1.y), o1[4 * g + 3] * bfhi(z1.y));
              *(PG8_LAS u32x2_t*)(Sr + 16 * g) = w0; *(PG8_LAS u32x2_t*)(Sr + 64 + 16 * g) = w1; }
          asm volatile("s_waitcnt lgkmcnt(0)" ::: "memory");
#pragma unroll
          for (int i = 0; i < 4; ++i) { const u32x4 v = *(PG8_LAS const u32x4*)(S + ((lane >> 3) + 8 * i) * 144 + (lane & 7) * 16); *(u32x4*)(g2 + rowc + (size_t)(8 * i) * DM) = v; }
          asm volatile("s_waitcnt lgkmcnt(0)" ::: "memory"); }
#pragma unroll
        for (int i = 0; i < NF; ++i) { kv[i] = kvn[i]; vv[i] = vvn[i]; }
    }
#undef ATT_LOAD_FILL
#undef ATT_LOAD_Q
}

__global__ __launch_bounds__(512, 2) void yoco_fwd(Params P) {
    extern __shared__ __attribute__((aligned(16))) unsigned char shm[];
    PG8_LAS unsigned char* lds = (PG8_LAS unsigned char*)shm;
    unsigned char* ws = P.ws;
    bf16_t* R1 = (bf16_t*)(ws + OFF_R1); bf16_t* R2 = (bf16_t*)(ws + OFF_R2); bf16_t* R3 = (bf16_t*)(ws + OFF_R3); bf16_t* R4 = (bf16_t*)(ws + OFF_R4);
    float* rstd0 = (float*)(ws + OFF_RSTD0); float* rstd1 = (float*)(ws + OFF_RSTD1); float* ssp = (float*)(ws + OFF_SSP);
    const bf16_t* pb = (const bf16_t*)(ws + OFF_PB); bf16_t* E1b = (bf16_t*)(ws + OFF_E1);
#define PH(k) if (P.ph_lo <= (k) && (k) < P.ph_hi)
#define SYNC(k) if (fused) { if ((k) < 2) xcd_barrier(xb, [&]() { deferred_items(P, (float*)shm, (k)); }); else if ((k) == 2) xcd_barrier(xb, [&]() { shadow_p_convert(P); }); else if (grp_ok && ((k) == 3 || (k) == 8)) pan_barrier(pcnt, bar + XB_TMO); else if (grp_ok) grp_barrier(gb); else xcd_barrier(xb, []() {}); }
    const bool fused = (P.ph_hi - P.ph_lo) > 1;
    volatile LAS unsigned* st = (volatile LAS unsigned*)(lds + LDS_ST);
    unsigned* bar = (unsigned*)(ws + OFF_BAR);
    if (fused) { if (threadIdx.x == 0) { st[0] = 0u; st[1] = 0u; } __syncthreads(); }
    XcdBarrier xb; xb.bar = bar; xb.x = 0u; xb.st = st;
    if (fused) xb = xcd_barrier_post(bar, st);
    unsigned* gtab = (unsigned*)(ws + OFF_BAR + 16384 + 8192);
    if (fused && threadIdx.x == 0) gtab[blockIdx.x] = xb.x;
    bool grp_ok = false;
    GrpBarrier gb;
    unsigned* pcnt; { int pm_, pn_; pg8::map_unit((int)(blockIdx.x & 255), 64, 4, pm_, pn_); pcnt = (unsigned*)(ws + OFF_BAR + 32768) + 64 * pm_; }
    PH(0) phase0(P, (float*)shm);
    SYNC(0)
    gb.cnt = (unsigned*)(ws + OFF_BAR + 16384) + 64 * (blockIdx.x & 7); gb.gen = (unsigned*)(ws + OFF_BAR + 16384 + 4096) + 64 * (blockIdx.x & 7); gb.tmo = bar + XB_TMO; gb.nmem = gridDim.x >> 3;
    if (fused) { const int t = threadIdx.x; int pred = 1;
        if (gridDim.x == 256 && t < 256) pred = (gtab[t] == gtab[t & 7]);
        grp_ok = (gridDim.x == 256) && (__syncthreads_and(pred) != 0); }
    PH(1) { Epi1 E{R2, R3, rstd0}; run_gemm(lds, R1, (const bf16_t*)(ws + OFF_WIN1), M_TOK, 2048, 1024, E); }
    SYNC(1)
    PH(2) pool_phase(P);
    SYNC(2)
    PH(3) { EpiResB<true> E{P.x, nullptr, R2}; run_gemm(lds, R1, (const bf16_t*)(ws + OFF_WAOUT), M_TOK, 1024, 1024, E); }
    SYNC(3)
    PH(4) { SchedPG S{ws, 0, (int)gridDim.x, (int)blockIdx.x}; EpiPG<true> E{EpiE{E1b}, EpiGate<true>{R2, E1b, R3, rstd1, nullptr}}; pg8::gemm_stream(lds, S, E); }
    SYNC(4)
    PH(6) { SchedP6 S{ws, (int)gridDim.x, (int)blockIdx.x};
            EpiP6 E{EpiKQZ{R1, R2, R4 + (size_t)M_TOK * DM, rstd1, P.k_norm, P.b_q_norm}, EpiVT{R4, rstd1}}; pg8::gemm_stream(lds, S, E); }
    SYNC(6)
    PH(7) attn_phase(P, lds);
    SYNC(7)
    PH(8) { EpiResB<false> E{nullptr, R3, R2}; run_gemm(lds, E1b, (const bf16_t*)(ws + OFF_WBOUT), M_TOK, 1024, 1024, E); }
    SYNC(8)
    PH(9) { SchedPG S{ws, 1, (int)gridDim.x, (int)blockIdx.x}; EpiPG<false> E{EpiE{E1b}, EpiGate<false>{R2, E1b, nullptr, nullptr, P.out}}; pg8::gemm_stream(lds, S, E); }
}

extern "C" void kernel_launch(void* const* d_in, const int* in_sizes, int n_in, void* d_out, int out_size, void* d_ws, size_t ws_size, hipStream_t stream) {
    static int grid = 0;
    if (grid == 0) {
        int dev = 0, cus = 0, per_cu = 0;
        if (n_in != 16 || out_size != M_TOK * DM || ws_size < WS_END) { fprintf(stderr, "kernel_launch: unexpected shapes (n_in %d out %d ws %zu)\n", n_in, out_size, ws_size); grid = -1; return; }
        (void)hipGetDevice(&dev); (void)hipDeviceGetAttribute(&cus, hipDeviceAttributeMultiprocessorCount, dev);
        if (hipFuncSetAttribute((const void*)yoco_fwd, hipFuncAttributeMaxDynamicSharedMemorySize, LDS_BYTES) != hipSuccess) { fprintf(stderr, "kernel_launch: hipFuncSetAttribute failed\n"); grid = -1; return; }
        (void)hipOccupancyMaxActiveBlocksPerMultiprocessor(&per_cu, (const void*)yoco_fwd, 512, LDS_BYTES);
        if (per_cu < 1) { fprintf(stderr, "kernel_launch: occupancy query says %d blocks per CU\n", per_cu); (void)hipGetLastError(); per_cu = 1; }
        grid = cus;
    }
    if (grid < 0) return;
    Params p{};
    const float** pp = (const float**)&p;
    for (int i = 0; i < 16; ++i) pp[i] = (const float*)d_in[i];
    p.out = (float*)d_out; p.ws = (unsigned char*)d_ws;
    p.ph_lo = 0; p.ph_hi = NPHASE;
    if (hipMemsetAsync((unsigned char*)d_ws + OFF_BAR, 0, 65536, stream) != hipSuccess) { fprintf(stderr, "kernel_launch: memset of the barrier words failed\n"); return; }
    void* args[] = {&p};
    hipError_t e = hipLaunchCooperativeKernel((const void*)yoco_fwd, dim3(grid), dim3(512), args, LDS_BYTES, stream);
    if (e != hipSuccess) fprintf(stderr, "kernel_launch: cooperative launch failed: %s (grid %d)\n", hipGetErrorString(e), grid);
}
```
